# Optimizing an MI355X kernel written in HIP

```python
import functools
import jax, jax.numpy as jnp
from jax import lax
import numpy as np

D_MODEL = 1024
BATCH = 16
SEQ = 2048
DEPTH = 1
DEC_BATCH = 128
DEC_SEQ = 1
PAST_LEN = 16384
PAGE_SIZE = 128

MIX_WIDTH = D_MODEL
LRU_WIDTH = MIX_WIDTH // 2
LRU_HEADS = 8
LRU_HEAD_DIM = LRU_WIDTH // LRU_HEADS
CONV_WIDTH = 4
LRU_C = 8.0
MLA_WIDTH = MIX_WIDTH - LRU_WIDTH
MLA_HEADS = 8
QK_NOPE_DIM = 64
QK_ROPE_DIM = 32
QK_HEAD_DIM = QK_NOPE_DIM + QK_ROPE_DIM
V_HEAD_DIM = MLA_WIDTH // MLA_HEADS
Q_LORA_RANK = 256
KV_LORA_RANK = 128
ROPE_THETA = 10000.0
ATTN_SCALE = QK_HEAD_DIM ** -0.5
D_FF = 2816
FFN_CONV_WIDTH = 3
Q_BLOCK = 128
EPS = 1e-6
IN_COLS = 2 * LRU_WIDTH + Q_LORA_RANK + KV_LORA_RANK + QK_ROPE_DIM
IN_SPLITS = (LRU_WIDTH, 2 * LRU_WIDTH, 2 * LRU_WIDTH + Q_LORA_RANK,
             2 * LRU_WIDTH + Q_LORA_RANK + KV_LORA_RANK)

kernel_name = 'hymba_rglru_mla_convffn_adaln_step'


def rms_norm(x, g):
    xf = x.astype(jnp.float32)
    y = xf * lax.rsqrt(jnp.mean(xf * xf, axis=-1, keepdims=True) + EPS)
    return (y * g.astype(jnp.float32)).astype(x.dtype)


def rope_cos_sin(pos):
    inv = ROPE_THETA ** (-jnp.arange(0, QK_ROPE_DIM, 2, dtype=jnp.float32) / QK_ROPE_DIM)
    ang = pos.astype(jnp.float32)[:, None] * inv[None, :]
    return jnp.cos(ang), jnp.sin(ang)


def apply_rope(x, cos, sin):
    xf = x.astype(jnp.float32)
    half = QK_ROPE_DIM // 2
    x1, x2 = xf[..., :half], xf[..., half:]
    return jnp.concatenate([x1 * cos - x2 * sin, x2 * cos + x1 * sin], axis=-1).astype(x.dtype)


def causal_dwconv(x, buf, w, b):
    k = w.shape[0]
    s = x.shape[1]
    xx = jnp.concatenate([buf.astype(x.dtype), x], axis=1)
    out = b + xx[:, 0:s] * w[0]
    for j in range(1, k):
        out = out + xx[:, j:j + s] * w[j]
    return out, xx[:, xx.shape[1] - (k - 1):]


def rg_lru(x, pos, h0, w_a, b_a, w_x, b_x, lam):
    bsz, s, w = x.shape
    xh = x.reshape(bsz, s, LRU_HEADS, LRU_HEAD_DIM)
    r = jax.nn.sigmoid((jnp.einsum('bshi,hij->bshj', xh, w_a).reshape(bsz, s, w) + b_a).astype(jnp.float32))
    i = jax.nn.sigmoid((jnp.einsum('bshi,hij->bshj', xh, w_x).reshape(bsz, s, w) + b_x).astype(jnp.float32))
    log_a = -LRU_C * r * jax.nn.softplus(-lam.astype(jnp.float32))
    a = jnp.exp(log_a)
    mult = jnp.sqrt(-jnp.expm1(2.0 * log_a))
    mult = jnp.where((pos == 0)[None, :, None], 1.0, mult)
    u = mult * i * x.astype(jnp.float32)

    def step(h, au):
        a_t, u_t = au
        h = a_t * h + u_t
        return h, h

    h_last, hs = lax.scan(step, h0.astype(jnp.float32), (jnp.swapaxes(a, 0, 1), jnp.swapaxes(u, 0, 1)))
    return jnp.swapaxes(hs, 0, 1).astype(x.dtype), h_last.astype(h0.dtype)


def mla_prompt_attention(q_nope, q_rope, kv_lat, k_rope, w_ukv, k_nope_g):
    bsz, s = q_nope.shape[:2]
    kv = (kv_lat @ w_ukv).reshape(bsz, s, MLA_HEADS, QK_NOPE_DIM + V_HEAD_DIM)
    k_nope = rms_norm(kv[..., :QK_NOPE_DIM], k_nope_g)
    v = kv[..., QK_NOPE_DIM:]
    nb = s // Q_BLOCK
    key_pos = jnp.arange(s)
    neg = jnp.finfo(jnp.float32).min

    def to_blocks(t):
        return jnp.moveaxis(t.reshape(bsz, nb, Q_BLOCK, *t.shape[2:]), 1, 0)

    def one_block(args):
        qn, qr, blk = args
        q_pos = blk * Q_BLOCK + jnp.arange(Q_BLOCK)
        sc = (jnp.einsum('bqhd,bkhd->bhqk', qn, k_nope)
              + jnp.einsum('bqhd,bkd->bhqk', qr, k_rope)).astype(jnp.float32) * ATTN_SCALE
        sc = jnp.where(key_pos[None, :] <= q_pos[:, None], sc, neg)
        p = jax.nn.softmax(sc, axis=-1).astype(v.dtype)
        return jnp.einsum('bhqk,bkhd->bqhd', p, v)

    out = lax.map(one_block, (to_blocks(q_nope), to_blocks(q_rope), jnp.arange(nb)))
    return jnp.moveaxis(out, 0, 1).reshape(bsz, s, MLA_HEADS, V_HEAD_DIM)


def mla_sample_attention(q_nope, q_rope, kv_lat, k_rope, cache_lat, cache_kr, page_table, w_ukv, k_nope_g):
    n_past = page_table.shape[1] * PAGE_SIZE
    ds = q_nope.shape[1]
    key_pos = jnp.arange(n_past + ds)
    q_pos = n_past + jnp.arange(ds)
    mask = key_pos[None, :] <= q_pos[:, None]
    neg = jnp.finfo(jnp.float32).min

    def one_seq(args):
        qn, qr, lat_new, kr_new, pages = args
        lat = jnp.concatenate([cache_lat[pages].reshape(n_past, KV_LORA_RANK).astype(lat_new.dtype), lat_new], axis=0)
        kr = jnp.concatenate([cache_kr[pages].reshape(n_past, QK_ROPE_DIM).astype(kr_new.dtype), kr_new], axis=0)
        kv = (lat @ w_ukv).reshape(n_past + ds, MLA_HEADS, QK_NOPE_DIM + V_HEAD_DIM)
        k_nope = rms_norm(kv[..., :QK_NOPE_DIM], k_nope_g)
        v = kv[..., QK_NOPE_DIM:]
        sc = (jnp.einsum('qhd,khd->hqk', qn, k_nope)
              + jnp.einsum('qhd,kd->hqk', qr, kr)).astype(jnp.float32) * ATTN_SCALE
        sc = jnp.where(mask, sc, neg)
        p = jax.nn.softmax(sc, axis=-1).astype(v.dtype)
        return jnp.einsum('hqk,khd->qhd', p, v)

    return lax.map(one_seq, (q_nope, q_rope, kv_lat, k_rope, page_table))


def hybrid_layer(x, c, pos, lru_h0, lru_buf, ffn_buf, attend, lp):
    bsz, s, _ = x.shape
    mod = jnp.dot(jax.nn.silu(c), lp['w_ada']) + lp['b_ada']
    shift1, scale1, gate1, shift2, scale2, gate2 = jnp.split(mod[:, None, :], 6, axis=-1)

    h = rms_norm(x, lp['norm1_g']) * (1.0 + scale1) + shift1
    z = h @ lp['w_in']
    x_lru, g_lru, q_lat, kv_lat, k_rope = jnp.split(z, IN_SPLITS, axis=-1)

    x_conv, lru_buf_new = causal_dwconv(x_lru, lru_buf, lp['lru_conv_w'], lp['lru_conv_b'])
    hs, h_last = rg_lru(x_conv, pos, lru_h0, lp['lru_w_a'], lp['lru_b_a'], lp['lru_w_x'], lp['lru_b_x'], lp['lru_lambda'])
    lru_out = hs * jax.nn.gelu(g_lru)

    cos, sin = rope_cos_sin(pos)
    q = (rms_norm(q_lat, lp['q_lora_norm_g']) @ lp['w_uq']).reshape(bsz, s, MLA_HEADS, QK_HEAD_DIM)
    q_nope = rms_norm(q[..., :QK_NOPE_DIM], lp['q_nope_norm_g'])
    q_rope = apply_rope(rms_norm(q[..., QK_NOPE_DIM:], lp['q_rope_norm_g']), cos[:, None, :], sin[:, None, :])
    kv_lat = rms_norm(kv_lat, lp['kv_lora_norm_g'])
    k_rope = apply_rope(rms_norm(k_rope, lp['k_rope_norm_g']), cos, sin)
    attn = attend(q_nope, q_rope, kv_lat, k_rope).reshape(bsz, s, MLA_WIDTH)

    mixed = jnp.concatenate([rms_norm(lru_out, lp['lru_out_norm_g']),
                             rms_norm(attn, lp['mla_out_norm_g'])], axis=-1) @ lp['w_o']
    x = x + gate1 * mixed

    h2 = rms_norm(x, lp['norm2_g']) * (1.0 + scale2) + shift2
    up, ffn_buf_new = causal_dwconv(h2 @ lp['w_up'], ffn_buf, lp['ffn_conv_w'], lp['ffn_conv_b'])
    val, gt = jnp.split(up, 2, axis=-1)
    x = x + gate2 * ((jax.nn.gelu(gt) * val) @ lp['w_down'])
    return x, kv_lat, k_rope, h_last, lru_buf_new, ffn_buf_new


def setup_inputs(seed: int = 0) -> dict:
    key = jax.random.key(seed)
    ks = iter(jax.random.split(key, 48))
    f32 = jnp.float32

    def nrm(shape, scale=1.0):
        return jax.random.normal(next(ks), shape, f32) * scale

    def gain(shape):
        return 1.0 + 0.02 * nrm(shape)

    L = DEPTH
    n_pages = PAST_LEN // PAGE_SIZE
    n_pool = (DEC_BATCH * n_pages * 5) // 4

    x_prompt = nrm((BATCH, SEQ, D_MODEL))
    x_sample = nrm((DEC_BATCH, DEC_SEQ, D_MODEL))
    cache_kv_latent = nrm((L, n_pool, PAGE_SIZE, KV_LORA_RANK))
    cache_k_rope = nrm((L, n_pool, PAGE_SIZE, QK_ROPE_DIM))
    state_lru_h = nrm((L, DEC_BATCH, LRU_WIDTH), 0.5)
    state_lru_conv = nrm((L, DEC_BATCH, CONV_WIDTH - 1, LRU_WIDTH))
    state_ffn_conv = nrm((L, DEC_BATCH, FFN_CONV_WIDTH - 1, 2 * D_FF))
    perm = jax.random.permutation(next(ks), n_pool)
    page_table = perm[:DEC_BATCH * n_pages].reshape(DEC_BATCH, n_pages).astype(jnp.int32)
    c_prompt = nrm((BATCH, D_MODEL))
    c_sample = nrm((DEC_BATCH, D_MODEL))

    a0 = jax.random.uniform(next(ks), (L, LRU_WIDTH), f32, 0.9, 0.999)
    sg = a0 ** (1.0 / LRU_C)
    lru_lambda = jnp.log(sg) - jnp.log1p(-sg)

    return {
        'x_prompt': x_prompt,
        'x_sample': x_sample,
        'cache_kv_latent': cache_kv_latent,
        'cache_k_rope': cache_k_rope,
        'state_lru_h': state_lru_h,
        'state_lru_conv': state_lru_conv,
        'state_ffn_conv': state_ffn_conv,
        'page_table': page_table,
        'c_prompt': c_prompt,
        'c_sample': c_sample,
        'w_ada': nrm((L, D_MODEL, 6 * D_MODEL), 0.5 * D_MODEL ** -0.5),
        'b_ada': nrm((L, 6 * D_MODEL), 0.01),
        'norm1_g': gain((L, D_MODEL)),
        'w_in': nrm((L, D_MODEL, IN_COLS), D_MODEL ** -0.5),
        'lru_conv_w': nrm((L, CONV_WIDTH, LRU_WIDTH), CONV_WIDTH ** -0.5),
        'lru_conv_b': nrm((L, LRU_WIDTH), 0.01),
        'lru_w_a': nrm((L, LRU_HEADS, LRU_HEAD_DIM, LRU_HEAD_DIM), LRU_HEAD_DIM ** -0.5),
        'lru_b_a': nrm((L, LRU_WIDTH), 0.01),
        'lru_w_x': nrm((L, LRU_HEADS, LRU_HEAD_DIM, LRU_HEAD_DIM), LRU_HEAD_DIM ** -0.5),
        'lru_b_x': nrm((L, LRU_WIDTH), 0.01),
        'lru_lambda': lru_lambda,
        'q_lora_norm_g': gain((L, Q_LORA_RANK)),
        'w_uq': nrm((L, Q_LORA_RANK, MLA_HEADS * QK_HEAD_DIM), Q_LORA_RANK ** -0.5),
        'q_nope_norm_g': gain((L, QK_NOPE_DIM)),
        'q_rope_norm_g': gain((L, QK_ROPE_DIM)),
        'kv_lora_norm_g': gain((L, KV_LORA_RANK)),
        'k_rope_norm_g': gain((L, QK_ROPE_DIM)),
        'w_ukv': nrm((L, KV_LORA_RANK, MLA_HEADS * (QK_NOPE_DIM + V_HEAD_DIM)), KV_LORA_RANK ** -0.5),
        'k_nope_norm_g': gain((L, QK_NOPE_DIM)),
        'lru_out_norm_g': gain((L, LRU_WIDTH)),
        'mla_out_norm_g': gain((L, MLA_WIDTH)),
        'w_o': nrm((L, MIX_WIDTH, D_MODEL), MIX_WIDTH ** -0.5),
        'norm2_g': gain((L, D_MODEL)),
        'w_up': nrm((L, D_MODEL, 2 * D_FF), D_MODEL ** -0.5),
        'ffn_conv_w': nrm((L, FFN_CONV_WIDTH, 2 * D_FF), FFN_CONV_WIDTH ** -0.5),
        'ffn_conv_b': nrm((L, 2 * D_FF), 0.01),
        'w_down': nrm((L, D_FF, D_MODEL), D_FF ** -0.5),
    }


def reference(x_prompt, x_sample, cache_kv_latent, cache_k_rope, state_lru_h, state_lru_conv,
              state_ffn_conv, page_table, c_prompt, c_sample, w_ada, b_ada, norm1_g, w_in,
              lru_conv_w, lru_conv_b, lru_w_a, lru_b_a, lru_w_x, lru_b_x, lru_lambda,
              q_lora_norm_g, w_uq, q_nope_norm_g, q_rope_norm_g, kv_lora_norm_g, k_rope_norm_g,
              w_ukv, k_nope_norm_g, lru_out_norm_g, mla_out_norm_g, w_o, norm2_g, w_up,
              ffn_conv_w, ffn_conv_b, w_down):
    bsz, s = x_prompt.shape[:2]
    dbsz, ds = x_sample.shape[:2]
    pos_prompt = jnp.arange(s)
    pos_sample = PAST_LEN + jnp.arange(ds)
    dt = x_prompt.dtype

    y_p, y_s = x_prompt, x_sample
    outs_p = ([], [], [], [], [])
    outs_s = ([], [], [], [], [])
    for l in range(DEPTH):
        lp = dict(w_ada=w_ada[l], b_ada=b_ada[l], norm1_g=norm1_g[l], w_in=w_in[l],
                  lru_conv_w=lru_conv_w[l], lru_conv_b=lru_conv_b[l], lru_w_a=lru_w_a[l],
                  lru_b_a=lru_b_a[l], lru_w_x=lru_w_x[l], lru_b_x=lru_b_x[l], lru_lambda=lru_lambda[l],
                  q_lora_norm_g=q_lora_norm_g[l], w_uq=w_uq[l], q_nope_norm_g=q_nope_norm_g[l],
                  q_rope_norm_g=q_rope_norm_g[l], kv_lora_norm_g=kv_lora_norm_g[l],
                  k_rope_norm_g=k_rope_norm_g[l], lru_out_norm_g=lru_out_norm_g[l],
                  mla_out_norm_g=mla_out_norm_g[l], w_o=w_o[l], norm2_g=norm2_g[l], w_up=w_up[l],
                  ffn_conv_w=ffn_conv_w[l], ffn_conv_b=ffn_conv_b[l], w_down=w_down[l])
        attend_prompt = functools.partial(mla_prompt_attention, w_ukv=w_ukv[l], k_nope_g=k_nope_norm_g[l])
        attend_sample = functools.partial(mla_sample_attention, cache_lat=cache_kv_latent[l],
                                          cache_kr=cache_k_rope[l], page_table=page_table,
                                          w_ukv=w_ukv[l], k_nope_g=k_nope_norm_g[l])
        res_p = hybrid_layer(y_p, c_prompt, pos_prompt,
                             jnp.zeros((bsz, LRU_WIDTH), dt),
                             jnp.zeros((bsz, CONV_WIDTH - 1, LRU_WIDTH), dt),
                             jnp.zeros((bsz, FFN_CONV_WIDTH - 1, 2 * D_FF), dt),
                             attend_prompt, lp)
        res_s = hybrid_layer(y_s, c_sample, pos_sample, state_lru_h[l], state_lru_conv[l],
                             state_ffn_conv[l], attend_sample, lp)
        y_p, y_s = res_p[0], res_s[0]
        for j in range(5):
            outs_p[j].append(res_p[j + 1])
            outs_s[j].append(res_s[j + 1])

    kv_latent_prompt = jnp.stack(outs_p[0])
    k_rope_prompt = jnp.stack(outs_p[1])
    lru_h_prompt = jnp.stack(outs_p[2])
    lru_conv_prompt = jnp.stack(outs_p[3])
    ffn_conv_prompt = jnp.stack(outs_p[4])
    kv_latent_sample = jnp.stack(outs_s[0])
    k_rope_sample = jnp.stack(outs_s[1])
    lru_h_sample = jnp.stack(outs_s[2])
    lru_conv_sample = jnp.stack(outs_s[3])
    ffn_conv_sample = jnp.stack(outs_s[4])
    return (y_p, y_s, kv_latent_prompt, k_rope_prompt, lru_h_prompt, lru_conv_prompt, ffn_conv_prompt,
            kv_latent_sample, k_rope_sample, lru_h_sample, lru_conv_sample, ffn_conv_sample)
```

```cpp
#include <hip/hip_runtime.h>
#include <cstdio>
#include <cstdint>
#include <cmath>

#ifndef MK_N_LAUNCHES
#define MK_N_LAUNCHES 16
#endif

constexpr int MP = 32768;
constexpr int MS = 128;
constexpr int MREAL = MP + MS;
constexpr int MR = 33024;
constexpr int DM = 1024, SEQ = 2048, NBATCH = 16;
constexpr int ZC = 1536;
constexpr int LRU_W = 512, NHEAD = 8;
constexpr int QLR = 256, KVLR = 128, ROPE_D = 32, NOPE_D = 64, QKD = 96, VD = 64;
constexpr int DFF = 2816, UPC = 5632;
constexpr int NPAGES = 128, PAGE = 128;
constexpr int MODC = 6144;
constexpr float EPS = 1e-6f;
constexpr float C2 = 0.10206207261596575f * 1.4426950408889634f;

constexpr size_t O_YP = 0, O_YS = 33554432, O_KVP = 33685504, O_KRP = 37879808, O_LHP = 38928384, O_LCP = 38936576, O_FCP = 38961152,
                 O_KVS = 39141376, O_KRS = 39157760, O_LHS = 39161856, O_LCS = 39227392, O_FCS = 39424000, O_END = 40865792;

constexpr size_t MiB = 1u << 20;
constexpr size_t WS_CTL = 0, CTL_ZERO_BYTES = 1 * MiB;
constexpr size_t WS_WIN = 1 * MiB;
constexpr size_t WS_WUQ = 4 * MiB;
constexpr size_t WS_WUKV = 5 * MiB;
constexpr size_t WS_WO = 6 * MiB;
constexpr size_t WS_WUP = 8 * MiB;
constexpr size_t WS_WDN = 20 * MiB;
constexpr size_t WS_WADA = 26 * MiB;
constexpr size_t WS_WG = 38 * MiB;
constexpr size_t WS_SC = 39 * MiB;
constexpr size_t WS_MOD = 40 * MiB;
constexpr size_t WS_ROPE = 44 * MiB;
constexpr size_t WS_SUM = 45 * MiB;
constexpr size_t WS_CARRY = 47 * MiB;
constexpr size_t WS_PART = 48 * MiB;
constexpr size_t WS_H1 = 64 * MiB;
constexpr size_t WS_Z = 130 * MiB;
constexpr size_t WS_QN = 228 * MiB;
constexpr size_t WS_KVN = 246 * MiB;
constexpr size_t WS_KR = 264 * MiB;
constexpr size_t WS_HL = 268 * MiB;
constexpr size_t WS_AC = 302 * MiB;
constexpr size_t WS_QRAW = 336 * MiB;
constexpr size_t WS_KVRAW = 386 * MiB;
constexpr size_t WS_Q = 452 * MiB;
constexpr size_t WS_KF = 502 * MiB;
constexpr size_t WS_V = 552 * MiB;
constexpr size_t WS_ATT = 586 * MiB;
constexpr size_t WS_MIX = 620 * MiB;
constexpr size_t WS_UP = 686 * MiB;
constexpr size_t WS_ACT = 1042 * MiB;
constexpr size_t WS_END = 1221 * MiB;
constexpr int CW_TMO = 0, CW_BAR = 4096;

constexpr int RING_OFF = 0, RING_BYTES = 131072;
constexpr int LDSCTL_OFF = RING_BYTES, MISC_OFF = LDSCTL_OFF + 320;
constexpr int LDS_BYTES = 147456;
constexpr int NWAVES = 8;

namespace pg8 {
#define PG8_LAS __attribute__((address_space(3)))
typedef unsigned short bf16_t;
typedef short bf16x8 __attribute__((ext_vector_type(8)));
typedef float f32x4 __attribute__((ext_vector_type(4)));
typedef unsigned u32x4 __attribute__((ext_vector_type(4)));
constexpr int BM = 256, BK = 64, HALF = 128, HTB = HALF * BK * 2  , STAGE_BYTES = 8 * HTB, NXCD = 8, WGM = 8;

__host__ __device__ __forceinline__ int lds_byte(int r, int c) { const int st = (r >> 4) * 2 + (c >> 5), rr = r & 15, cc = c & 31, ob = rr * 64 + cc * 2; return st * 1024 + (ob ^ (((ob >> 9) & 1) << 5)); }
__host__ __device__ __forceinline__ void stage_rc(int b, int& R, int& C) { const int st = b / 1024, sb = b % 1024, swz = sb ^ (((sb >> 9) & 1) << 5); R = (st >> 1) * 16 + swz / 64; C = (st & 1) * 32 + (swz % 64) / 2; }
__host__ __device__ __forceinline__ int perm32(int rho) { const int n = rho >> 4, i = rho & 15; return 8 * (i >> 2) + 4 * n + (i & 3); }

struct Unit { int pm, pn; };
struct Gemm { const bf16_t* A; const bf16_t* Bt; int M, N, K; };

struct StaticOrder {
    int nM, nN, nwg, G, c;
    __host__ __device__ void init(int M, int N, int G_, int c_) { nM = M / BM; nN = N / BM; nwg = nM * nN; G = G_; c = c_; }
    __host__ __device__ bool next(int i, Unit& u) const {
        const long L = (long)i * G + c; if (L >= nwg) return false;
        int wgid = (int)L; { const int q = nwg / NXCD, r = nwg % NXCD, xcd = wgid % NXCD, off = wgid / NXCD; wgid = (xcd < r ? xcd * (q + 1) : r * (q + 1) + (xcd - r) * q) + off; }
        const int nig = WGM * nN, gid = wgid / nig, fm = gid * WGM, gsz = (nM - fm) < WGM ? (nM - fm) : WGM;
        u.pm = fm + ((wgid % nig) % gsz); u.pn = (wgid % nig) / gsz; return true;
    }
    __device__ __forceinline__ void a_ready(const Unit&) const {}
    __device__ __forceinline__ void done(const Unit&) const {}
};

__device__ __forceinline__ unsigned cvt_pk_bf16(float lo, float hi) { unsigned r; asm volatile("v_cvt_pk_bf16_f32 %0, %1, %2" : "=v"(r) : "v"(lo), "v"(hi)); return r; }
typedef float f32x2 __attribute__((ext_vector_type(2)));
__device__ __forceinline__ f32x2 gelu_pk(f32x2 v) {
    const f32x2 av = __builtin_elementwise_abs(v), d = av * 0.2316418882f + 1.0f;
    f32x2 t; t.x = __builtin_amdgcn_rcpf(d.x); t.y = __builtin_amdgcn_rcpf(d.y);
    f32x2 q = t * 0.5307027145f + (-0.7265760135f); q = q * t + 0.7107068705f; q = q * t + (-0.142248368f); q = q * t + 0.127414796f; q = q * t;
    const f32x2 s = (v * v) * (-0.72134752044f);
    f32x2 e; e.x = __builtin_amdgcn_exp2f(s.x); e.y = __builtin_amdgcn_exp2f(s.y);
    const f32x2 m = v * (q * e), r = v - m;
    f32x2 o; o.x = v.x < 0.f ? m.x : r.x; o.y = v.y < 0.f ? m.y : r.y; return o;
}

template <int ACT  > struct EpiBf16 {
    static constexpr bool PERM = true, AFTER_DRAIN = false; static_assert(ACT == 0 || ACT == 1, "EpiBf16: ACT is 0 (none) or 1 (gelu_pk)");
    bf16_t* O; int ldc; const float* bias; int split_cols; size_t split_stride; float scale0;
    __device__ __forceinline__ void operator()(const f32x4 (&acc)[2][2][4][2], const Unit& u, int wr, int wc, int fr, int fq) const {
        const int row0 = u.pm * BM + wr * 64 + fr; int colt = u.pn * BM; bf16_t* base = O;
        float sc = 1.f; if (split_cols) { const int t = colt / split_cols; base += (size_t)t * split_stride; colt -= t * split_cols; if (t == 0) sc = scale0; }
        const int col0 = colt + wc * 32 + 8 * fq, bcol0 = u.pn * BM + wc * 32 + 8 * fq;
        f32x4 bv[2][2];
#pragma unroll
        for (int bj = 0; bj < 2; ++bj)
#pragma unroll
            for (int n = 0; n < 2; ++n) bv[bj][n] = bias ? *(const f32x4*)(bias + bcol0 + bj * HALF + 4 * n) : (f32x4){0.f, 0.f, 0.f, 0.f};
#pragma unroll
        for (int ai = 0; ai < 2; ++ai)
#pragma unroll
            for (int m = 0; m < 4; ++m) { bf16_t* rowp = base + (size_t)(row0 + ai * HALF + m * 16) * ldc + col0;
#pragma unroll
                for (int bj = 0; bj < 2; ++bj) { f32x4 v0 = acc[ai][bj][m][0] + bv[bj][0], v1 = acc[ai][bj][m][1] + bv[bj][1];
                    if (ACT == 1) { f32x2 a = gelu_pk((f32x2){v0[0], v0[1]}), b = gelu_pk((f32x2){v0[2], v0[3]}), c = gelu_pk((f32x2){v1[0], v1[1]}), d = gelu_pk((f32x2){v1[2], v1[3]});
                        v0 = (f32x4){a.x, a.y, b.x, b.y}; v1 = (f32x4){c.x, c.y, d.x, d.y}; }
                    v0 = v0 * sc; v1 = v1 * sc; u32x4 w; w.x = cvt_pk_bf16(v0[0], v0[1]); w.y = cvt_pk_bf16(v0[2], v0[3]); w.z = cvt_pk_bf16(v1[0], v1[1]); w.w = cvt_pk_bf16(v1[2], v1[3]);
                    *(u32x4*)(rowp + bj * HALF) = w; } }
    }
};

struct EpiResGate {
    static constexpr bool PERM = false, AFTER_DRAIN = false;
    const float* basep; const float* bases; float* out; const float* mod; int goff;
    __device__ __forceinline__ void operator()(const f32x4 (&acc)[2][2][4][2], const Unit& u, int wr, int wc, int fr, int fq) const {
        const int col0 = u.pn * BM + wc * 32 + 4 * fq;
#pragma unroll
        for (int ai = 0; ai < 2; ++ai)
#pragma unroll
            for (int m = 0; m < 4; ++m) {
                const int row = u.pm * BM + ai * HALF + wr * 64 + m * 16 + fr;
                if (row < 32896) {
                    const float* bp = (row < 32768) ? basep + (size_t)row * 1024 : bases + (size_t)(row - 32768) * 1024;
                    const float* gp = mod + (size_t)((row < 32768) ? (row >> 11) : (16 + row - 32768)) * 6144 + goff;
                    float* op = out + (size_t)row * 1024;
#pragma unroll
                    for (int bj = 0; bj < 2; ++bj)
#pragma unroll
                        for (int n = 0; n < 2; ++n) { const int c = col0 + bj * HALF + n * 16;
                            const f32x4 bs = *(const f32x4*)(bp + c), gt = *(const f32x4*)(gp + c);
                            *(f32x4*)(op + c) = bs + gt * acc[ai][bj][m][n]; }
                }
            }
    }
};

template <class Epi, class Sched, bool ALIGN_EPI = false, bool SP2 = false>
__device__ __forceinline__ void gemm_phase(PG8_LAS unsigned char* lds, const Gemm g, const Sched& S, const Epi& E) {
    const int tid = threadIdx.x, wid = __builtin_amdgcn_readfirstlane(tid >> 6), lane = tid & 63, wr = wid >> 2, wc = wid & 3, fr = lane & 15, fq = lane >> 4;
    const int K = g.K, nt = K / BK;
    unsigned voffA[2], voffB[2];
#pragma unroll
    for (int i = 0; i < 2; ++i) { int R, C; stage_rc(tid * 16 + i * 8192, R, C); const int Rb = Epi::PERM ? ((R & ~31) + perm32(R & 31)) : R;
        voffA[i] = (unsigned)(R * K + C) * 2u; voffB[i] = (unsigned)(Rb * K + C) * 2u; }
    const size_t kstep = (size_t)(BK * 2);
    const size_t hstep = (size_t)HALF * K * 2;
    const size_t tstep = 2 * hstep;
    const unsigned ldsw = (unsigned)wid * 1024u;
    const int aoff = lds_byte(wr * 64 + fr, fq * 8), boff = lds_byte(wc * 32 + fr, fq * 8);
#define PG8_SA(b, h) (((b) * 2 + (h)) * HTB)
#define PG8_SB(b, h) ((4 + (b) * 2 + (h)) * HTB)
#define PG8_STAGE(bufoff, gbase, voff) do { _Pragma("unroll") for (int _i = 0; _i < 2; ++_i) \
        __builtin_amdgcn_global_load_lds((const unsigned*)((const char*)(gbase) + (voff)[_i]), (PG8_LAS unsigned*)(lds + (bufoff) + ldsw + _i * 8192), 16, 0, 0); } while (0)
#define PG8_LDA(dst, b, h) do { _Pragma("unroll") for (int m = 0; m < 4; ++m) _Pragma("unroll") for (int k = 0; k < 2; ++k) dst[m][k] = *(const PG8_LAS bf16x8*)(lds + PG8_SA(b, h) + aoff + m * 2048 + k * 1024); } while (0)
#define PG8_LDB(dst, b, h) do { _Pragma("unroll") for (int n = 0; n < 2; ++n) _Pragma("unroll") for (int k = 0; k < 2; ++k) dst[n][k] = *(const PG8_LAS bf16x8*)(lds + PG8_SB(b, h) + boff + n * 2048 + k * 1024); } while (0)
#define PG8_MMA(ai, bj, At, Bt) do { __builtin_amdgcn_s_setprio(1); _Pragma("unroll") for (int m = 0; m < 4; ++m) _Pragma("unroll") for (int n = 0; n < 2; ++n) _Pragma("unroll") for (int k = 0; k < 2; ++k) \
        acc[ai][bj][m][n] = __builtin_amdgcn_mfma_f32_16x16x32_bf16(Bt[n][k], At[m][k], acc[ai][bj][m][n], 0, 0, 0); __builtin_amdgcn_s_setprio(0); } while (0)
#define PG8_WAIT_V(n) asm volatile("s_waitcnt vmcnt(" #n ")" ::: "memory")
#define PG8_WAIT_L(n) asm volatile("s_waitcnt lgkmcnt(" #n ")" ::: "memory")
#define PG8_BAR __builtin_amdgcn_s_barrier()
#define PG8_SCHED __builtin_amdgcn_sched_barrier(0)
    Unit cur, nxt; int ui = 0;
    if (!S.next(0, cur)) return;
    f32x4 acc[2][2][4][2];
#pragma unroll
    for (int a = 0; a < 2; ++a)
#pragma unroll
        for (int b = 0; b < 2; ++b)
#pragma unroll
            for (int m = 0; m < 4; ++m)
#pragma unroll
                for (int n = 0; n < 2; ++n) acc[a][b][m][n] = (f32x4){0.f, 0.f, 0.f, 0.f};
    bf16x8 At[4][2], B0[2][2], B1[2][2];
    const char* cA = (const char*)g.A + (size_t)cur.pm * tstep; const char* cB = (const char*)g.Bt + (size_t)cur.pn * tstep;
    S.a_ready(cur);
    if constexpr (SP2) {
        PG8_STAGE(PG8_SB(0, 0), cB, voffB); PG8_STAGE(PG8_SB(0, 1), cB + hstep, voffB); PG8_STAGE(PG8_SA(0, 0), cA, voffA); PG8_STAGE(PG8_SA(0, 1), cA + hstep, voffA);
        if (wr == 1) PG8_BAR;
        PG8_WAIT_V(2); PG8_BAR;
        PG8_STAGE(PG8_SB(1, 0), cB + kstep, voffB); PG8_STAGE(PG8_SA(1, 0), cA + kstep, voffA); PG8_STAGE(PG8_SB(1, 1), cB + hstep + kstep, voffB);
        PG8_WAIT_V(6); PG8_BAR;
    } else {
        PG8_STAGE(PG8_SB(0, 0), cB, voffB); PG8_STAGE(PG8_SA(0, 0), cA, voffA); PG8_STAGE(PG8_SB(0, 1), cB + hstep, voffB); PG8_STAGE(PG8_SA(0, 1), cA + hstep, voffA);
        if (wr == 1) PG8_BAR;
        PG8_WAIT_V(4); PG8_BAR;
        PG8_STAGE(PG8_SB(1, 0), cB + kstep, voffB); PG8_STAGE(PG8_SA(1, 0), cA + kstep, voffA); PG8_STAGE(PG8_SB(1, 1), cB + hstep + kstep, voffB);
        PG8_WAIT_V(6); PG8_BAR;
    }
    for (;;) {
        const bool has_next = S.next(ui + 1, nxt);
        const char* nA = has_next ? (const char*)g.A + (size_t)nxt.pm * tstep : cA; const char* nB = has_next ? (const char*)g.Bt + (size_t)nxt.pn * tstep : cB;
        for (int t = 0; t < nt; t += 2) {
            const bool last = (t == nt - 2);
            const char* a1 = cA + (size_t)(t + 1) * kstep;
            const char* a2 = last ? nA : cA + (size_t)(t + 2) * kstep; const char* b2 = last ? nB : cB + (size_t)(t + 2) * kstep;
            const char* a3 = a2 + kstep; const char* b3 = b2 + kstep;
            if (last && has_next) S.a_ready(nxt);
            if constexpr (SP2) {
            PG8_LDB(B0, 0, 0); PG8_LDB(B1, 0, 1); PG8_SCHED; PG8_LDA(At, 0, 0); PG8_STAGE(PG8_SA(1, 1), a1 + hstep, voffA);
            PG8_WAIT_V(8); PG8_WAIT_L(0); PG8_BAR; PG8_MMA(0, 0, At, B0); PG8_MMA(0, 1, At, B1); PG8_BAR; PG8_SCHED;
            PG8_LDA(At, 0, 1); PG8_STAGE(PG8_SB(0, 0), b2, voffB); PG8_STAGE(PG8_SB(0, 1), b2 + hstep, voffB); PG8_STAGE(PG8_SA(0, 0), a2, voffA);
            PG8_WAIT_V(8); PG8_WAIT_L(0); PG8_BAR; PG8_MMA(1, 0, At, B0); PG8_MMA(1, 1, At, B1); PG8_BAR; PG8_SCHED;
            PG8_LDB(B0, 1, 0); PG8_LDB(B1, 1, 1); PG8_SCHED; PG8_LDA(At, 1, 0); PG8_STAGE(PG8_SA(0, 1), a2 + hstep, voffA);
            PG8_WAIT_V(8); PG8_WAIT_L(0); PG8_BAR; PG8_MMA(0, 0, At, B0); PG8_MMA(0, 1, At, B1); PG8_BAR; PG8_SCHED;
            PG8_LDA(At, 1, 1); PG8_STAGE(PG8_SB(1, 0), b3, voffB); PG8_STAGE(PG8_SB(1, 1), b3 + hstep, voffB); PG8_STAGE(PG8_SA(1, 0), a3, voffA);
            PG8_WAIT_V(8); PG8_WAIT_L(0); PG8_BAR; PG8_MMA(1, 0, At, B0); PG8_MMA(1, 1, At, B1); PG8_BAR; PG8_SCHED;
            } else {
            PG8_LDB(B0, 0, 0); PG8_SCHED; PG8_LDA(At, 0, 0); PG8_STAGE(PG8_SA(1, 1), a1 + hstep, voffA);
            PG8_WAIT_L(8); PG8_BAR; PG8_WAIT_L(0); PG8_MMA(0, 0, At, B0); PG8_BAR; PG8_SCHED;
            PG8_LDB(B1, 0, 1); PG8_STAGE(PG8_SB(0, 0), b2, voffB);
            PG8_BAR; PG8_WAIT_L(0); PG8_MMA(0, 1, At, B1); PG8_BAR;
            PG8_LDA(At, 0, 1); PG8_STAGE(PG8_SA(0, 0), a2, voffA);
            PG8_BAR; PG8_WAIT_L(0); PG8_MMA(1, 0, At, B0); PG8_BAR; PG8_SCHED;
            PG8_STAGE(PG8_SB(0, 1), b2 + hstep, voffB);
            PG8_WAIT_V(6); PG8_BAR; PG8_MMA(1, 1, At, B1); PG8_BAR;
            PG8_LDB(B0, 1, 0); PG8_SCHED; PG8_LDA(At, 1, 0); PG8_STAGE(PG8_SA(0, 1), a2 + hstep, voffA);
            PG8_WAIT_L(8); PG8_BAR; PG8_WAIT_L(0); PG8_MMA(0, 0, At, B0); PG8_BAR; PG8_SCHED;
            PG8_LDB(B1, 1, 1); PG8_STAGE(PG8_SB(1, 0), b3, voffB);
            PG8_BAR; PG8_WAIT_L(0); PG8_MMA(0, 1, At, B1); PG8_BAR;
            PG8_LDA(At, 1, 1); PG8_STAGE(PG8_SA(1, 0), a3, voffA);
            PG8_BAR; PG8_WAIT_L(0); PG8_MMA(1, 0, At, B0); PG8_BAR; PG8_SCHED;
            PG8_STAGE(PG8_SB(1, 1), b3 + hstep, voffB);
            PG8_WAIT_V(6); PG8_BAR; PG8_MMA(1, 1, At, B1); PG8_BAR;
            }
        }
        if constexpr (ALIGN_EPI) { if (wr == 0) PG8_BAR; }
        if constexpr (!Epi::AFTER_DRAIN) { E(acc, cur, wr, wc, fr, fq); S.done(cur); }
        if (!has_next) break;
#pragma unroll
        for (int a = 0; a < 2; ++a)
#pragma unroll
            for (int b = 0; b < 2; ++b)
#pragma unroll
                for (int m = 0; m < 4; ++m)
#pragma unroll
                    for (int n = 0; n < 2; ++n) acc[a][b][m][n] = (f32x4){0.f, 0.f, 0.f, 0.f};
        cur = nxt; cA = nA; cB = nB; ++ui;
        if constexpr (ALIGN_EPI) { if (wr == 1) PG8_BAR; }
    }
    PG8_WAIT_V(0);
    if constexpr (!ALIGN_EPI) { if (wr == 0) PG8_BAR; }
    PG8_BAR;
    if constexpr (Epi::AFTER_DRAIN) { E.fused(acc, cur, wr, wc, fr, fq, lds, wid, lane); S.done(cur); }
#undef PG8_SA
#undef PG8_SB
#undef PG8_STAGE
#undef PG8_LDA
#undef PG8_LDB
#undef PG8_MMA
#undef PG8_WAIT_V
#undef PG8_WAIT_L
#undef PG8_BAR
#undef PG8_SCHED
}
}
#define GAS __attribute__((address_space(1)))
#define LAS __attribute__((address_space(3)))
typedef unsigned short bf16;
typedef unsigned v4u __attribute__((ext_vector_type(4)));
typedef float f32x4 __attribute__((ext_vector_type(4)));
typedef short bf16x8 __attribute__((ext_vector_type(8)));
typedef GAS unsigned gu32;
typedef GAS unsigned long long gu64;
#define RLX_AGENT __ATOMIC_RELAXED, __HIP_MEMORY_SCOPE_AGENT
#define LDS_WAIT() asm volatile("s_waitcnt lgkmcnt(0)" ::: "memory")
#define VM_WAIT() asm volatile("s_waitcnt vmcnt(0)" ::: "memory")
__device__ __forceinline__ unsigned long long rt() { return __builtin_amdgcn_s_memrealtime(); }
__device__ __forceinline__ unsigned f2bf(float f) { unsigned u = __builtin_bit_cast(unsigned, f); return (u + 0x7fffu + ((u >> 16) & 1u)) >> 16; }
__device__ __forceinline__ unsigned pk2(float lo, float hi) { return f2bf(lo) | (f2bf(hi) << 16); }
#define XB_TMO      128
#define XB_XCNT(j)  (256  + 64 * (j))
#define XB_XSUB(j)  (1280 + 64 * (j))
#define XB_XGEN(j)  (2304 + 64 * (j))
#define XB_TOP      3328
#define XB_TOPGEN   3392
#define XCD_BAR_WORDS 3456
#define XB_SPIN_CAP (1u << 18)

__device__ __forceinline__ unsigned xb_ld(unsigned* p)              { return __hip_atomic_load(p, __ATOMIC_RELAXED, __HIP_MEMORY_SCOPE_AGENT); }
__device__ __forceinline__ unsigned xb_add(unsigned* p, unsigned v) { return __hip_atomic_fetch_add(p, v, __ATOMIC_RELAXED, __HIP_MEMORY_SCOPE_AGENT); }
__device__ __forceinline__ unsigned xb_xcc_id() { return (unsigned)__builtin_amdgcn_s_getreg((3 << 11) | 20) & 0xFu; }
#define XB_SPIN(cond, bar) do { unsigned _sp = 0; while (cond) { __builtin_amdgcn_s_sleep(1); \
    if ((++_sp & 255u) == 0u) { if (xb_ld(&(bar)[XB_TMO])) break; if (_sp > XB_SPIN_CAP) { atomicAdd(&(bar)[XB_TMO], 1u); break; } } } } while (0)

struct XcdBarrier {
    unsigned* bar; unsigned x;
    volatile LAS unsigned* st;
};

__device__ __forceinline__ XcdBarrier xcd_barrier_post(unsigned* bar, volatile LAS unsigned* st) {
    XcdBarrier b; b.bar = bar; b.x = xb_xcc_id(); b.st = st;
    if (threadIdx.x == 0) (void)xb_add(&bar[XB_XCNT(b.x)], 1u);
    return b;
}
__device__ __forceinline__ void xcd_barrier_complete(unsigned* bar, unsigned x, unsigned& nloc, unsigned& nx) {
    const unsigned G = gridDim.x * gridDim.y * gridDim.z;
    unsigned sum, cnt, mine, sp = 0u;
    for (;;) {
        sum = 0u; cnt = 0u; mine = 0u;
#pragma unroll
        for (unsigned j = 0; j < 16; ++j) { const unsigned c = xb_ld(&bar[XB_XCNT(j)]); sum += c; cnt += (c > 0u) ? 1u : 0u; mine = (j == x) ? c : mine; }
        if (sum == G) break;
        __builtin_amdgcn_s_sleep(1);
        if ((++sp & 255u) == 0u) { if (xb_ld(&bar[XB_TMO])) break; if (sp > XB_SPIN_CAP) { atomicAdd(&bar[XB_TMO], 1u); break; } }
    }
    nloc = mine > 0u ? mine : 1u; nx = cnt > 0u ? cnt : 1u;
}

__device__ __forceinline__ void xcd_barrier(const XcdBarrier& b) {
    asm volatile("s_waitcnt vmcnt(0)" ::: "memory");
    __syncthreads();
    if (threadIdx.x == 0) {
        unsigned* bar = b.bar;
        __builtin_amdgcn_s_waitcnt(0);
        unsigned nloc = b.st[0], nx = b.st[1];
        if (nloc == 0u) { xcd_barrier_complete(bar, b.x, nloc, nx); b.st[0] = nloc; b.st[1] = nx; }
        const unsigned old = xb_add(&bar[XB_XSUB(b.x)], 1u);
        const unsigned gen = old / nloc;
        if (old + 1u == (gen + 1u) * nloc) {
            __builtin_amdgcn_fence(__ATOMIC_RELEASE, "agent");
            asm volatile("s_waitcnt vmcnt(0)" ::: "memory");
            const unsigned og = xb_add(&bar[XB_TOP], 1u);
            const unsigned tg = og / nx;
            if (og + 1u == (tg + 1u) * nx) xb_add(&bar[XB_TOPGEN], 1u);
            else XB_SPIN(xb_ld(&bar[XB_TOPGEN]) == tg, bar);
            __builtin_amdgcn_fence(__ATOMIC_ACQUIRE, "agent");
            xb_add(&bar[XB_XGEN(b.x)], 1u);
            asm volatile("s_waitcnt vmcnt(0)" ::: "memory");
        } else {
            XB_SPIN(xb_ld(&bar[XB_XGEN(b.x)]) == gen, bar);
            __builtin_amdgcn_fence(__ATOMIC_ACQUIRE, "agent");
            asm volatile("s_waitcnt vmcnt(0)" ::: "memory");
        }
    }
    __syncthreads();
}

typedef float f32x16 __attribute__((ext_vector_type(16)));
typedef float f32x2 __attribute__((ext_vector_type(2)));
typedef unsigned v2u __attribute__((ext_vector_type(2)));
typedef short s16x4 __attribute__((ext_vector_type(4)));

struct Params { const float* in[37]; float* out; unsigned char* ws; int ph_lo, ph_hi; };

__device__ __forceinline__ float bf2f(unsigned short b) { return __uint_as_float(((unsigned)b) << 16); }
__device__ __forceinline__ float bflo(unsigned w) { return __uint_as_float(w << 16); }
__device__ __forceinline__ float bfhi(unsigned w) { return __uint_as_float(w & 0xffff0000u); }
__device__ __forceinline__ float wave_sum(float v) {
#pragma unroll
    for (int o = 1; o < 64; o <<= 1) v += __shfl_xor(v, o);
    return v;
}
__device__ __forceinline__ float wave_max(float v) {
#pragma unroll
    for (int o = 1; o < 64; o <<= 1) v = fmaxf(v, __shfl_xor(v, o));
    return v;
}
__device__ __forceinline__ float gelu_tanh(float x) {
    const float u = 0.7978845608028654f * (x + 0.044715f * x * x * x);
    return x / (1.0f + __expf(-2.0f * u));
}
__device__ __forceinline__ float sigmoidf_(float x) { return 1.0f / (1.0f + __expf(-x)); }
__device__ __forceinline__ f32x16 mfma32(bf16x8 a, bf16x8 b, f32x16 c) { return __builtin_amdgcn_mfma_f32_32x32x16_bf16(a, b, c, 0, 0, 0); }
__device__ __forceinline__ f32x4 mfma16(bf16x8 a, bf16x8 b, f32x4 c) { return __builtin_amdgcn_mfma_f32_16x16x32_bf16(a, b, c, 0, 0, 0); }
__device__ __forceinline__ int crow(int r, int hi) { return (r & 3) + 8 * (r >> 2) + 4 * hi; }
__device__ __forceinline__ bf16x8 pack8(const float* v) { v4u w; w.x = pk2(v[0], v[1]); w.y = pk2(v[2], v[3]); w.z = pk2(v[4], v[5]); w.w = pk2(v[6], v[7]); return __builtin_bit_cast(bf16x8, w); }
__device__ __forceinline__ float xhalf_sum(float v) { return v + __shfl_xor(v, 32); }

struct Ctx {
    LAS unsigned char* lds; int tid, lane, wave, G, bid;
    const Params* p;
};
#define WSP(T, off) ((T*)(P.ws + (off)))

__device__ __forceinline__ void p0_transpose_item(const float* W, int N, bf16* WT, int ldk, LAS float* scr, int nblk, int item, int lane) {
    const int kb = item / nblk, nb = item % nblk, k0 = 64 * kb, n0 = 32 * nb;
#pragma unroll 8
    for (int i = 0; i < 32; ++i) { const int kk = 2 * i + (lane >> 5); scr[kk * 33 + (lane & 31)] = W[(size_t)(k0 + kk) * N + n0 + (lane & 31)]; }
    LDS_WAIT(); asm volatile("" ::: "memory");
    const int c = lane & 7;
#pragma unroll
    for (int j = 0; j < 4; ++j) { const int n = (lane >> 3) + 8 * j; const LAS float* s = scr + (8 * c) * 33 + n;
        v4u o; o.x = pk2(s[0 * 33], s[1 * 33]); o.y = pk2(s[2 * 33], s[3 * 33]); o.z = pk2(s[4 * 33], s[5 * 33]); o.w = pk2(s[6 * 33], s[7 * 33]);
        *(GAS v4u*)(WT + (size_t)(n0 + n) * ldk + k0 + 8 * c) = o; }
    LDS_WAIT(); asm volatile("" ::: "memory");
}
__device__ __forceinline__ void phase_p0a(const Ctx& C, const Params& P) {
    LAS float* scr = (LAS float*)(C.lds + RING_OFF + C.wave * 16384);
    const int gw = C.bid * NWAVES + C.wave, NGW = C.G * NWAVES, lane = C.lane;
    constexpr int I_IN = 16 * 45, I_UQ = 4 * 24, I_UKV = 2 * 32, I_O = 16 * 32, I_UP = 16 * 176, I_DN = 44 * 32, I_ADA = 16 * 192, I_G = 32;
    constexpr int NITEMS = I_IN + I_UQ + I_UKV + I_O + I_UP + I_DN + I_ADA + I_G;
    for (int it = gw; it < NITEMS; it += NGW) {
        int r = it;
        if (r < I_UP) { p0_transpose_item(P.in[33], UPC, WSP(bf16, WS_WUP), 1024, scr, 176, r, lane); continue; } r -= I_UP;
        if (r < I_ADA) { p0_transpose_item(P.in[10], MODC, WSP(bf16, WS_WADA), 1024, scr, 192, r, lane); continue; } r -= I_ADA;
        if (r < I_DN) { p0_transpose_item(P.in[36], DM, WSP(bf16, WS_WDN), DFF, scr, 32, r, lane); continue; } r -= I_DN;
        if (r < I_IN) { p0_transpose_item(P.in[13], 1440, WSP(bf16, WS_WIN), 1024, scr, 45, r, lane); continue; } r -= I_IN;
        if (r < I_O) { p0_transpose_item(P.in[31], DM, WSP(bf16, WS_WO), 1024, scr, 32, r, lane); continue; } r -= I_O;
        if (r < I_UQ) { p0_transpose_item(P.in[22], 768, WSP(bf16, WS_WUQ), 256, scr, 24, r, lane); continue; } r -= I_UQ;
        if (r < I_UKV) { p0_transpose_item(P.in[27], 1024, WSP(bf16, WS_WUKV), 256, scr, 32, r, lane); continue; } r -= I_UKV;
        { const int hg = r >> 1, sub = r & 1, h = hg >> 1, gate = hg & 1;
          p0_transpose_item(P.in[gate ? 18 : 16] + (size_t)h * 4096, 64, WSP(bf16, WS_WG) + (size_t)(h * 2 + gate) * 4096, 64, scr, 2, sub, lane); }
    }
    const int gt = C.bid * 512 + C.tid, NGT = C.G * 512;
    { bf16* w = WSP(bf16, WS_WIN) + (size_t)1440 * 1024; for (int i = gt; i < 96 * 1024 / 8; i += NGT) ((v4u*)w)[i] = (v4u){0u, 0u, 0u, 0u}; }
    { bf16* w = WSP(bf16, WS_WUKV); for (int i = gt; i < 1024 * 16; i += NGT) { const int n = i >> 4, c = i & 15; *(v4u*)(w + (size_t)n * 256 + 128 + c * 8) = (v4u){0u, 0u, 0u, 0u}; } }
    { bf16* sc = WSP(bf16, WS_SC);
      for (int i = gt; i < 256 * 1024 / 4; i += NGT) { const int r = i >> 8, c4 = (i & 255) * 4; v2u o = (v2u){0u, 0u};
          if (r < 144) { const float* src = (r < 16) ? P.in[8] + (size_t)r * 1024 : P.in[9] + (size_t)(r - 16) * 1024; const f32x4 v = *(const f32x4*)(src + c4);
              o.x = pk2(v.x * sigmoidf_(v.x), v.y * sigmoidf_(v.y)); o.y = pk2(v.z * sigmoidf_(v.z), v.w * sigmoidf_(v.w)); }
          *(v2u*)(sc + (size_t)r * 1024 + c4) = o; } }
    { float* rt = WSP(float, WS_ROPE);
      for (int i = gt; i < 2049 * 16; i += NGT) { const int pi = i >> 4, k = i & 15; const float pos = (pi == 2048) ? 16384.0f : (float)pi;
          const float inv = powf(10000.0f, -(float)(2 * k) / 32.0f); const float ang = pos * inv; rt[2 * i] = cosf(ang); rt[2 * i + 1] = sinf(ang); } }
}

template <class Epi> __device__ __forceinline__ void skinny_gemm(const Ctx& C, const bf16* A, int lda, const bf16* Bt, int ldb, int MT, int NT, int K, const Epi& E) {
    const int gw = C.bid * NWAVES + C.wave, NGW = C.G * NWAVES, lane = C.lane;
    for (int wu = gw; wu < MT * NT; wu += NGW) {
        const int mt = wu % MT, nt = wu / MT;
        const bf16* ap = A + (size_t)(mt * 16 + (lane & 15)) * lda + 8 * (lane >> 4);
        const bf16* bp = Bt + (size_t)(nt * 16 + (lane & 15)) * ldb + 8 * (lane >> 4);
        f32x4 acc = (f32x4){0.f, 0.f, 0.f, 0.f};
#pragma unroll 8
        for (int k = 0; k < K; k += 32) { const bf16x8 a = *(const bf16x8*)(ap + k), b = *(const bf16x8*)(bp + k); acc = mfma16(a, b, acc); }
        E(acc, mt, nt, lane);
    }
}
struct EpiMod { float* mod; const float* bias;
    __device__ __forceinline__ void operator()(const f32x4& acc, int mt, int nt, int lane) const {
        const int col = nt * 16 + (lane & 15); const float b = bias[col];
#pragma unroll
        for (int i = 0; i < 4; ++i) { const int row = mt * 16 + 4 * (lane >> 4) + i; if (row < 144) mod[(size_t)row * MODC + col] = acc[i] + b; }
    } };
__device__ __forceinline__ void phase_p0b(const Ctx& C, const Params& P) {
    EpiMod E{WSP(float, WS_MOD), P.in[11]};
    skinny_gemm(C, WSP(bf16, WS_SC), 1024, WSP(bf16, WS_WADA), 1024, 9, MODC / 16, 1024, E);
}

__device__ __forceinline__ const float* mod_row(const Params& P, int r) { return WSP(const float, WS_MOD) + (size_t)((r < MP) ? (r >> 11) : (16 + r - MP)) * MODC; }
template <bool SECOND> __device__ __forceinline__ void phase_norm_mod(const Ctx& C, const Params& P) {
    const int gw = C.bid * NWAVES + C.wave, NGW = C.G * NWAVES, lane = C.lane;
    const float* g = P.in[SECOND ? 32 : 12]; bf16* H = WSP(bf16, WS_H1);
    constexpr int SH = SECOND ? 3072 : 0, SC = SECOND ? 4096 : 1024;
    for (int r = gw; r < MR; r += NGW) {
        GAS unsigned long long* o8 = (GAS unsigned long long*)(H + (size_t)r * 1024) + lane;
        if (r >= MREAL) {
#pragma unroll
            for (int j = 0; j < 4; ++j) o8[64 * j] = 0ull;
            continue; }
        const float* xr = SECOND ? (P.out + (size_t)r * 1024) : ((r < MP) ? P.in[0] + (size_t)r * 1024 : P.in[1] + (size_t)(r - MP) * 1024);
        const float* md = mod_row(P, r);
        f32x4 v[4]; float s = 0.f;
#pragma unroll
        for (int j = 0; j < 4; ++j) { v[j] = *((const f32x4*)xr + lane + 64 * j); s += (v[j].x * v[j].x + v[j].y * v[j].y) + (v[j].z * v[j].z + v[j].w * v[j].w); }
        const float rstd = rsqrtf(wave_sum(s) * (1.f / 1024.f) + EPS);
#pragma unroll
        for (int j = 0; j < 4; ++j) { const int c = 4 * (lane + 64 * j);
            const f32x4 gg = *(const f32x4*)(g + c), sc = *(const f32x4*)(md + SC + c), sh = *(const f32x4*)(md + SH + c);
            const f32x4 h = v[j] * rstd * gg * (sc + 1.0f) + sh;
            o8[64 * j] = (unsigned long long)pk2(h.x, h.y) | ((unsigned long long)pk2(h.z, h.w) << 32); }
    }
}

__device__ __forceinline__ void phase_p3a(const Ctx& C, const Params& P) {
    const int gw = C.bid * NWAVES + C.wave, NGW = C.G * NWAVES, lane = C.lane;
    const bf16* Z = WSP(const bf16, WS_Z); bf16* QN = WSP(bf16, WS_QN); bf16* KVN = WSP(bf16, WS_KVN); bf16* KR = WSP(bf16, WS_KR);
    const float* gq = P.in[21]; const float* gkv = P.in[25]; const float* gkr = P.in[26]; const float* rope = WSP(const float, WS_ROPE);
    for (int r = gw; r < MREAL; r += NGW) {
        const bf16* z = Z + (size_t)r * ZC;
        const bool smp = r >= MP; const int s_ = r - MP, b = r >> 11, t = r & 2047;
        { const v2u w = *(const v2u*)(z + 1024 + 4 * lane); const float a0 = bflo(w.x), a1 = bfhi(w.x), a2 = bflo(w.y), a3 = bfhi(w.y);
          const float rstd = rsqrtf(wave_sum(a0 * a0 + a1 * a1 + a2 * a2 + a3 * a3) * (1.f / 256.f) + EPS); const f32x4 g = *(const f32x4*)(gq + 4 * lane);
          v2u o; o.x = pk2(a0 * rstd * g.x, a1 * rstd * g.y); o.y = pk2(a2 * rstd * g.z, a3 * rstd * g.w); *(v2u*)(QN + (size_t)r * 256 + 4 * lane) = o; }
        { const unsigned w = *(const unsigned*)(z + 1280 + 2 * lane); const float a0 = bflo(w), a1 = bfhi(w);
          const float rstd = rsqrtf(wave_sum(a0 * a0 + a1 * a1) * (1.f / 128.f) + EPS); const f32x2 g = *(const f32x2*)(gkv + 2 * lane);
          const float o0 = a0 * rstd * g.x, o1 = a1 * rstd * g.y;
          float* dst = P.out + (smp ? O_KVS + (size_t)s_ * 128 : O_KVP + (size_t)r * 128); *(f32x2*)(dst + 2 * lane) = (f32x2){o0, o1};
          *(unsigned*)(KVN + (size_t)r * 256 + 2 * lane) = pk2(o0, o1); *(unsigned*)(KVN + (size_t)r * 256 + 128 + 2 * lane) = 0u; }
        { const float a = (lane < 32) ? bf2f(z[1408 + lane]) : 0.f; const float rstd = rsqrtf(wave_sum(a * a) * (1.f / 32.f) + EPS);
          const float v = a * rstd * gkr[lane & 31]; const float pr = __shfl_xor(v, 16);
          const f32x2 cs = *(const f32x2*)(rope + ((size_t)(smp ? 2048 : t) * 16 + (lane & 15)) * 2);
          const float o = (lane & 16) ? (v * cs.x + pr * cs.y) : (v * cs.x - pr * cs.y);
          if (lane < 32) { float* dst = P.out + (smp ? O_KRS + (size_t)s_ * 32 : O_KRP + (size_t)r * 32); dst[lane] = o; KR[(size_t)r * 32 + lane] = (bf16)f2bf(o); } }
        if (smp) { const v4u w = *(const v4u*)(z + 8 * lane); float* d2 = P.out + O_LCS + (size_t)s_ * 1536; const float* st = P.in[5] + (size_t)s_ * 1536;
            *(f32x4*)(d2 + 8 * lane) = *(const f32x4*)(st + 512 + 8 * lane); *(f32x4*)(d2 + 8 * lane + 4) = *(const f32x4*)(st + 512 + 8 * lane + 4);
            *(f32x4*)(d2 + 512 + 8 * lane) = *(const f32x4*)(st + 1024 + 8 * lane); *(f32x4*)(d2 + 512 + 8 * lane + 4) = *(const f32x4*)(st + 1024 + 8 * lane + 4);
            *(f32x4*)(d2 + 1024 + 8 * lane) = (f32x4){bflo(w.x), bfhi(w.x), bflo(w.y), bfhi(w.y)}; *(f32x4*)(d2 + 1024 + 8 * lane + 4) = (f32x4){bflo(w.z), bfhi(w.z), bflo(w.w), bfhi(w.w)}; }
        else if (t >= 2045) { const v4u w = *(const v4u*)(z + 8 * lane); float* d2 = P.out + O_LCP + ((size_t)b * 3 + (t - 2045)) * 512;
            *(f32x4*)(d2 + 8 * lane) = (f32x4){bflo(w.x), bfhi(w.x), bflo(w.y), bfhi(w.y)}; *(f32x4*)(d2 + 8 * lane + 4) = (f32x4){bflo(w.z), bfhi(w.z), bflo(w.w), bfhi(w.w)}; }
    }
}

template <bool SMP> __device__ __forceinline__ void phase_p3b(const Ctx& C, const Params& P) {
    LAS float* L = (LAS float*)(C.lds + RING_OFF);
    for (int i = C.tid; i < 2048; i += 512) L[i] = P.in[14][i];
    { const int i = C.tid; L[2048 + i] = P.in[15][i]; L[2560 + i] = P.in[17][i]; L[3072 + i] = P.in[19][i];
      const float nl = -P.in[20][i]; L[3584 + i] = fmaxf(nl, 0.f) + log1pf(__expf(-fabsf(nl))); }
    __syncthreads();
    const int lane0 = C.lane, h = C.wave;
    const bf16* Z = WSP(const bf16, WS_Z); bf16* HL = WSP(bf16, WS_HL); bf16* AC = WSP(bf16, WS_AC); float* SUM = WSP(float, WS_SUM);
    const bf16* WG = WSP(const bf16, WS_WG);
    bf16x8 idf[2];
#pragma unroll
    for (int s2 = 0; s2 < 2; ++s2) { bf16x8 f;
#pragma unroll
        for (int j = 0; j < 8; ++j) f[j] = (16 * s2 + 8 * (lane0 >> 5) + j == (lane0 & 31)) ? (short)0x3F80 : (short)0;
        idf[s2] = f; }
    const int NIT = SMP ? 4 : NBATCH * 32;
    for (int it0 = C.bid; it0 < NIT; it0 += C.G) {
        constexpr bool smp = SMP; const int it = SMP ? it0 + NBATCH * 32 : it0;
        int lane = lane0; asm volatile("" : "+v"(lane));
        const int tk = lane & 31, hh = lane >> 5;
        const int b = it >> 5, chunk = it & 31;
        float carP[2] = {1.f, 1.f}, carS[2] = {0.f, 0.f};
#pragma unroll 1
        for (int sub = 0; sub < (smp ? 1 : 2); ++sub) {
            const int t0 = smp ? 0 : chunk * 64 + sub * 32;
            const int sq = (it - NBATCH * 32) * 32;
            const size_t rowA = smp ? (size_t)(MP + sq + tk) : (size_t)b * SEQ + t0 + tk;
            bf16x8 af[4];
#pragma unroll
            for (int s = 0; s < 4; ++s) {
                const int ch0 = 64 * h + 16 * s + 8 * hh;
                float xc[8];
#pragma unroll
                for (int j = 0; j < 8; ++j) xc[j] = L[2048 + ch0 + j];
#pragma unroll
                for (int tap = 0; tap < 4; ++tap) {
                    float xv[8];
                    if (smp && tap < 3) { const float* st = P.in[5] + ((size_t)(sq + tk) * 3 + tap) * 512 + ch0; const f32x4 a = *(const f32x4*)st, bq = *(const f32x4*)(st + 4);
                        xv[0] = a.x; xv[1] = a.y; xv[2] = a.z; xv[3] = a.w; xv[4] = bq.x; xv[5] = bq.y; xv[6] = bq.z; xv[7] = bq.w; }
                    else { const int tt = t0 + tk - 3 + tap; v4u w = (v4u){0u, 0u, 0u, 0u};
                        if (smp || tt >= 0) w = *(const v4u*)(Z + (rowA - 3 + tap) * ZC + ch0);
                        xv[0] = bflo(w.x); xv[1] = bfhi(w.x); xv[2] = bflo(w.y); xv[3] = bfhi(w.y); xv[4] = bflo(w.z); xv[5] = bfhi(w.z); xv[6] = bflo(w.w); xv[7] = bfhi(w.w); }
#pragma unroll
                    for (int j = 0; j < 8; ++j) xc[j] += L[tap * 512 + ch0 + j] * xv[j];
                }
                af[s] = pack8(xc);
                asm volatile("" ::: "memory"); __builtin_amdgcn_sched_barrier(0);
            }
#pragma unroll 1
            for (int cb = 0; cb < 2; ++cb) {
                f32x16 ra = {}, ia = {}, xq = {};
                { unsigned woff = (unsigned)(((h * 2) * 64 + 32 * cb + tk) * 64 + 8 * hh); asm volatile("" : "+v"(woff));
                  const bf16* wp = WG + woff;
#pragma unroll
                  for (int s = 0; s < 4; ++s) { const bf16x8 wa = *(const bf16x8*)(wp + 16 * s), wx = *(const bf16x8*)(wp + 4096 + 16 * s); ra = mfma32(af[s], wa, ra); ia = mfma32(af[s], wx, ia); } }
                { const bf16x8 afa = cb ? af[2] : af[0], afb = cb ? af[3] : af[1]; xq = mfma32(afa, idf[0], xq); xq = mfma32(afb, idf[1], xq); }
                const int ch = 64 * h + 32 * cb + tk;
                const float spc = L[3584 + ch], bac = L[2560 + ch], bxc = L[3072 + ch];
                float av[16], hv[16];
#pragma unroll
                for (int rr = 0; rr < 16; ++rr) {
                    const float rg = sigmoidf_(ra[rr] + bac), ig = sigmoidf_(ia[rr] + bxc);
                    const float la = -8.0f * spc * rg; const float a = __expf(la);
                    const float x2 = 2.0f * la;
                    const float ser = -x2 * (1.0f + x2 * (0.5f + x2 * (0.16666667f + x2 * (0.041666668f + x2 * (0.008333334f + x2 * 0.0013888889f)))));
                    float mult = sqrtf(x2 > -0.25f ? ser : 1.0f - a * a);
                    if (!smp && (t0 + crow(rr, hh)) == 0) mult = 1.0f;
                    av[rr] = a; hv[rr] = mult * ig * xq[rr];
                    if ((rr & 3) == 3) __builtin_amdgcn_sched_barrier(0);
                }
                if (smp) {
#pragma unroll
                    for (int rr = 0; rr < 16; ++rr) { const int sI = sq + crow(rr, hh); const float h0 = P.in[4][(size_t)sI * 512 + ch];
                        const float hn = av[rr] * h0 + hv[rr]; P.out[O_LHS + (size_t)sI * 512 + ch] = hn;
                        HL[(size_t)(MP + sI) * 512 + ch] = (bf16)f2bf(hn); AC[(size_t)(MP + sI) * 512 + ch] = (bf16)0; }
                } else {
#pragma unroll
                    for (int gi = 0; gi < 4; ++gi)
#pragma unroll
                        for (int j = 1; j < 4; ++j) { hv[4 * gi + j] = av[4 * gi + j] * hv[4 * gi + j - 1] + hv[4 * gi + j]; av[4 * gi + j] = av[4 * gi + j] * av[4 * gi + j - 1]; }
                    float Pc = cb ? carP[1] : carP[0], Sc = cb ? carS[1] : carS[0];
#pragma unroll
                    for (int gi = 0; gi < 4; ++gi) {
                        const float oA = av[4 * gi + 3], oH = hv[4 * gi + 3];
                        const float pA = __shfl_xor(oA, 32), pH = __shfl_xor(oH, 32);
                        const float loA = hh ? pA : oA, loH = hh ? pH : oH, hiA = hh ? oA : pA, hiH = hh ? oH : pH;
                        const float S1 = loH + loA * Sc, P1 = loA * Pc;
                        const float Sin = hh ? S1 : Sc, Pin = hh ? P1 : Pc;
#pragma unroll
                        for (int j = 0; j < 4; ++j) { const int rr = 4 * gi + j; hv[rr] = hv[rr] + av[rr] * Sin; av[rr] = av[rr] * Pin; }
                        Sc = hiH + hiA * S1; Pc = hiA * P1;
                    }
                    if (cb) { carP[1] = Pc; carS[1] = Sc; } else { carP[0] = Pc; carS[0] = Sc; }
                    { const unsigned ob = (unsigned)(((b * SEQ + t0 + 4 * hh) * 512 + ch) * 2);
#pragma unroll
                      for (int rr = 0; rr < 16; ++rr) { const unsigned o2 = ob + (unsigned)(((rr & 3) + 8 * (rr >> 2)) * 1024);
                          *(bf16*)((char*)HL + o2) = (bf16)f2bf(hv[rr]); *(bf16*)((char*)AC + o2) = (bf16)f2bf(av[rr]); } }
                }
            }
        }
        if (!smp) { int lq = lane; asm volatile("" : "+v"(lq));
            if (lq < 32) {
#pragma unroll
                for (int cb = 0; cb < 2; ++cb) { const int ch = 64 * h + 32 * cb + lq; *(f32x2*)(SUM + (((size_t)b * 32 + chunk) * 512 + ch) * 2) = (f32x2){carP[cb], carS[cb]}; } }
        }
    }
    __syncthreads();
}

__device__ __forceinline__ float g8_sum(float v) { v += __shfl_xor(v, 1); v += __shfl_xor(v, 2); v += __shfl_xor(v, 4); return v; }
__device__ __forceinline__ void phase_p5(const Ctx& C, const Params& P) {
    const int gw = C.bid * NWAVES + C.wave, NGW = C.G * NWAVES, lane = C.lane, hd = lane >> 3, sub = lane & 7;
    const bf16* QRAW = WSP(const bf16, WS_QRAW); const bf16* KVRAW = WSP(const bf16, WS_KVRAW); const bf16* KR = WSP(const bf16, WS_KR);
    bf16* Q = WSP(bf16, WS_Q); bf16* KF = WSP(bf16, WS_KF); bf16* V = WSP(bf16, WS_V);
    const float* gqn = P.in[23]; const float* gqr = P.in[24]; const float* gkn = P.in[28]; const float* rope = WSP(const float, WS_ROPE);
    for (int r = gw; r < MREAL; r += NGW) {
        const int pi = (r >= MP) ? 2048 : (r & 2047);
        { const bf16* q = QRAW + (size_t)r * 768 + hd * 96;
          const v4u w = *(const v4u*)(q + 8 * sub); float v[8] = {bflo(w.x), bfhi(w.x), bflo(w.y), bfhi(w.y), bflo(w.z), bfhi(w.z), bflo(w.w), bfhi(w.w)};
          float ss = 0.f;
#pragma unroll
          for (int j = 0; j < 8; ++j) ss += v[j] * v[j];
          const float rstd = rsqrtf(g8_sum(ss) * (1.f / 64.f) + EPS) * C2;
#pragma unroll
          for (int j = 0; j < 8; ++j) v[j] = v[j] * rstd * gqn[8 * sub + j];
          *(bf16x8*)(Q + (size_t)r * 768 + hd * 96 + 8 * sub) = pack8(v);
          const v2u wr_ = *(const v2u*)(q + 64 + 4 * sub); float x[4] = {bflo(wr_.x), bfhi(wr_.x), bflo(wr_.y), bfhi(wr_.y)};
          const float rs2 = rsqrtf(g8_sum(x[0] * x[0] + x[1] * x[1] + x[2] * x[2] + x[3] * x[3]) * (1.f / 32.f) + EPS);
          float o[4];
#pragma unroll
          for (int j = 0; j < 4; ++j) { const float me = x[j] * rs2 * gqr[4 * sub + j]; const float pr = __shfl_xor(me, 4);
              const f32x2 cs = *(const f32x2*)(rope + ((size_t)pi * 16 + 4 * (sub & 3) + j) * 2);
              o[j] = ((sub & 4) ? (me * cs.x + pr * cs.y) : (me * cs.x - pr * cs.y)) * C2; }
          v2u ow; ow.x = pk2(o[0], o[1]); ow.y = pk2(o[2], o[3]); *(v2u*)(Q + (size_t)r * 768 + hd * 96 + 64 + 4 * sub) = ow; }
        { const bf16* kv = KVRAW + (size_t)r * 1024 + hd * 128;
          const v4u w = *(const v4u*)(kv + 8 * sub); float v[8] = {bflo(w.x), bfhi(w.x), bflo(w.y), bfhi(w.y), bflo(w.z), bfhi(w.z), bflo(w.w), bfhi(w.w)};
          float ss = 0.f;
#pragma unroll
          for (int j = 0; j < 8; ++j) ss += v[j] * v[j];
          const float rstd = rsqrtf(g8_sum(ss) * (1.f / 64.f) + EPS);
#pragma unroll
          for (int j = 0; j < 8; ++j) v[j] = v[j] * rstd * gkn[8 * sub + j];
          *(bf16x8*)(KF + (size_t)r * 768 + hd * 96 + 8 * sub) = pack8(v);
          *(v2u*)(KF + (size_t)r * 768 + hd * 96 + 64 + 4 * sub) = *(const v2u*)(KR + (size_t)r * 32 + 4 * sub);
          *(v4u*)(V + (size_t)r * 512 + hd * 64 + 8 * sub) = *(const v4u*)(kv + 64 + 8 * sub); }
    }
}

__device__ __forceinline__ void phase_carry(const Ctx& C, const Params& P) {
    const float* SUM = WSP(const float, WS_SUM); float* CAR = WSP(float, WS_CARRY);
    for (int idx = C.bid * 512 + C.tid; idx < NBATCH * 512; idx += C.G * 512) {
        const int b = idx >> 9, ch = idx & 511; float H = 0.f;
        for (int k = 0; k < 32; ++k) { CAR[((size_t)b * 32 + k) * 512 + ch] = H; const f32x2 ps = *(const f32x2*)(SUM + (((size_t)b * 32 + k) * 512 + ch) * 2); H = ps.x * H + ps.y; }
        P.out[O_LHP + idx] = H;
    }
}

constexpr int KT_PITCH = 208, VT_PITCH = 192;
constexpr int KT_BYTES = 64 * KT_PITCH, VT_BYTES = 64 * VT_PITCH, ATT_BUF = KT_BYTES + VT_BYTES;
__device__ __forceinline__ s16x4 tr_read(unsigned addr) { s16x4 r; asm volatile("ds_read_b64_tr_b16 %0, %1\n\ts_waitcnt lgkmcnt(0)" : "=&v"(r) : "v"(addr) : "memory"); return r; }
__device__ __forceinline__ void attn_unit(const Ctx& C, const Params& P, int bh, int qb) {
    const int lane = C.lane, wid = C.wave, tid = C.tid, r32 = lane & 31, hh = lane >> 5;
    const int b = bh >> 3, h = bh & 7;
    const bf16* Q = WSP(const bf16, WS_Q); const bf16* KF = WSP(const bf16, WS_KF); const bf16* V = WSP(const bf16, WS_V); bf16* ATT = WSP(bf16, WS_ATT);
    const size_t rowbase = (size_t)b * SEQ; const int q0 = qb * 256 + wid * 32;
    const unsigned lds0 = (unsigned)(uintptr_t)(C.lds + RING_OFF);
    bf16x8 qf[6];
#pragma unroll
    for (int s = 0; s < 6; ++s) qf[s] = *(const bf16x8*)(Q + (rowbase + q0 + r32) * 768 + h * 96 + 16 * s + 8 * hh);
    const int NT = 4 * (qb + 1);
    const int kc0 = tid, kr0 = kc0 / 12, kk0 = kc0 % 12, kc1 = 512 + tid, kr1 = kc1 / 12, kk1 = kc1 % 12; const bool k2 = tid < 256;
    const int vr = tid >> 3, vk = tid & 7;
    const bf16* kg0 = KF + (rowbase + kr0) * 768 + h * 96 + kk0 * 8; const bf16* kg1 = KF + (rowbase + kr1) * 768 + h * 96 + kk1 * 8;
    const bf16* vg = V + (rowbase + vr) * 512 + h * 64 + vk * 8;
    v4u sk0, sk1 = (v4u){0u, 0u, 0u, 0u}, sv;
    sk0 = *(const v4u*)kg0; if (k2) sk1 = *(const v4u*)kg1; sv = *(const v4u*)vg;
    { LAS unsigned char* bufp = C.lds + RING_OFF; *(LAS v4u*)(bufp + kr0 * KT_PITCH + kk0 * 16) = sk0; if (k2) *(LAS v4u*)(bufp + kr1 * KT_PITCH + kk1 * 16) = sk1; *(LAS v4u*)(bufp + KT_BYTES + vr * VT_PITCH + vk * 16) = sv; }
    __syncthreads();
    float m_run = -INFINITY, l_run = 0.f; f32x16 o[2]; o[0] = f32x16{}; o[1] = f32x16{};
    for (int t = 0; t < NT; ++t) {
        const int cur = t & 1; const bool more = (t + 1 < NT);
        if (more) { const size_t adv = (size_t)(t + 1) * 64; sk0 = *(const v4u*)(kg0 + adv * 768); if (k2) sk1 = *(const v4u*)(kg1 + adv * 768); sv = *(const v4u*)(vg + adv * 512); }
        LAS unsigned char* Kb = C.lds + RING_OFF + cur * ATT_BUF; const unsigned Vb = lds0 + cur * ATT_BUF + KT_BYTES;
        if (64 * t <= q0 + 31) {
        f32x16 p[2];
#pragma unroll
        for (int kh = 0; kh < 2; ++kh) { f32x16 acc = f32x16{};
#pragma unroll
            for (int s = 0; s < 6; ++s) { const bf16x8 kf = *(const LAS bf16x8*)(Kb + (32 * kh + r32) * KT_PITCH + (16 * s + 8 * hh) * 2); acc = mfma32(kf, qf[s], acc); }
            p[kh] = acc; }
        if (64 * t + 63 > q0) { const int qq = q0 + r32;
#pragma unroll
            for (int kh = 0; kh < 2; ++kh)
#pragma unroll
                for (int r = 0; r < 16; ++r) if (64 * t + 32 * kh + crow(r, hh) > qq) p[kh][r] = -INFINITY; }
        float mx = p[0][0];
#pragma unroll
        for (int r = 1; r < 16; ++r) mx = fmaxf(mx, p[0][r]);
#pragma unroll
        for (int r = 0; r < 16; ++r) mx = fmaxf(mx, p[1][r]);
        mx = fmaxf(mx, __shfl_xor(mx, 32));
        const float m_new = fmaxf(m_run, mx); const float alpha = exp2f(m_run - m_new); m_run = m_new;
        float ps = 0.f;
#pragma unroll
        for (int kh = 0; kh < 2; ++kh)
#pragma unroll
            for (int r = 0; r < 16; ++r) { const float e = exp2f(p[kh][r] - m_new); p[kh][r] = e; ps += e; }
        l_run = l_run * alpha + ps;
#pragma unroll
        for (int dt = 0; dt < 2; ++dt)
#pragma unroll
            for (int r = 0; r < 16; ++r) o[dt][r] *= alpha;
#pragma unroll
        for (int kh = 0; kh < 2; ++kh)
#pragma unroll
            for (int s2 = 0; s2 < 2; ++s2) {
                float pv[8];
#pragma unroll
                for (int j = 0; j < 8; ++j) pv[j] = p[kh][8 * s2 + j];
                const bf16x8 pf = pack8(pv);
                const int keyb = 32 * kh + 16 * s2 + 4 * hh; const int i16 = lane & 15, q4 = i16 >> 2, p4 = i16 & 3, blk = (lane >> 4) & 1;
                { const unsigned a0 = Vb + (keyb + q4) * VT_PITCH + (16 * blk + 4 * p4) * 2;
                  s16x4 lo0, hi0, lo1, hi1;
                  asm volatile("ds_read_b64_tr_b16 %0, %4\n\tds_read_b64_tr_b16 %1, %4 offset:1536\n\tds_read_b64_tr_b16 %2, %4 offset:64\n\tds_read_b64_tr_b16 %3, %4 offset:1600\n\ts_waitcnt lgkmcnt(0)"
                               : "=&v"(lo0), "=&v"(hi0), "=&v"(lo1), "=&v"(hi1) : "v"(a0) : "memory");
                  o[0] = mfma32(__builtin_shufflevector(lo0, hi0, 0, 1, 2, 3, 4, 5, 6, 7), pf, o[0]);
                  o[1] = mfma32(__builtin_shufflevector(lo1, hi1, 0, 1, 2, 3, 4, 5, 6, 7), pf, o[1]); }
            }
        }
        if (more) { LAS unsigned char* nb = C.lds + RING_OFF + (cur ^ 1) * ATT_BUF;
            *(LAS v4u*)(nb + kr0 * KT_PITCH + kk0 * 16) = sk0; if (k2) *(LAS v4u*)(nb + kr1 * KT_PITCH + kk1 * 16) = sk1; *(LAS v4u*)(nb + KT_BYTES + vr * VT_PITCH + vk * 16) = sv; }
        __syncthreads();
    }
    const float linv = 1.0f / xhalf_sum(l_run);
    bf16* orow = ATT + (rowbase + q0 + r32) * 512 + h * 64;
#pragma unroll
    for (int dt = 0; dt < 2; ++dt)
#pragma unroll
        for (int g = 0; g < 4; ++g) { v2u w; w.x = pk2(o[dt][4 * g] * linv, o[dt][4 * g + 1] * linv); w.y = pk2(o[dt][4 * g + 2] * linv, o[dt][4 * g + 3] * linv);
            *(v2u*)(orow + 32 * dt + 8 * g + 4 * hh) = w; }
}
__device__ __forceinline__ void phase_attn_prompt(const Ctx& C, const Params& P) {
    for (int pi = C.bid; pi < 512; pi += C.G) {
        const int bh = pi >> 2, pr = pi & 3;
        attn_unit(C, P, bh, 7 - pr);
        attn_unit(C, P, bh, pr);
    }
}

constexpr int LK_PITCH = 272, LT_PITCH = 272, LKR_PITCH = 144;
constexpr int SA_LK = 0, SA_LT = 128 * LK_PITCH, SA_KR = SA_LT + 128 * LT_PITCH, SA_P = SA_KR + 128 * LKR_PITCH, SA_AL = SA_P + 16 * 256, SA_QR = SA_AL + 64, SA_SC = SA_QR + 8 * 128, SA_END = SA_SC + 8 * 512;
constexpr int PART_STRIDE = 8 * 132;
__device__ __forceinline__ void phase_attn_sample(const Ctx& C, const Params& P) {
    const int lane = C.lane, h = C.wave, tid = C.tid, r32 = lane & 31, hh = lane >> 5;
    const bf16* WUKV = WSP(const bf16, WS_WUKV); const bf16* Q = WSP(const bf16, WS_Q); float* PART = WSP(float, WS_PART);
    const float* cache_lat = P.in[2]; const float* cache_kr = P.in[3]; const int* ptab = (const int*)P.in[7]; const float* gkn = P.in[28];
    LAS unsigned char* S = C.lds + RING_OFF; const unsigned lds0 = (unsigned)(uintptr_t)S;
    bf16x8 wk[2][8];
#pragma unroll
    for (int rt = 0; rt < 2; ++rt)
#pragma unroll
        for (int s = 0; s < 8; ++s) wk[rt][s] = *(const bf16x8*)(WUKV + (size_t)(h * 128 + 32 * rt + r32) * 256 + 16 * s + 8 * hh);
    const int kg = tid >> 5, dq = tid & 31;
    for (int u = C.bid; u < 256; u += C.G) {
        const int sq = u >> 1, half = u & 1; const size_t qrow = (size_t)(MP + sq);
        unsigned qg[2][8];
#pragma unroll
        for (int rt = 0; rt < 2; ++rt)
#pragma unroll
            for (int r = 0; r < 16; r += 2) { const int d0 = 32 * rt + crow(r, hh), d1 = 32 * rt + crow(r + 1, hh);
                qg[rt][r >> 1] = pk2(bf2f(Q[qrow * 768 + h * 96 + d0]) * gkn[d0], bf2f(Q[qrow * 768 + h * 96 + d1]) * gkn[d1]); }
        if (lane < 32) *(LAS float*)(S + SA_QR + h * 128 + lane * 4) = bf2f(Q[qrow * 768 + h * 96 + 64 + lane]);
        float m_run = -INFINITY, l_run = 0.f; f32x4 ctx = (f32x4){0.f, 0.f, 0.f, 0.f};
        f32x4 pl[8]; f32x4 pk[2];
        { const int pg = ptab[sq * NPAGES + half * 64];
          const float* lp = cache_lat + (size_t)pg * (PAGE * KVLR) + (size_t)(8 * kg) * KVLR + 4 * dq;
#pragma unroll
          for (int i = 0; i < 8; ++i) pl[i] = *(const f32x4*)(lp + (size_t)i * KVLR);
          const float* kp = cache_kr + (size_t)pg * (PAGE * ROPE_D);
#pragma unroll
          for (int i = 0; i < 2; ++i) pk[i] = *(const f32x4*)(kp + (size_t)(tid + 512 * i) * 4); }
        for (int pgi = 0; pgi < 64; ++pgi) {
#pragma unroll
            for (int i = 0; i < 8; ++i) { v2u w; w.x = pk2(pl[i].x, pl[i].y); w.y = pk2(pl[i].z, pl[i].w); *(LAS v2u*)(S + SA_LK + (8 * kg + i) * LK_PITCH + dq * 8) = w; }
            { v4u w0, w1, w2, w3;
              w0.x = pk2(pl[0].x, pl[1].x); w0.y = pk2(pl[2].x, pl[3].x); w0.z = pk2(pl[4].x, pl[5].x); w0.w = pk2(pl[6].x, pl[7].x);
              w1.x = pk2(pl[0].y, pl[1].y); w1.y = pk2(pl[2].y, pl[3].y); w1.z = pk2(pl[4].y, pl[5].y); w1.w = pk2(pl[6].y, pl[7].y);
              w2.x = pk2(pl[0].z, pl[1].z); w2.y = pk2(pl[2].z, pl[3].z); w2.z = pk2(pl[4].z, pl[5].z); w2.w = pk2(pl[6].z, pl[7].z);
              w3.x = pk2(pl[0].w, pl[1].w); w3.y = pk2(pl[2].w, pl[3].w); w3.z = pk2(pl[4].w, pl[5].w); w3.w = pk2(pl[6].w, pl[7].w);
              *(LAS v4u*)(S + SA_LT + (4 * dq + 0) * LT_PITCH + kg * 16) = w0; *(LAS v4u*)(S + SA_LT + (4 * dq + 1) * LT_PITCH + kg * 16) = w1;
              *(LAS v4u*)(S + SA_LT + (4 * dq + 2) * LT_PITCH + kg * 16) = w2; *(LAS v4u*)(S + SA_LT + (4 * dq + 3) * LT_PITCH + kg * 16) = w3; }
#pragma unroll
            for (int i = 0; i < 2; ++i) { const int c = tid + 512 * i, key = c >> 3, part = c & 7; *(LAS f32x4*)(S + SA_KR + key * LKR_PITCH + part * 16) = pk[i]; }
            __syncthreads();
            if (pgi + 1 < 64) { const int pg = ptab[sq * NPAGES + half * 64 + pgi + 1];
                const float* lp = cache_lat + (size_t)pg * (PAGE * KVLR) + (size_t)(8 * kg) * KVLR + 4 * dq;
#pragma unroll
                for (int i = 0; i < 8; ++i) pl[i] = *(const f32x4*)(lp + (size_t)i * KVLR);
                const float* kp = cache_kr + (size_t)pg * (PAGE * ROPE_D);
#pragma unroll
                for (int i = 0; i < 2; ++i) pk[i] = *(const f32x4*)(kp + (size_t)(tid + 512 * i) * 4); }
#pragma unroll 1
            for (int kt = 0; kt < 4; ++kt) {
                f32x16 a0 = f32x16{}, a1 = f32x16{};
#pragma unroll
                for (int s = 0; s < 8; ++s) { const bf16x8 bfr = *(const LAS bf16x8*)(S + SA_LK + (32 * kt + r32) * LK_PITCH + (16 * s + 8 * hh) * 2); a0 = mfma32(wk[0][s], bfr, a0); a1 = mfma32(wk[1][s], bfr, a1); }
                float ss = 0.f, dot = 0.f;
#pragma unroll
                for (int r = 0; r < 16; r += 2) { ss += a0[r] * a0[r] + a0[r + 1] * a0[r + 1]; dot += a0[r] * bflo(qg[0][r >> 1]) + a0[r + 1] * bfhi(qg[0][r >> 1]);
                    ss += a1[r] * a1[r] + a1[r + 1] * a1[r + 1]; dot += a1[r] * bflo(qg[1][r >> 1]) + a1[r + 1] * bfhi(qg[1][r >> 1]); }
                float rp = 0.f; const LAS float* kr = (const LAS float*)(S + SA_KR + (32 * kt + r32) * LKR_PITCH + 64 * hh);
#pragma unroll
                for (int i = 0; i < 16; i += 4) { const f32x4 qv = *(const LAS f32x4*)(S + SA_QR + h * 128 + 64 * hh + 4 * i), kv = *(const LAS f32x4*)(kr + i);
                    rp += (qv.x * kv.x + qv.y * kv.y) + (qv.z * kv.z + qv.w * kv.w); }
                ss = xhalf_sum(ss); dot = xhalf_sum(dot); rp = xhalf_sum(rp);
                const float scv = rsqrtf(ss * (1.f / 64.f) + EPS) * dot + rp;
                if (hh == 0) *(LAS float*)(S + SA_SC + h * 512 + (32 * kt + r32) * 4) = scv;
            }
            asm volatile("s_waitcnt lgkmcnt(0)" ::: "memory");
            float sc[4];
#pragma unroll
            for (int kt = 0; kt < 4; ++kt) sc[kt] = *(const LAS float*)(S + SA_SC + h * 512 + (32 * kt + r32) * 4);
            float mx = fmaxf(fmaxf(sc[0], sc[1]), fmaxf(sc[2], sc[3])); mx = wave_max(mx);
            const float m_new = fmaxf(m_run, mx); const float alpha = exp2f(m_run - m_new); m_run = m_new;
            float ps = 0.f;
#pragma unroll
            for (int kt = 0; kt < 4; ++kt) { const float e = exp2f(sc[kt] - m_new); ps += e; if (hh == 0) *(LAS bf16*)(S + SA_P + h * 256 + (32 * kt + r32) * 2) = (bf16)f2bf(e); }
            l_run = l_run * alpha + ps;
            if (lane == 0) *(LAS float*)(S + SA_AL + h * 4) = alpha;
            __syncthreads();
            { const int g4 = lane >> 4, n16 = lane & 15;
              if (g4 < 2) { const f32x4 al = *(const LAS f32x4*)(S + SA_AL + 16 * g4); ctx = ctx * al; }
#pragma unroll
              for (int ks = 0; ks < 4; ++ks) {
                  bf16x8 af = *(const LAS bf16x8*)(S + SA_P + (n16 & 7) * 256 + (32 * ks + 8 * g4) * 2); if (n16 >= 8) af = bf16x8{};
                  const bf16x8 bfr = *(const LAS bf16x8*)(S + SA_LT + (16 * h + n16) * LT_PITCH + (32 * ks + 8 * g4) * 2);
                  ctx = mfma16(af, bfr, ctx); } }
            __syncthreads();
        }
        { const int g4 = lane >> 4, n16 = lane & 15; float* pu = PART + (size_t)u * PART_STRIDE;
          if (g4 < 2) {
#pragma unroll
              for (int i = 0; i < 4; ++i) pu[(4 * g4 + i) * 132 + 16 * h + n16] = ctx[i]; }
          const float lsum = wave_sum(l_run) * 0.5f;
          if (lane == 0) { pu[h * 132 + 128] = m_run; pu[h * 132 + 129] = lsum; } }
    }
}

__device__ __forceinline__ void phase_sample_combine(const Ctx& C, const Params& P) {
    const int gw = C.bid * NWAVES + C.wave, NGW = C.G * NWAVES, lane = C.lane;
    const float* PART = WSP(const float, WS_PART); const bf16* Q = WSP(const bf16, WS_Q); const bf16* KF = WSP(const bf16, WS_KF); const bf16* V = WSP(const bf16, WS_V);
    bf16* ATT = WSP(bf16, WS_ATT); const float* wukv = P.in[27];
    for (int it = gw; it < MS * NHEAD; it += NGW) {
        const int sq = it >> 3, h = it & 7; const size_t row = (size_t)(MP + sq);
        const float* p0 = PART + (size_t)(2 * sq) * PART_STRIDE + h * 132; const float* p1 = p0 + PART_STRIDE;
        float sn = 0.f; if (lane < 48) { const unsigned qa = *(const unsigned*)(Q + row * 768 + h * 96 + 2 * lane), ka = *(const unsigned*)(KF + row * 768 + h * 96 + 2 * lane); sn = bflo(qa) * bflo(ka) + bfhi(qa) * bfhi(ka); }
        sn = wave_sum(sn);
        const float m0 = p0[128], l0 = p0[129], m1 = p1[128], l1 = p1[129];
        const float M = fmaxf(fmaxf(m0, m1), sn); const float w0 = exp2f(m0 - M), w1 = exp2f(m1 - M), wn = exp2f(sn - M);
        const float Lt = l0 * w0 + l1 * w1 + wn;
        const float c_lo = p0[lane] * w0 + p1[lane] * w1, c_hi = p0[64 + lane] * w0 + p1[64 + lane] * w1;
        float acc = 0.f; const float* wv = wukv + h * 128 + 64 + lane;
        for (int k = 0; k < 64; ++k) { acc += __shfl(c_lo, k) * wv[(size_t)k * 1024]; acc += __shfl(c_hi, k) * wv[(size_t)(64 + k) * 1024]; }
        const float outv = (acc + wn * bf2f(V[row * 512 + h * 64 + lane])) / Lt;
        ATT[row * 512 + h * 64 + lane] = (bf16)f2bf(outv);
    }
}

__device__ __forceinline__ void phase_mix(const Ctx& C, const Params& P) {
    const int gw = C.bid * NWAVES + C.wave, NGW = C.G * NWAVES, lane = C.lane;
    const bf16* Z = WSP(const bf16, WS_Z); const bf16* HL = WSP(const bf16, WS_HL); const bf16* AC = WSP(const bf16, WS_AC); const bf16* ATT = WSP(const bf16, WS_ATT);
    const float* CAR = WSP(const float, WS_CARRY); bf16* MIX = WSP(bf16, WS_MIX); const float* glo = P.in[29]; const float* gmo = P.in[30];
    for (int r = gw; r < MREAL; r += NGW) {
        const int c = 8 * lane;
        const v4u wh = *(const v4u*)(HL + (size_t)r * 512 + c), wa = *(const v4u*)(AC + (size_t)r * 512 + c), wg = *(const v4u*)(Z + (size_t)r * ZC + 512 + c);
        float hv[8] = {bflo(wh.x), bfhi(wh.x), bflo(wh.y), bfhi(wh.y), bflo(wh.z), bfhi(wh.z), bflo(wh.w), bfhi(wh.w)};
        const float av[8] = {bflo(wa.x), bfhi(wa.x), bflo(wa.y), bfhi(wa.y), bflo(wa.z), bfhi(wa.z), bflo(wa.w), bfhi(wa.w)};
        const float gv[8] = {bflo(wg.x), bfhi(wg.x), bflo(wg.y), bfhi(wg.y), bflo(wg.z), bfhi(wg.z), bflo(wg.w), bfhi(wg.w)};
        if (r < MP) { const float* cp = CAR + ((size_t)(r >> 11) * 32 + ((r & 2047) >> 6)) * 512 + c; const f32x4 c0 = *(const f32x4*)cp, c1 = *(const f32x4*)(cp + 4);
            const float cin[8] = {c0.x, c0.y, c0.z, c0.w, c1.x, c1.y, c1.z, c1.w};
#pragma unroll
            for (int j = 0; j < 8; ++j) hv[j] += av[j] * cin[j]; }
        float ss = 0.f;
#pragma unroll
        for (int j = 0; j < 8; ++j) { hv[j] = hv[j] * gelu_tanh(gv[j]); ss += hv[j] * hv[j]; }
        const float rstd = rsqrtf(wave_sum(ss) * (1.f / 512.f) + EPS);
        { const f32x4 g0 = *(const f32x4*)(glo + c), g1 = *(const f32x4*)(glo + c + 4); const float gg[8] = {g0.x, g0.y, g0.z, g0.w, g1.x, g1.y, g1.z, g1.w};
#pragma unroll
          for (int j = 0; j < 8; ++j) hv[j] = hv[j] * rstd * gg[j];
          *(bf16x8*)(MIX + (size_t)r * 1024 + c) = pack8(hv); }
        const v4u wt = *(const v4u*)(ATT + (size_t)r * 512 + c);
        float tv[8] = {bflo(wt.x), bfhi(wt.x), bflo(wt.y), bfhi(wt.y), bflo(wt.z), bfhi(wt.z), bflo(wt.w), bfhi(wt.w)};
        float s2 = 0.f;
#pragma unroll
        for (int j = 0; j < 8; ++j) s2 += tv[j] * tv[j];
        const float rs2 = rsqrtf(wave_sum(s2) * (1.f / 512.f) + EPS);
        { const f32x4 g0 = *(const f32x4*)(gmo + c), g1 = *(const f32x4*)(gmo + c + 4); const float gg[8] = {g0.x, g0.y, g0.z, g0.w, g1.x, g1.y, g1.z, g1.w};
#pragma unroll
          for (int j = 0; j < 8; ++j) tv[j] = tv[j] * rs2 * gg[j];
          *(bf16x8*)(MIX + (size_t)r * 1024 + 512 + c) = pack8(tv); }
    }
}

__device__ __forceinline__ void unpack8(const v4u& w, float* v) { v[0] = bflo(w.x); v[1] = bfhi(w.x); v[2] = bflo(w.y); v[3] = bfhi(w.y); v[4] = bflo(w.z); v[5] = bfhi(w.z); v[6] = bflo(w.w); v[7] = bfhi(w.w); }
__device__ __forceinline__ void phase_convgelu(const Ctx& C, const Params& P) {
    const bf16* UP = WSP(const bf16, WS_UP); bf16* ACT = WSP(bf16, WS_ACT); const float* fw = P.in[34]; const float* fb = P.in[35];
    const int tid = C.tid; if (tid >= 352) return;
    const int c = 8 * tid;
    float wv[3][8], wg[3][8], bv[8], bg[8];
#pragma unroll
    for (int j = 0; j < 8; ++j) { bv[j] = fb[c + j]; bg[j] = fb[DFF + c + j];
#pragma unroll
        for (int k = 0; k < 3; ++k) { wv[k][j] = fw[k * UPC + c + j]; wg[k][j] = fw[k * UPC + DFF + c + j]; } }
    const int NIT = MP / 64 + 2;
    for (int it = C.bid; it < NIT; it += C.G) {
        const bool smp = it >= MP / 64; const int r0 = it * 64;
        float v1[8], v2[8], g1[8], g2[8];
        if (!smp) { if ((r0 & 2047) == 0) {
#pragma unroll
                for (int j = 0; j < 8; ++j) { v1[j] = 0.f; v2[j] = 0.f; g1[j] = 0.f; g2[j] = 0.f; } }
            else { unpack8(*(const v4u*)(UP + (size_t)(r0 - 1) * UPC + c), v1); unpack8(*(const v4u*)(UP + (size_t)(r0 - 2) * UPC + c), v2);
                   unpack8(*(const v4u*)(UP + (size_t)(r0 - 1) * UPC + DFF + c), g1); unpack8(*(const v4u*)(UP + (size_t)(r0 - 2) * UPC + DFF + c), g2); } }
        for (int i = 0; i < 64; ++i) {
            const int r = r0 + i;
            float v0[8], g0[8]; unpack8(*(const v4u*)(UP + (size_t)r * UPC + c), v0); unpack8(*(const v4u*)(UP + (size_t)r * UPC + DFF + c), g0);
            if (smp) { const int s_ = r - MP; const float* st = P.in[6] + (size_t)s_ * 2 * UPC;
#pragma unroll
                for (int j = 0; j < 8; ++j) { v2[j] = st[c + j]; g2[j] = st[DFF + c + j]; v1[j] = st[UPC + c + j]; g1[j] = st[UPC + DFF + c + j]; }
                float* d = P.out + O_FCS + (size_t)s_ * 2 * UPC;
#pragma unroll
                for (int j = 0; j < 8; ++j) { d[c + j] = v1[j]; d[DFF + c + j] = g1[j]; d[UPC + c + j] = v0[j]; d[UPC + DFF + c + j] = g0[j]; } }
            else { const int t = r & 2047; if (t >= 2046) { float* d = P.out + O_FCP + ((size_t)(r >> 11) * 2 + (t - 2046)) * UPC;
#pragma unroll
                for (int j = 0; j < 8; ++j) { d[c + j] = v0[j]; d[DFF + c + j] = g0[j]; } } }
            float o[8];
#pragma unroll
            for (int j = 0; j < 8; ++j) { const float val = bv[j] + wv[0][j] * v2[j] + wv[1][j] * v1[j] + wv[2][j] * v0[j]; const float gt = bg[j] + wg[0][j] * g2[j] + wg[1][j] * g1[j] + wg[2][j] * g0[j];
                o[j] = gelu_tanh(gt) * val; v2[j] = v1[j]; v1[j] = v0[j]; g2[j] = g1[j]; g1[j] = g0[j]; }
            *(bf16x8*)(ACT + (size_t)r * DFF + c) = pack8(o);
        }
    }
}

constexpr int N_LAUNCHES = MK_N_LAUNCHES;
constexpr int N_PHASES = 16;
template <int PHASE_MASK> __global__ void __launch_bounds__(NWAVES * 64, 2) mk_fwd(Params P) {
    extern __shared__ __attribute__((aligned(16))) unsigned char lds[];
    Ctx C; C.lds = (LAS unsigned char*)lds; C.tid = threadIdx.x; C.lane = C.tid & 63; C.wave = __builtin_amdgcn_readfirstlane(C.tid >> 6); C.G = gridDim.x; C.bid = blockIdx.x;
    volatile LAS unsigned* MISC = (volatile LAS unsigned*)(C.lds + MISC_OFF);
    for (int u = C.tid; u < (LDS_BYTES - LDSCTL_OFF) / 4; u += NWAVES * 64) ((LAS unsigned*)(C.lds + LDSCTL_OFF))[u] = 0u;
    __syncthreads();
    gu32* ctl = (gu32*)(P.ws + WS_CTL);
    XcdBarrier bar; bar.bar = (unsigned*)(ctl + CW_BAR); bar.x = 0; bar.st = nullptr;
    if (N_LAUNCHES == 1) bar = xcd_barrier_post((unsigned*)(ctl + CW_BAR), MISC + 8);
    const int lo = P.ph_lo, hi = P.ph_hi;
#define IN(k) (((PHASE_MASK >> (k)) & 1) && lo <= (k) && (k) < hi)
#define SEAM(k) do { if (IN(k) && IN((k) + 1)) xcd_barrier(bar); } while (0)

    if (IN(0)) { phase_p0a(C, P); } SEAM(0);
    if (IN(1)) { phase_p0b(C, P); } SEAM(1);
    if (IN(2)) { phase_norm_mod<false>(C, P); } SEAM(2);
    if (IN(3)) {
        pg8::Gemm g{WSP(const pg8::bf16_t, WS_H1), WSP(const pg8::bf16_t, WS_WIN), MR, ZC, 1024}; pg8::StaticOrder S; S.init(MR, ZC, C.G, C.bid);
        pg8::EpiBf16<0> E{WSP(pg8::bf16_t, WS_Z), ZC, nullptr, 0, 0, 1.f};
        pg8::gemm_phase<pg8::EpiBf16<0>, pg8::StaticOrder, true, true>(C.lds + RING_OFF, g, S, E);
    } SEAM(3);
    if (IN(4)) { phase_p3a(C, P); phase_p3b<false>(C, P); } SEAM(4);
    if (IN(5)) {
        pg8::Gemm g{WSP(const pg8::bf16_t, WS_QN), WSP(const pg8::bf16_t, WS_WUQ), MR, 768, 256}; pg8::StaticOrder S; S.init(MR, 768, C.G, C.bid);
        pg8::EpiBf16<0> E{WSP(pg8::bf16_t, WS_QRAW), 768, nullptr, 0, 0, 1.f};
        pg8::gemm_phase<pg8::EpiBf16<0>, pg8::StaticOrder, true, true>(C.lds + RING_OFF, g, S, E);
    }
    if (IN(6)) {
        pg8::Gemm g{WSP(const pg8::bf16_t, WS_KVN), WSP(const pg8::bf16_t, WS_WUKV), MR, 1024, 256}; pg8::StaticOrder S; S.init(MR, 1024, C.G, C.bid);
        pg8::EpiBf16<0> E{WSP(pg8::bf16_t, WS_KVRAW), 1024, nullptr, 0, 0, 1.f};
        pg8::gemm_phase<pg8::EpiBf16<0>, pg8::StaticOrder, true, true>(C.lds + RING_OFF, g, S, E);
    } SEAM(6);
    if (IN(7)) { phase_p3b<true>(C, P); phase_p5(C, P); } SEAM(7);
    if (IN(8)) { phase_carry(C, P); phase_attn_sample(C, P); phase_attn_prompt(C, P); } SEAM(8);
    if (IN(9)) { phase_sample_combine(C, P); } SEAM(9);
    if (IN(10)) { phase_mix(C, P); } SEAM(10);
    if (IN(11)) {
        pg8::Gemm g{WSP(const pg8::bf16_t, WS_MIX), WSP(const pg8::bf16_t, WS_WO), MR, 1024, 1024}; pg8::StaticOrder S; S.init(MR, 1024, C.G, C.bid);
        pg8::EpiResGate E{P.in[0], P.in[1], P.out, WSP(const float, WS_MOD), 2048};
        pg8::gemm_phase<pg8::EpiResGate, pg8::StaticOrder, true, true>(C.lds + RING_OFF, g, S, E);
    } SEAM(11);
    if (IN(12)) { phase_norm_mod<true>(C, P); } SEAM(12);
    if (IN(13)) {
        pg8::Gemm g{WSP(const pg8::bf16_t, WS_H1), WSP(const pg8::bf16_t, WS_WUP), MR, UPC, 1024}; pg8::StaticOrder S; S.init(MR, UPC, C.G, C.bid);
        pg8::EpiBf16<0> E{WSP(pg8::bf16_t, WS_UP), UPC, nullptr, 0, 0, 1.f};
        pg8::gemm_phase<pg8::EpiBf16<0>, pg8::StaticOrder, true, true>(C.lds + RING_OFF, g, S, E);
    } SEAM(13);
    if (IN(14)) { phase_convgelu(C, P); } SEAM(14);
    if (IN(15)) {
        pg8::Gemm g{WSP(const pg8::bf16_t, WS_ACT), WSP(const pg8::bf16_t, WS_WDN), MR, 1024, DFF}; pg8::StaticOrder S; S.init(MR, 1024, C.G, C.bid);
        pg8::EpiResGate E{P.out, P.out + (size_t)MP * 1024, P.out, WSP(const float, WS_MOD), 5120};
        pg8::gemm_phase<pg8::EpiResGate, pg8::StaticOrder, true, true>(C.lds + RING_OFF, g, S, E);
    }
#undef IN
#undef SEAM
}

typedef void (*KernFn)(Params);
template <int... I> struct Seq {};
static KernFn phase_kernel(int k) {
    switch (k) {
#define PK(i) case i: return mk_fwd<(1 << i)>;
        PK(0) PK(1) PK(2) PK(3) PK(4) PK(5) PK(6) PK(7) PK(8) PK(9) PK(10) PK(11) PK(12) PK(13) PK(14) PK(15)
#undef PK
        default: if constexpr (N_LAUNCHES == 1) return mk_fwd<0xffff>; else return nullptr;
    }
}
extern "C" void kernel_launch(void* const* d_in, const int* in_sizes, int n_in, void* d_out, int out_size, void* d_ws, size_t ws_size, hipStream_t stream) {
    static int grid = 0;
    static KernFn fns[N_PHASES];
    if (grid == 0) {
        if (n_in != 37 || out_size != (int)O_END || ws_size < WS_END) { fprintf(stderr, "kernel_launch: unexpected shapes: n_in %d out %d ws %zu\n", n_in, out_size, ws_size); grid = -1; return; }
        int dev = 0, cus = 0, per_cu = 0;
        if (hipGetDevice(&dev) != hipSuccess || hipDeviceGetAttribute(&cus, hipDeviceAttributeMultiprocessorCount, dev) != hipSuccess) { grid = -1; return; }
        for (int li = 0; li < N_LAUNCHES; ++li) {
            fns[li] = (N_LAUNCHES == 1) ? phase_kernel(99) : phase_kernel(li);
            if (hipFuncSetAttribute((const void*)fns[li], hipFuncAttributeMaxDynamicSharedMemorySize, LDS_BYTES) != hipSuccess) { fprintf(stderr, "kernel_launch: hipFuncSetAttribute failed\n"); grid = -1; return; }
            if (hipOccupancyMaxActiveBlocksPerMultiprocessor(&per_cu, (const void*)fns[li], NWAVES * 64, LDS_BYTES) != hipSuccess || per_cu < 1) { fprintf(stderr, "kernel_launch: occupancy query says %d for launch %d\n", per_cu, li); }
        }
        (void)hipGetLastError();
        grid = cus;
    }
    if (grid < 0) return;
    if (hipMemsetAsync((char*)d_ws + WS_CTL, 0, CTL_ZERO_BYTES, stream) != hipSuccess) return;
    Params p{};
    for (int i = 0; i < 37; ++i) p.in[i] = (const float*)d_in[i];
    p.out = (float*)d_out; p.ws = (unsigned char*)d_ws;
    for (int li = 0; li < N_LAUNCHES; ++li) {
        if (N_LAUNCHES == 1) { p.ph_lo = 0; p.ph_hi = N_PHASES; } else { p.ph_lo = li; p.ph_hi = li + 1; }
        hipLaunchKernelGGL(fns[li], dim3(grid), dim3(NWAVES * 64), LDS_BYTES, stream, p);
        const hipError_t le = hipPeekAtLastError();
        if (le != hipSuccess) { fprintf(stderr, "kernel_launch: launch %d failed: %s\n", li, hipGetErrorName(le)); break; }
    }
}
```

```cpp
#include <hip/hip_runtime.h>
#include <cstdio>
#include <cstdint>
#include <cmath>

#ifndef MK_N_LAUNCHES
#define MK_N_LAUNCHES 1
#endif

constexpr int MP = 32768;
constexpr int MS = 128;
constexpr int MREAL = MP + MS;
constexpr int MR = 33024;
constexpr int DM = 1024, SEQ = 2048, NBATCH = 16;
constexpr int ZC = 1536;
constexpr int LRU_W = 512, NHEAD = 8;
constexpr int QLR = 256, KVLR = 128, ROPE_D = 32, NOPE_D = 64, QKD = 96, VD = 64;
constexpr int DFF = 2816, UPC = 5632;
constexpr int NPAGES = 128, PAGE = 128;
constexpr int MODC = 6144;
constexpr float EPS = 1e-6f;
constexpr float C2 = 0.10206207261596575f * 1.4426950408889634f;

constexpr size_t O_YP = 0, O_YS = 33554432, O_KVP = 33685504, O_KRP = 37879808, O_LHP = 38928384, O_LCP = 38936576, O_FCP = 38961152,
                 O_KVS = 39141376, O_KRS = 39157760, O_LHS = 39161856, O_LCS = 39227392, O_FCS = 39424000, O_END = 40865792;

constexpr size_t MiB = 1u << 20;
constexpr size_t WS_CTL = 0, CTL_ZERO_BYTES = 1 * MiB;
constexpr size_t WS_WIN = 1 * MiB;
constexpr size_t WS_WUQ = 4 * MiB;
constexpr size_t WS_WUKV = 5 * MiB;
constexpr size_t WS_WO = 6 * MiB;
constexpr size_t WS_WUP = 8 * MiB;
constexpr size_t WS_WDN = 20 * MiB;
constexpr size_t WS_WADA = 26 * MiB;
constexpr size_t WS_WG = 38 * MiB;
constexpr size_t WS_SC = 39 * MiB;
constexpr size_t WS_MOD = 40 * MiB;
constexpr size_t WS_ROPE = 44 * MiB;
constexpr size_t WS_SUM = 45 * MiB;
constexpr size_t WS_CARRY = 47 * MiB;
constexpr size_t WS_PART = 48 * MiB;
constexpr size_t WS_H1 = 64 * MiB;
constexpr size_t WS_Z = 130 * MiB;
constexpr size_t WS_QN = 228 * MiB;
constexpr size_t WS_KVN = 246 * MiB;
constexpr size_t WS_KR = 264 * MiB;
constexpr size_t WS_HL = 268 * MiB;
constexpr size_t WS_AC = 302 * MiB;
constexpr size_t WS_QRAW = 336 * MiB;
constexpr size_t WS_KVRAW = 386 * MiB;
constexpr size_t WS_Q = 452 * MiB;
constexpr size_t WS_KF = 502 * MiB;
constexpr size_t WS_V = 552 * MiB;
constexpr size_t WS_ATT = 586 * MiB;
constexpr size_t WS_MIX = 620 * MiB;
constexpr size_t WS_UP = 686 * MiB;
constexpr size_t WS_ACT = 1042 * MiB;
constexpr size_t WS_RAW = 1221 * MiB;
constexpr size_t WS_X1 = 1246 * MiB;
constexpr size_t WS_SH2 = 1312 * MiB;
constexpr size_t WS_SB = 1313 * MiB;
constexpr size_t WS_ROWSS = WS_CTL + 256 * 1024;
constexpr size_t WS_END = 1318 * MiB;
constexpr int CW_TMO = 0, CW_BAR = 4096;

constexpr int RING_OFF = 0, RING_BYTES = 143360;
constexpr int LDSCTL_OFF = RING_BYTES, MISC_OFF = LDSCTL_OFF + 320;
constexpr int LDS_BYTES = 147456;
constexpr int NWAVES = 8;

namespace pg8 {
#define PG8_LAS __attribute__((address_space(3)))
typedef unsigned short bf16_t;
typedef short bf16x8 __attribute__((ext_vector_type(8)));
typedef float f32x4 __attribute__((ext_vector_type(4)));
typedef unsigned u32x4 __attribute__((ext_vector_type(4)));
constexpr int BM = 256, BK = 64, HALF = 128, HTB = HALF * BK * 2  , STAGE_BYTES = 8 * HTB, NXCD = 8, WGM = 8;

__host__ __device__ __forceinline__ int lds_byte(int r, int c) { const int st = (r >> 4) * 2 + (c >> 5), rr = r & 15, cc = c & 31, ob = rr * 64 + cc * 2; return st * 1024 + (ob ^ (((ob >> 9) & 1) << 5)); }
__host__ __device__ __forceinline__ void stage_rc(int b, int& R, int& C) { const int st = b / 1024, sb = b % 1024, swz = sb ^ (((sb >> 9) & 1) << 5); R = (st >> 1) * 16 + swz / 64; C = (st & 1) * 32 + (swz % 64) / 2; }
__host__ __device__ __forceinline__ int perm32(int rho) { const int n = rho >> 4, i = rho & 15; return 8 * (i >> 2) + 4 * n + (i & 3); }

struct Unit { int pm, pn; };
struct Gemm { const bf16_t* A; const bf16_t* Bt; int M, N, K; };

struct StaticOrder {
    int nM, nN, nwg, G, c;
    __host__ __device__ void init(int M, int N, int G_, int c_) { nM = M / BM; nN = N / BM; nwg = nM * nN; G = G_; c = c_; }
    __host__ __device__ bool next(int i, Unit& u) const {
        const long L = (long)i * G + c; if (L >= nwg) return false;
        int wgid = (int)L; { const int q = nwg / NXCD, r = nwg % NXCD, xcd = wgid % NXCD, off = wgid / NXCD; wgid = (xcd < r ? xcd * (q + 1) : r * (q + 1) + (xcd - r) * q) + off; }
        const int nig = WGM * nN, gid = wgid / nig, fm = gid * WGM, gsz = (nM - fm) < WGM ? (nM - fm) : WGM;
        u.pm = fm + ((wgid % nig) % gsz); u.pn = (wgid % nig) / gsz; return true;
    }
    __device__ __forceinline__ void a_ready(const Unit&) const {}
    __device__ __forceinline__ void done(const Unit&) const {}
};

__device__ __forceinline__ unsigned cvt_pk_bf16(float lo, float hi) { unsigned r; asm volatile("v_cvt_pk_bf16_f32 %0, %1, %2" : "=v"(r) : "v"(lo), "v"(hi)); return r; }
typedef float f32x2 __attribute__((ext_vector_type(2)));
__device__ __forceinline__ f32x2 gelu_pk(f32x2 v) {
    const f32x2 av = __builtin_elementwise_abs(v), d = av * 0.2316418882f + 1.0f;
    f32x2 t; t.x = __builtin_amdgcn_rcpf(d.x); t.y = __builtin_amdgcn_rcpf(d.y);
    f32x2 q = t * 0.5307027145f + (-0.7265760135f); q = q * t + 0.7107068705f; q = q * t + (-0.142248368f); q = q * t + 0.127414796f; q = q * t;
    const f32x2 s = (v * v) * (-0.72134752044f);
    f32x2 e; e.x = __builtin_amdgcn_exp2f(s.x); e.y = __builtin_amdgcn_exp2f(s.y);
    const f32x2 m = v * (q * e), r = v - m;
    f32x2 o; o.x = v.x < 0.f ? m.x : r.x; o.y = v.y < 0.f ? m.y : r.y; return o;
}

template <int ACT  > struct EpiBf16 {
    static constexpr bool PERM = true, AFTER_DRAIN = false, PERMA = false; static_assert(ACT == 0 || ACT == 1, "EpiBf16: ACT is 0 (none) or 1 (gelu_pk)");
    bf16_t* O; int ldc; const float* bias; int split_cols; size_t split_stride; float scale0;
    __device__ __forceinline__ void operator()(const f32x4 (&acc)[2][2][4][2], const Unit& u, int wr, int wc, int fr, int fq) const {
        const int row0 = u.pm * BM + wr * 64 + fr; int colt = u.pn * BM; bf16_t* base = O;
        float sc = 1.f; if (split_cols) { const int t = colt / split_cols; base += (size_t)t * split_stride; colt -= t * split_cols; if (t == 0) sc = scale0; }
        const int col0 = colt + wc * 32 + 8 * fq, bcol0 = u.pn * BM + wc * 32 + 8 * fq;
        f32x4 bv[2][2];
#pragma unroll
        for (int bj = 0; bj < 2; ++bj)
#pragma unroll
            for (int n = 0; n < 2; ++n) bv[bj][n] = bias ? *(const f32x4*)(bias + bcol0 + bj * HALF + 4 * n) : (f32x4){0.f, 0.f, 0.f, 0.f};
#pragma unroll
        for (int ai = 0; ai < 2; ++ai)
#pragma unroll
            for (int m = 0; m < 4; ++m) { bf16_t* rowp = base + (size_t)(row0 + ai * HALF + m * 16) * ldc + col0;
#pragma unroll
                for (int bj = 0; bj < 2; ++bj) { f32x4 v0 = acc[ai][bj][m][0] + bv[bj][0], v1 = acc[ai][bj][m][1] + bv[bj][1];
                    if (ACT == 1) { f32x2 a = gelu_pk((f32x2){v0[0], v0[1]}), b = gelu_pk((f32x2){v0[2], v0[3]}), c = gelu_pk((f32x2){v1[0], v1[1]}), d = gelu_pk((f32x2){v1[2], v1[3]});
                        v0 = (f32x4){a.x, a.y, b.x, b.y}; v1 = (f32x4){c.x, c.y, d.x, d.y}; }
                    v0 = v0 * sc; v1 = v1 * sc; u32x4 w; w.x = cvt_pk_bf16(v0[0], v0[1]); w.y = cvt_pk_bf16(v0[2], v0[3]); w.z = cvt_pk_bf16(v1[0], v1[1]); w.w = cvt_pk_bf16(v1[2], v1[3]);
                    *(u32x4*)(rowp + bj * HALF) = w; } }
    }
};

template <bool BASE_BF16, bool OUT_BF16, bool XG> struct EpiResGate {
    static constexpr bool PERM = OUT_BF16 || BASE_BF16, AFTER_DRAIN = false, PERMA = false;
    static constexpr int CN = PERM ? 4 : 16, CQ = PERM ? 8 : 4;
    const void* base; void* out; const float* mod; int goff; bf16_t* xg; const float* g2; float* rowss;
    typedef unsigned u32x2e __attribute__((ext_vector_type(2)));
    static constexpr int GM = BASE_BF16 ? 4 : 2, NG = 8 / GM;
    template <class BT> __device__ __forceinline__ void load_group(BT (&b)[GM * 4], int g, const Unit& u, int wr, int fr, int col0) const {
#pragma unroll
        for (int q = 0; q < GM; ++q) { const int am = g * GM + q; const size_t row = (size_t)(u.pm * BM + (am >> 2) * HALF + wr * 64 + (am & 3) * 16 + fr);
#pragma unroll
            for (int bj = 0; bj < 2; ++bj) {
                if constexpr (BASE_BF16 && PERM) { const u32x4 w = *(const u32x4*)((const bf16_t*)base + row * 1024 + col0 + bj * HALF); b[q * 4 + bj * 2] = (BT){w.x, w.y}; b[q * 4 + bj * 2 + 1] = (BT){w.z, w.w}; }
                else {
#pragma unroll
                    for (int n = 0; n < 2; ++n) b[q * 4 + bj * 2 + n] = *(const BT*)((const typename std::conditional<BASE_BF16, bf16_t, float>::type*)base + row * 1024 + col0 + bj * HALF + n * CN); } } }
    }
    __device__ __forceinline__ void operator()(const f32x4 (&acc)[2][2][4][2], const Unit& u, int wr, int wc, int fr, int fq) const {
        typedef typename std::conditional<BASE_BF16, u32x2e, f32x4>::type BT;
        const int col0 = u.pn * BM + wc * 32 + CQ * fq;
        const float* mrow = mod + (size_t)((u.pm * BM) >> 11) * 6144;
        BT ring[2][GM * 4];
        load_group(ring[0], 0, u, wr, fr, col0);
        f32x4 gt[2][2], G2[2][2];
#pragma unroll
        for (int bj = 0; bj < 2; ++bj)
#pragma unroll
            for (int n = 0; n < 2; ++n) { const int c = col0 + bj * HALF + n * CN; gt[bj][n] = *(const f32x4*)(mrow + goff + c);
                if (XG) G2[bj][n] = *(const f32x4*)(g2 + c) * (*(const f32x4*)(mrow + 4096 + c) + 1.0f); }
#pragma unroll
        for (int g = 0; g < NG; ++g) {
            if (g + 1 < NG) load_group(ring[(g + 1) & 1], g + 1, u, wr, fr, col0);
            asm volatile("" ::: "memory");
#pragma unroll
            for (int q = 0; q < GM; ++q) { const int am = g * GM + q, ai = am >> 2, m = am & 3;
                const size_t row = (size_t)(u.pm * BM + ai * HALF + wr * 64 + m * 16 + fr);
                float ss = 0.f;
#pragma unroll
                for (int bj = 0; bj < 2; ++bj) { u32x2e wo[2], wx[2];
#pragma unroll
                    for (int n = 0; n < 2; ++n) { const int c = col0 + bj * HALF + n * CN;
                        f32x4 bs;
                        if constexpr (BASE_BF16) { const u32x2e w = ring[g & 1][q * 4 + bj * 2 + n]; bs = (f32x4){__uint_as_float(w.x << 16), __uint_as_float(w.x & 0xffff0000u), __uint_as_float(w.y << 16), __uint_as_float(w.y & 0xffff0000u)}; }
                        else bs = ring[g & 1][q * 4 + bj * 2 + n];
                        const f32x4 o = bs + gt[bj][n] * acc[ai][bj][m][n];
                        if (OUT_BF16) { wo[n].x = cvt_pk_bf16(o[0], o[1]); wo[n].y = cvt_pk_bf16(o[2], o[3]); if (!PERM) *(u32x2e*)((bf16_t*)out + row * 1024 + c) = wo[n]; }
                        else *(f32x4*)((float*)out + row * 1024 + c) = o;
                        if (XG) { const f32x4 x = o * G2[bj][n]; wx[n].x = cvt_pk_bf16(x[0], x[1]); wx[n].y = cvt_pk_bf16(x[2], x[3]); if (!PERM) *(u32x2e*)(xg + row * 1024 + c) = wx[n];
                            ss += (o[0] * o[0] + o[1] * o[1]) + (o[2] * o[2] + o[3] * o[3]); } }
                    if (PERM) { const int c8 = col0 + bj * HALF;
                        if (OUT_BF16) *(u32x4*)((bf16_t*)out + row * 1024 + c8) = (u32x4){wo[0].x, wo[0].y, wo[1].x, wo[1].y};
                        if (XG) *(u32x4*)(xg + row * 1024 + c8) = (u32x4){wx[0].x, wx[0].y, wx[1].x, wx[1].y}; } }
                if (XG) {
                    { auto rr = __builtin_amdgcn_permlane16_swap(__float_as_uint(ss), __float_as_uint(ss), false, false); ss = __uint_as_float(rr[0]) + __uint_as_float(rr[1]); }
                    { auto rr = __builtin_amdgcn_permlane32_swap(__float_as_uint(ss), __float_as_uint(ss), false, false); ss = __uint_as_float(rr[0]) + __uint_as_float(rr[1]); }
                    if (fq == 0) __hip_atomic_fetch_add(rowss + row, ss, __ATOMIC_RELAXED, __HIP_MEMORY_SCOPE_AGENT); }
            }
        }
    }
};


__device__ __forceinline__ float dpp_shr1(float v) { return __builtin_bit_cast(float, __builtin_amdgcn_update_dpp(0, __builtin_bit_cast(int, v), 0x111, 0xf, 0xf, false)); }
__device__ __forceinline__ float gelu_tanh_e(float x) { const float u = 0.7978845608028654f * (x + 0.044715f * x * x * x); return x * __builtin_amdgcn_rcpf(1.0f + __builtin_amdgcn_exp2f(-2.8853900817779268f * u)); }
#ifndef CW1_AT
#define CW1_AT 7
#endif
struct EpiConvGelu {
    static constexpr bool PERM = true, AFTER_DRAIN = false, PERMA = true;
    bf16_t* ACT; float* RAW; const float* fw; const float* fb; const float* rowss; const float* SB;
    __device__ __forceinline__ void operator()(const f32x4 (&acc_)[2][2][4][2], const Unit& u, int wr, int wc, int fr_, int fq_) const {
        f32x4 (&acc)[2][2][4][2] = const_cast<f32x4 (&)[2][2][4][2]>(acc_);
        int ln_; asm volatile("v_mbcnt_lo_u32_b32 %0, -1, 0\n\tv_mbcnt_hi_u32_b32 %0, -1, %0" : "=v"(ln_)); const int fr = ln_ & 15, fq = ln_ >> 4; (void)fr_; (void)fq_;
        const int tb = u.pm * BM + wr * 128 + fr * 8;
        { const f32x4 s0 = *(const f32x4*)(rowss + tb), s1 = *(const f32x4*)(rowss + tb + 4);
          float rs[8]; rs[0] = s0[0]; rs[1] = s0[1]; rs[2] = s0[2]; rs[3] = s0[3]; rs[4] = s1[0]; rs[5] = s1[1]; rs[6] = s1[2]; rs[7] = s1[3];
#pragma unroll
          for (int j = 0; j < 8; ++j) rs[j] = __builtin_amdgcn_rsqf(rs[j] * (1.f / 1024.f) + 1e-6f);
          const float* sbp = SB + (size_t)((u.pm * BM) >> 11) * 5632 + u.pn * BM + wc * 32 + fq * 8;
#pragma unroll
          for (int bj = 0; bj < 2; ++bj)
#pragma unroll
              for (int n = 0; n < 2; ++n) { const f32x4 sb = *(const f32x4*)(sbp + bj * HALF + 4 * n);
#pragma unroll
                  for (int j = 0; j < 8; ++j) acc[j >> 2][bj][j & 3][n] = acc[j >> 2][bj][j & 3][n] * rs[j] + sb; } }
        const int cb = u.pn * 128 + wc * 32 + fq * 8;
        const int blk = u.pm * 2 + wr;
        f32x4 cw[2][8];
#define CW_LOAD(n) do { const int c0_ = cb + 4 * (n); \
            cw[n][0] = *(const f32x4*)(fw + c0_); cw[n][1] = *(const f32x4*)(fw + 5632 + c0_); cw[n][2] = *(const f32x4*)(fw + 11264 + c0_); cw[n][3] = *(const f32x4*)(fb + c0_); \
            cw[n][4] = *(const f32x4*)(fw + 2816 + c0_); cw[n][5] = *(const f32x4*)(fw + 5632 + 2816 + c0_); cw[n][6] = *(const f32x4*)(fw + 11264 + 2816 + c0_); cw[n][7] = *(const f32x4*)(fb + 2816 + c0_); } while (0)
#pragma unroll
        for (int n = 0; n < 2; ++n) {
            const int c0 = cb + 4 * n;
            if (n == 0) CW_LOAD(0);
            const f32x4 wv0 = cw[n][0], wv1 = cw[n][1], wv2 = cw[n][2], bv = cw[n][3], wg0 = cw[n][4], wg1 = cw[n][5], wg2 = cw[n][6], bg = cw[n][7];
            f32x4 pv1, pv2, pg1, pg2;
#pragma unroll
            for (int e = 0; e < 4; ++e) { pv1[e] = dpp_shr1(acc[1][0][3][n][e]); pv2[e] = dpp_shr1(acc[1][0][2][n][e]); pg1[e] = dpp_shr1(acc[1][1][3][n][e]); pg2[e] = dpp_shr1(acc[1][1][2][n][e]); }
#pragma unroll
            for (int j = 0; j < 8; ++j) { const int ai = j >> 2, m = j & 3;
                if (n == 0 && j == 1) {
                    if (fr == 15) { float* r = RAW + (size_t)blk * 4 * 5632;
#pragma unroll
                        for (int n2 = 0; n2 < 2; ++n2) { const int c2 = cb + 4 * n2;
                            *(f32x4*)(r + c2) = acc[1][0][2][n2]; *(f32x4*)(r + 2816 + c2) = acc[1][1][2][n2]; *(f32x4*)(r + 5632 + c2) = acc[1][0][3][n2]; *(f32x4*)(r + 5632 + 2816 + c2) = acc[1][1][3][n2]; } }
                    if (fr == 0) { float* r = RAW + ((size_t)blk * 4 + 2) * 5632;
#pragma unroll
                        for (int n2 = 0; n2 < 2; ++n2) { const int c2 = cb + 4 * n2;
                            *(f32x4*)(r + c2) = acc[0][0][0][n2]; *(f32x4*)(r + 2816 + c2) = acc[0][1][0][n2]; *(f32x4*)(r + 5632 + c2) = acc[0][0][1][n2]; *(f32x4*)(r + 5632 + 2816 + c2) = acc[0][1][1][n2]; } } }
                if (n == 0 && j == CW1_AT) CW_LOAD(1);
                const f32x4 v = acc[ai][0][m][n], g = acc[ai][1][m][n];
                const f32x4 val = bv + wv0 * pv2 + wv1 * pv1 + wv2 * v, gt = bg + wg0 * pg2 + wg1 * pg1 + wg2 * g;
                u32x4 dummy; (void)dummy;
                const unsigned p0 = cvt_pk_bf16(gelu_tanh_e(gt[0]) * val[0], gelu_tanh_e(gt[1]) * val[1]), p1 = cvt_pk_bf16(gelu_tanh_e(gt[2]) * val[2], gelu_tanh_e(gt[3]) * val[3]);
                typedef unsigned u32x2e __attribute__((ext_vector_type(2)));
                *(u32x2e*)(ACT + (size_t)(tb + j) * 2816 + c0) = (u32x2e){p0, p1};
                pv2 = pv1; pv1 = v; pg2 = pg1; pg1 = g; }
        }
#undef CW_LOAD
    }
};

template <bool PA> struct EpiNull {
    static constexpr bool PERM = false, AFTER_DRAIN = false, PERMA = PA;
    __device__ __forceinline__ void operator()(const f32x4 (&acc)[2][2][4][2], const Unit& u, int wr, int wc, int fr, int fq) const {
#pragma unroll
        for (int i = 0; i < 32; ++i) asm volatile("" :: "v"(acc[i >> 4][(i >> 3) & 1][(i >> 1) & 3][i & 1]));
    }
};

template <int MODE> struct EpiProbe {
    static constexpr bool PERM = false, AFTER_DRAIN = false, PERMA = false;
    float* out; const bf16_t* base;
    __device__ __forceinline__ void operator()(const f32x4 (&acc)[2][2][4][2], const Unit& u, int wr, int wc, int fr, int fq) const {
        typedef unsigned u32x2e __attribute__((ext_vector_type(2)));
        const int col0 = u.pn * BM + wc * 32 + 4 * fq;
#pragma unroll
        for (int am = 0; am < 8; ++am) { const int ai = am >> 2, m = am & 3; const size_t row = (size_t)(u.pm * BM + ai * HALF + wr * 64 + m * 16 + fr);
#pragma unroll
            for (int bj = 0; bj < 2; ++bj)
#pragma unroll
                for (int n = 0; n < 2; ++n) { const int c = col0 + bj * HALF + n * 16;
                    if (MODE == 0) *(f32x4*)(out + row * 1024 + c) = acc[ai][bj][m][n];
                    else if (MODE == 1) { const u32x2e w = *(const u32x2e*)(base + row * 1024 + c); asm volatile("" :: "v"(w), "v"(acc[ai][bj][m][n])); }
                    else { u32x2e w; w.x = cvt_pk_bf16(acc[ai][bj][m][n][0], acc[ai][bj][m][n][1]); w.y = cvt_pk_bf16(acc[ai][bj][m][n][2], acc[ai][bj][m][n][3]); *(u32x2e*)((bf16_t*)out + row * 1024 + c) = w; } } }
    }
};
template <class Epi, class Sched, bool ALIGN_EPI = false, bool SP2 = false>
__device__ __forceinline__ void gemm_phase(PG8_LAS unsigned char* lds, const Gemm g, const Sched& S, const Epi& E, const int tid) {
    const int wid = __builtin_amdgcn_readfirstlane(tid >> 6), lane = tid & 63, wr = wid >> 2, wc = wid & 3, fr = lane & 15, fq = lane >> 4;
    const int K = g.K, nt = K / BK;
    unsigned voffA[2], voffB[2];
#pragma unroll
    for (int i = 0; i < 2; ++i) { int R, C; stage_rc(tid * 16 + i * 8192, R, C); const int Rb = Epi::PERM ? ((R & ~31) + perm32(R & 31)) : R;
        const int Ra = Epi::PERMA ? (128 * (R >> 6) + 8 * (R & 15) + ((R >> 4) & 3)) : R;
        voffA[i] = (unsigned)(Ra * K + C) * 2u; voffB[i] = (unsigned)(Rb * K + C) * 2u; }
    const size_t kstep = (size_t)(BK * 2);
    const size_t hstep = (size_t)HALF * K * 2;
    const size_t hstepA = Epi::PERMA ? (size_t)4 * K * 2 : hstep;
    const size_t tstep = 2 * hstep;
    const unsigned ldsw = (unsigned)wid * 1024u;
    const int aoff = lds_byte(wr * 64 + fr, fq * 8), boff = lds_byte(wc * 32 + fr, fq * 8);
#define PG8_SA(b, h) (((b) * 2 + (h)) * HTB)
#define PG8_SB(b, h) ((4 + (b) * 2 + (h)) * HTB)
#define PG8_STAGE(bufoff, gbase, voff) do { _Pragma("unroll") for (int _i = 0; _i < 2; ++_i) \
        __builtin_amdgcn_global_load_lds((const unsigned*)((const char*)(gbase) + (voff)[_i]), (PG8_LAS unsigned*)(lds + (bufoff) + ldsw + _i * 8192), 16, 0, 0); } while (0)
#define PG8_LDA(dst, b, h) do { _Pragma("unroll") for (int m = 0; m < 4; ++m) _Pragma("unroll") for (int k = 0; k < 2; ++k) dst[m][k] = *(const PG8_LAS bf16x8*)(lds + PG8_SA(b, h) + aoff + m * 2048 + k * 1024); } while (0)
#define PG8_LDB(dst, b, h) do { _Pragma("unroll") for (int n = 0; n < 2; ++n) _Pragma("unroll") for (int k = 0; k < 2; ++k) dst[n][k] = *(const PG8_LAS bf16x8*)(lds + PG8_SB(b, h) + boff + n * 2048 + k * 1024); } while (0)
#define PG8_MMA(ai, bj, At, Bt) do { __builtin_amdgcn_s_setprio(1); _Pragma("unroll") for (int m = 0; m < 4; ++m) _Pragma("unroll") for (int n = 0; n < 2; ++n) _Pragma("unroll") for (int k = 0; k < 2; ++k) \
        acc[ai][bj][m][n] = __builtin_amdgcn_mfma_f32_16x16x32_bf16(Bt[n][k], At[m][k], acc[ai][bj][m][n], 0, 0, 0); __builtin_amdgcn_s_setprio(0); } while (0)
#define PG8_WAIT_V(n) asm volatile("s_waitcnt vmcnt(" #n ")" ::: "memory")
#define PG8_WAIT_L(n) asm volatile("s_waitcnt lgkmcnt(" #n ")" ::: "memory")
#define PG8_BAR __builtin_amdgcn_s_barrier()
#define PG8_SCHED __builtin_amdgcn_sched_barrier(0)
    Unit cur, nxt; int ui = 0;
    if (!S.next(0, cur)) return;
    f32x4 acc[2][2][4][2];
#pragma unroll
    for (int a = 0; a < 2; ++a)
#pragma unroll
        for (int b = 0; b < 2; ++b)
#pragma unroll
            for (int m = 0; m < 4; ++m)
#pragma unroll
                for (int n = 0; n < 2; ++n) acc[a][b][m][n] = (f32x4){0.f, 0.f, 0.f, 0.f};
    bf16x8 At[4][2], B0[2][2], B1[2][2];
    const char* cA = (const char*)g.A + (size_t)cur.pm * tstep; const char* cB = (const char*)g.Bt + (size_t)cur.pn * tstep;
    S.a_ready(cur);
    if constexpr (SP2) {
        PG8_STAGE(PG8_SB(0, 0), cB, voffB); PG8_STAGE(PG8_SB(0, 1), cB + hstep, voffB); PG8_STAGE(PG8_SA(0, 0), cA, voffA); PG8_STAGE(PG8_SA(0, 1), cA + hstepA, voffA);
        if (wr == 1) PG8_BAR;
        PG8_WAIT_V(2); PG8_BAR;
        PG8_STAGE(PG8_SB(1, 0), cB + kstep, voffB); PG8_STAGE(PG8_SA(1, 0), cA + kstep, voffA); PG8_STAGE(PG8_SB(1, 1), cB + hstep + kstep, voffB);
        PG8_WAIT_V(6); PG8_BAR;
    } else {
        PG8_STAGE(PG8_SB(0, 0), cB, voffB); PG8_STAGE(PG8_SA(0, 0), cA, voffA); PG8_STAGE(PG8_SB(0, 1), cB + hstep, voffB); PG8_STAGE(PG8_SA(0, 1), cA + hstepA, voffA);
        if (wr == 1) PG8_BAR;
        PG8_WAIT_V(4); PG8_BAR;
        PG8_STAGE(PG8_SB(1, 0), cB + kstep, voffB); PG8_STAGE(PG8_SA(1, 0), cA + kstep, voffA); PG8_STAGE(PG8_SB(1, 1), cB + hstep + kstep, voffB);
        PG8_WAIT_V(6); PG8_BAR;
    }
    for (;;) {
        const bool has_next = S.next(ui + 1, nxt);
        const char* nA = has_next ? (const char*)g.A + (size_t)nxt.pm * tstep : cA; const char* nB = has_next ? (const char*)g.Bt + (size_t)nxt.pn * tstep : cB;
        for (int t = 0; t < nt; t += 2) {
            const bool last = (t == nt - 2);
            const char* a1 = cA + (size_t)(t + 1) * kstep;
            const char* a2 = last ? nA : cA + (size_t)(t + 2) * kstep; const char* b2 = last ? nB : cB + (size_t)(t + 2) * kstep;
            const char* a3 = a2 + kstep; const char* b3 = b2 + kstep;
            if (last && has_next) S.a_ready(nxt);
            if constexpr (SP2) {
            PG8_LDB(B0, 0, 0); PG8_LDB(B1, 0, 1); PG8_SCHED; PG8_LDA(At, 0, 0); PG8_STAGE(PG8_SA(1, 1), a1 + hstepA, voffA);
            PG8_WAIT_V(8); PG8_WAIT_L(0); PG8_BAR; PG8_MMA(0, 0, At, B0); PG8_MMA(0, 1, At, B1); PG8_BAR; PG8_SCHED;
            PG8_LDA(At, 0, 1); PG8_STAGE(PG8_SB(0, 0), b2, voffB); PG8_STAGE(PG8_SB(0, 1), b2 + hstep, voffB); PG8_STAGE(PG8_SA(0, 0), a2, voffA);
            PG8_WAIT_V(8); PG8_WAIT_L(0); PG8_BAR; PG8_MMA(1, 0, At, B0); PG8_MMA(1, 1, At, B1); PG8_BAR; PG8_SCHED;
            PG8_LDB(B0, 1, 0); PG8_LDB(B1, 1, 1); PG8_SCHED; PG8_LDA(At, 1, 0); PG8_STAGE(PG8_SA(0, 1), a2 + hstepA, voffA);
            PG8_WAIT_V(8); PG8_WAIT_L(0); PG8_BAR; PG8_MMA(0, 0, At, B0); PG8_MMA(0, 1, At, B1); PG8_BAR; PG8_SCHED;
            PG8_LDA(At, 1, 1); PG8_STAGE(PG8_SB(1, 0), b3, voffB); PG8_STAGE(PG8_SB(1, 1), b3 + hstep, voffB); PG8_STAGE(PG8_SA(1, 0), a3, voffA);
            PG8_WAIT_V(8); PG8_WAIT_L(0); PG8_BAR; PG8_MMA(1, 0, At, B0); PG8_MMA(1, 1, At, B1); PG8_BAR; PG8_SCHED;
            } else {
            PG8_LDB(B0, 0, 0); PG8_SCHED; PG8_LDA(At, 0, 0); PG8_STAGE(PG8_SA(1, 1), a1 + hstepA, voffA);
            PG8_WAIT_L(8); PG8_BAR; PG8_WAIT_L(0); PG8_MMA(0, 0, At, B0); PG8_BAR; PG8_SCHED;
            PG8_LDB(B1, 0, 1); PG8_STAGE(PG8_SB(0, 0), b2, voffB);
            PG8_BAR; PG8_WAIT_L(0); PG8_MMA(0, 1, At, B1); PG8_BAR;
            PG8_LDA(At, 0, 1); PG8_STAGE(PG8_SA(0, 0), a2, voffA);
            PG8_BAR; PG8_WAIT_L(0); PG8_MMA(1, 0, At, B0); PG8_BAR; PG8_SCHED;
            PG8_STAGE(PG8_SB(0, 1), b2 + hstep, voffB);
            PG8_WAIT_V(6); PG8_BAR; PG8_MMA(1, 1, At, B1); PG8_BAR;
            PG8_LDB(B0, 1, 0); PG8_SCHED; PG8_LDA(At, 1, 0); PG8_STAGE(PG8_SA(0, 1), a2 + hstepA, voffA);
            PG8_WAIT_L(8); PG8_BAR; PG8_WAIT_L(0); PG8_MMA(0, 0, At, B0); PG8_BAR; PG8_SCHED;
            PG8_LDB(B1, 1, 1); PG8_STAGE(PG8_SB(1, 0), b3, voffB);
            PG8_BAR; PG8_WAIT_L(0); PG8_MMA(0, 1, At, B1); PG8_BAR;
            PG8_LDA(At, 1, 1); PG8_STAGE(PG8_SA(1, 0), a3, voffA);
            PG8_BAR; PG8_WAIT_L(0); PG8_MMA(1, 0, At, B0); PG8_BAR; PG8_SCHED;
            PG8_STAGE(PG8_SB(1, 1), b3 + hstep, voffB);
            PG8_WAIT_V(6); PG8_BAR; PG8_MMA(1, 1, At, B1); PG8_BAR;
            }
        }
        if constexpr (ALIGN_EPI) { if (wr == 0) PG8_BAR; }
        if constexpr (!Epi::AFTER_DRAIN) { E(acc, cur, wr, wc, fr, fq); S.done(cur); }
        if (!has_next) break;
#pragma unroll
        for (int a = 0; a < 2; ++a)
#pragma unroll
            for (int b = 0; b < 2; ++b)
#pragma unroll
                for (int m = 0; m < 4; ++m)
#pragma unroll
                    for (int n = 0; n < 2; ++n) acc[a][b][m][n] = (f32x4){0.f, 0.f, 0.f, 0.f};
        cur = nxt; cA = nA; cB = nB; ++ui;
        if constexpr (ALIGN_EPI) { if (wr == 1) PG8_BAR; }
    }
    PG8_WAIT_V(0);
    if constexpr (!ALIGN_EPI) { if (wr == 0) PG8_BAR; }
    PG8_BAR;
    if constexpr (Epi::AFTER_DRAIN) { E.fused(acc, cur, wr, wc, fr, fq, lds, wid, lane); S.done(cur); }
#undef PG8_SA
#undef PG8_SB
#undef PG8_STAGE
#undef PG8_LDA
#undef PG8_LDB
#undef PG8_MMA
#undef PG8_WAIT_V
#undef PG8_WAIT_L
#undef PG8_BAR
#undef PG8_SCHED
}
}
#define GAS __attribute__((address_space(1)))
#define LAS __attribute__((address_space(3)))
typedef unsigned short bf16;
typedef unsigned v4u __attribute__((ext_vector_type(4)));
typedef float f32x4 __attribute__((ext_vector_type(4)));
typedef short bf16x8 __attribute__((ext_vector_type(8)));
typedef GAS unsigned gu32;
typedef GAS unsigned long long gu64;
#define RLX_AGENT __ATOMIC_RELAXED, __HIP_MEMORY_SCOPE_AGENT
#define LDS_WAIT() asm volatile("s_waitcnt lgkmcnt(0)" ::: "memory")
#define VM_WAIT() asm volatile("s_waitcnt vmcnt(0)" ::: "memory")
__device__ __forceinline__ unsigned long long rt() { return __builtin_amdgcn_s_memrealtime(); }
typedef float f32x2_cv __attribute__((ext_vector_type(2))); typedef __bf16 bf16x2_cv __attribute__((ext_vector_type(2)));
__device__ __forceinline__ unsigned pk2(float lo, float hi) { f32x2_cv v = {lo, hi}; bf16x2_cv b = __builtin_convertvector(v, bf16x2_cv); return __builtin_bit_cast(unsigned, b); }
__device__ __forceinline__ unsigned f2bf(float f) { return pk2(f, f) & 0xffffu; }
#define XB_TMO      128
#define XB_XCNT(j)  (256  + 64 * (j))
#define XB_XSUB(j)  (1280 + 64 * (j))
#define XB_XGEN(j)  (2304 + 64 * (j))
#define XB_TOP      3328
#define XB_TOPGEN   3392
#define XCD_BAR_WORDS 3456
#define XB_SPIN_CAP (1u << 18)

__device__ __forceinline__ unsigned xb_ld(unsigned* p)              { return __hip_atomic_load(p, __ATOMIC_RELAXED, __HIP_MEMORY_SCOPE_AGENT); }
__device__ __forceinline__ unsigned xb_add(unsigned* p, unsigned v) { return __hip_atomic_fetch_add(p, v, __ATOMIC_RELAXED, __HIP_MEMORY_SCOPE_AGENT); }
__device__ __forceinline__ unsigned xb_xcc_id() { return (unsigned)__builtin_amdgcn_s_getreg((3 << 11) | 20) & 0xFu; }
#define XB_SPIN(cond, bar) do { unsigned _sp = 0; while (cond) { __builtin_amdgcn_s_sleep(1); \
    if ((++_sp & 255u) == 0u) { if (xb_ld(&(bar)[XB_TMO])) break; if (_sp > XB_SPIN_CAP) { atomicAdd(&(bar)[XB_TMO], 1u); break; } } } } while (0)

struct XcdBarrier {
    unsigned* bar; unsigned x;
    volatile LAS unsigned* st;
};

__device__ __forceinline__ XcdBarrier xcd_barrier_post(unsigned* bar, volatile LAS unsigned* st, int tid) {
    XcdBarrier b; b.bar = bar; b.x = xb_xcc_id(); b.st = st;
    if (tid == 0) (void)xb_add(&bar[XB_XCNT(b.x)], 1u);
    return b;
}
__device__ __forceinline__ void xcd_barrier_complete(unsigned* bar, unsigned x, unsigned& nloc, unsigned& nx) {
    const unsigned G = gridDim.x * gridDim.y * gridDim.z;
    unsigned sum, cnt, mine, sp = 0u;
    for (;;) {
        sum = 0u; cnt = 0u; mine = 0u;
#pragma unroll
        for (unsigned j = 0; j < 16; ++j) { const unsigned c = xb_ld(&bar[XB_XCNT(j)]); sum += c; cnt += (c > 0u) ? 1u : 0u; mine = (j == x) ? c : mine; }
        if (sum == G) break;
        __builtin_amdgcn_s_sleep(1);
        if ((++sp & 255u) == 0u) { if (xb_ld(&bar[XB_TMO])) break; if (sp > XB_SPIN_CAP) { atomicAdd(&bar[XB_TMO], 1u); break; } }
    }
    nloc = mine > 0u ? mine : 1u; nx = cnt > 0u ? cnt : 1u;
}

__device__ __forceinline__ void xcd_barrier(const XcdBarrier& b, int tid) {
    asm volatile("s_waitcnt vmcnt(0)" ::: "memory");
    __syncthreads();
    if (tid == 0) {
        unsigned* bar = b.bar;
        __builtin_amdgcn_s_waitcnt(0);
        unsigned nloc = b.st[0], nx = b.st[1];
        if (nloc == 0u) { xcd_barrier_complete(bar, b.x, nloc, nx); b.st[0] = nloc; b.st[1] = nx; }
        const unsigned old = xb_add(&bar[XB_XSUB(b.x)], 1u);
        const unsigned gen = old / nloc;
        if (old + 1u == (gen + 1u) * nloc) {
            __builtin_amdgcn_fence(__ATOMIC_RELEASE, "agent");
            asm volatile("s_waitcnt vmcnt(0)" ::: "memory");
            const unsigned og = xb_add(&bar[XB_TOP], 1u);
            const unsigned tg = og / nx;
            if (og + 1u == (tg + 1u) * nx) xb_add(&bar[XB_TOPGEN], 1u);
            else XB_SPIN(xb_ld(&bar[XB_TOPGEN]) == tg, bar);
            __builtin_amdgcn_fence(__ATOMIC_ACQUIRE, "agent");
            xb_add(&bar[XB_XGEN(b.x)], 1u);
            asm volatile("s_waitcnt vmcnt(0)" ::: "memory");
        } else {
            XB_SPIN(xb_ld(&bar[XB_XGEN(b.x)]) == gen, bar);
            __builtin_amdgcn_fence(__ATOMIC_ACQUIRE, "agent");
            asm volatile("s_waitcnt vmcnt(0)" ::: "memory");
        }
    }
    __syncthreads();
}

typedef float f32x16 __attribute__((ext_vector_type(16)));
typedef float f32x2 __attribute__((ext_vector_type(2)));
typedef unsigned v2u __attribute__((ext_vector_type(2)));
typedef short s16x4 __attribute__((ext_vector_type(4)));

struct Params { const float* in[37]; float* out; unsigned char* ws; int ph_lo, ph_hi; };

__device__ __forceinline__ float bf2f(unsigned short b) { return __uint_as_float(((unsigned)b) << 16); }
__device__ __forceinline__ float bflo(unsigned w) { return __uint_as_float(w << 16); }
__device__ __forceinline__ float bfhi(unsigned w) { return __uint_as_float(w & 0xffff0000u); }
#define DPPF0(v, ctrl) __builtin_bit_cast(float, __builtin_amdgcn_update_dpp(__builtin_bit_cast(int, v), __builtin_bit_cast(int, v), ctrl, 0xf, 0xf, false))
__device__ __forceinline__ float row16_sum(float v) { v += DPPF0(v, 0xB1); v += DPPF0(v, 0x4E); v += DPPF0(v, 0x141); v += DPPF0(v, 0x140); return v; }
__device__ __forceinline__ float lane_xor16(float v, int lane) { auto rr = __builtin_amdgcn_permlane16_swap(__float_as_uint(v), __float_as_uint(v), false, false); return __uint_as_float((lane & 16) ? rr[0] : rr[1]); }
__device__ __forceinline__ float lane_xor32(float v, int lane) { auto rr = __builtin_amdgcn_permlane32_swap(__float_as_uint(v), __float_as_uint(v), false, false); return __uint_as_float((lane & 32) ? rr[0] : rr[1]); }
__device__ __forceinline__ float wave_sum(float v) {
    v = row16_sum(v);
    { auto rr = __builtin_amdgcn_permlane16_swap(__float_as_uint(v), __float_as_uint(v), false, false); v = __uint_as_float(rr[0]) + __uint_as_float(rr[1]); }
    { auto rr = __builtin_amdgcn_permlane32_swap(__float_as_uint(v), __float_as_uint(v), false, false); v = __uint_as_float(rr[0]) + __uint_as_float(rr[1]); }
    return v;
}
__device__ __forceinline__ void unpack8f(const v4u& w, float* v) { v[0] = bflo(w.x); v[1] = bfhi(w.x); v[2] = bflo(w.y); v[3] = bfhi(w.y); v[4] = bflo(w.z); v[5] = bfhi(w.z); v[6] = bflo(w.w); v[7] = bfhi(w.w); }
__device__ __forceinline__ float wave_max(float v) {
#pragma unroll
    for (int o = 1; o < 64; o <<= 1) v = fmaxf(v, __shfl_xor(v, o));
    return v;
}
__device__ __forceinline__ float dpp_f(float v, int ctrl_dummy);
#define DPPF(v, ctrl) __builtin_bit_cast(float, __builtin_amdgcn_update_dpp(__builtin_bit_cast(int, v), __builtin_bit_cast(int, v), ctrl, 0xf, 0xf, false))
__device__ __forceinline__ float half_max32(float v) {
    v = fmaxf(v, DPPF(v, 0xB1)); v = fmaxf(v, DPPF(v, 0x4E)); v = fmaxf(v, DPPF(v, 0x141)); v = fmaxf(v, DPPF(v, 0x140));
    auto rr = __builtin_amdgcn_permlane16_swap(__float_as_uint(v), __float_as_uint(v), false, false);
    return fmaxf(__uint_as_float(rr[0]), __uint_as_float(rr[1]));
}
__device__ __forceinline__ float gelu_tanh(float x) {
    const float u = 0.7978845608028654f * (x + 0.044715f * x * x * x);
    return x * __builtin_amdgcn_rcpf(1.0f + __builtin_amdgcn_exp2f(-2.8853900817779268f * u));
}
__device__ __forceinline__ float sigmoidf_(float x) { return __builtin_amdgcn_rcpf(1.0f + __builtin_amdgcn_exp2f(-1.4426950408889634f * x)); }
__device__ __forceinline__ f32x16 mfma32(bf16x8 a, bf16x8 b, f32x16 c) { return __builtin_amdgcn_mfma_f32_32x32x16_bf16(a, b, c, 0, 0, 0); }
__device__ __forceinline__ f32x4 mfma16(bf16x8 a, bf16x8 b, f32x4 c) { return __builtin_amdgcn_mfma_f32_16x16x32_bf16(a, b, c, 0, 0, 0); }
__device__ __forceinline__ int crow(int r, int hi) { return (r & 3) + 8 * (r >> 2) + 4 * hi; }
__device__ __forceinline__ bf16x8 pack8(const float* v) { v4u w; w.x = pk2(v[0], v[1]); w.y = pk2(v[2], v[3]); w.z = pk2(v[4], v[5]); w.w = pk2(v[6], v[7]); return __builtin_bit_cast(bf16x8, w); }
__device__ __forceinline__ float xhalf_sum(float v) { auto rr = __builtin_amdgcn_permlane32_swap(__float_as_uint(v), __float_as_uint(v), false, false); return __uint_as_float(rr[0]) + __uint_as_float(rr[1]); }

__device__ __forceinline__ int fresh_lane() { int l; asm volatile("v_mbcnt_lo_u32_b32 %0, -1, 0\n\tv_mbcnt_hi_u32_b32 %0, -1, %0" : "=v"(l)); return l; }
struct Ctx {
    LAS unsigned char* lds; int tid, lane, wave, G, bid;
    const Params* p;
};
#define WSP(T, off) ((T*)(P.ws + (off)))

template <bool UPPERM = false> __device__ __forceinline__ void p0_transpose_item(const float* W, int N, bf16* WT, int ldk, LAS float* scr, int nblk, int item, int lane) {
    const int kb = item / nblk, nb = item % nblk, k0 = 64 * kb, n0 = 32 * nb;
    const int d0 = UPPERM ? ((n0 < DFF) ? (256 * (n0 >> 7) + (n0 & 127)) : (256 * ((n0 - DFF) >> 7) + 128 + ((n0 - DFF) & 127))) : n0;
#pragma unroll 8
    for (int i = 0; i < 32; ++i) { const int kk = 2 * i + (lane >> 5); scr[kk * 33 + (lane & 31)] = W[(size_t)(k0 + kk) * N + n0 + (lane & 31)]; }
    LDS_WAIT(); asm volatile("" ::: "memory");
    const int c = lane & 7;
#pragma unroll
    for (int j = 0; j < 4; ++j) { const int n = (lane >> 3) + 8 * j; const LAS float* s = scr + (8 * c) * 33 + n;
        v4u o; o.x = pk2(s[0 * 33], s[1 * 33]); o.y = pk2(s[2 * 33], s[3 * 33]); o.z = pk2(s[4 * 33], s[5 * 33]); o.w = pk2(s[6 * 33], s[7 * 33]);
        *(GAS v4u*)(WT + (size_t)(d0 + n) * ldk + k0 + 8 * c) = o; }
    LDS_WAIT(); asm volatile("" ::: "memory");
}
__device__ __forceinline__ void phase_p0a(const Ctx& C, const Params& P) {
    LAS float* scr = (LAS float*)(C.lds + RING_OFF + C.wave * 16384);
    const int gw = C.bid * NWAVES + C.wave, NGW = C.G * NWAVES, lane = C.lane;
    constexpr int I_IN = 16 * 45, I_UQ = 4 * 24, I_UKV = 2 * 32, I_O = 16 * 32, I_UP = 16 * 176, I_DN = 44 * 32, I_ADA = 16 * 192, I_G = 32;
    constexpr int NITEMS = I_IN + I_UQ + I_UKV + I_O + I_UP + I_DN + I_ADA + I_G;
    for (int it = gw; it < NITEMS; it += NGW) {
        int r = it;
        if (r < I_UP) { p0_transpose_item<true>(P.in[33], UPC, WSP(bf16, WS_WUP), 1024, scr, 176, r, lane); continue; } r -= I_UP;
        if (r < I_ADA) { p0_transpose_item(P.in[10], MODC, WSP(bf16, WS_WADA), 1024, scr, 192, r, lane); continue; } r -= I_ADA;
        if (r < I_DN) { p0_transpose_item(P.in[36], DM, WSP(bf16, WS_WDN), DFF, scr, 32, r, lane); continue; } r -= I_DN;
        if (r < I_IN) { p0_transpose_item(P.in[13], 1440, WSP(bf16, WS_WIN), 1024, scr, 45, r, lane); continue; } r -= I_IN;
        if (r < I_O) { p0_transpose_item(P.in[31], DM, WSP(bf16, WS_WO), 1024, scr, 32, r, lane); continue; } r -= I_O;
        if (r < I_UQ) { p0_transpose_item(P.in[22], 768, WSP(bf16, WS_WUQ), 256, scr, 24, r, lane); continue; } r -= I_UQ;
        if (r < I_UKV) { p0_transpose_item(P.in[27], 1024, WSP(bf16, WS_WUKV), 256, scr, 32, r, lane); continue; } r -= I_UKV;
        { const int hg = r >> 1, sub = r & 1, h = hg >> 1, gate = hg & 1;
          p0_transpose_item(P.in[gate ? 18 : 16] + (size_t)h * 4096, 64, WSP(bf16, WS_WG) + (size_t)(h * 2 + gate) * 4096, 64, scr, 2, sub, lane); }
    }
    const int gt = C.bid * 512 + C.tid, NGT = C.G * 512;
    { bf16* w = WSP(bf16, WS_WIN) + (size_t)1440 * 1024; for (int i = gt; i < 96 * 1024 / 8; i += NGT) ((v4u*)w)[i] = (v4u){0u, 0u, 0u, 0u}; }
    { bf16* w = WSP(bf16, WS_WUKV); for (int i = gt; i < 1024 * 16; i += NGT) { const int n = i >> 4, c = i & 15; *(v4u*)(w + (size_t)n * 256 + 128 + c * 8) = (v4u){0u, 0u, 0u, 0u}; } }
    { bf16* sc = WSP(bf16, WS_SC);
      for (int i = gt; i < 256 * 1024 / 4; i += NGT) { const int r = i >> 8, c4 = (i & 255) * 4; v2u o = (v2u){0u, 0u};
          if (r < 144) { const float* src = (r < 16) ? P.in[8] + (size_t)r * 1024 : P.in[9] + (size_t)(r - 16) * 1024; const f32x4 v = *(const f32x4*)(src + c4);
              o.x = pk2(v.x * sigmoidf_(v.x), v.y * sigmoidf_(v.y)); o.y = pk2(v.z * sigmoidf_(v.z), v.w * sigmoidf_(v.w)); }
          *(v2u*)(sc + (size_t)r * 1024 + c4) = o; } }
    { float* rt = WSP(float, WS_ROPE);
      for (int i = gt; i < 2049 * 16; i += NGT) { const int pi = i >> 4, k = i & 15; const float pos = (pi == 2048) ? 16384.0f : (float)pi;
          const float inv = powf(10000.0f, -(float)(2 * k) / 32.0f); const float ang = pos * inv; rt[2 * i] = cosf(ang); rt[2 * i + 1] = sinf(ang); } }
}

template <int NW, class Epi> __device__ __forceinline__ void skinny_gemm(const Ctx& C, const bf16* A, int lda, const bf16* Bt, int ldb, int MT, int NT, int K, const Epi& E) {
    const int gw = C.bid * NWAVES + C.wave, NGW = C.G * NWAVES, lane = C.lane;
    for (int wu = gw; wu < MT * NT; wu += NGW) {
        const int mt = wu % MT, nt = wu / MT;
        const bf16* ap = A + (size_t)(mt * 16 + (lane & 15)) * lda + 8 * (lane >> 4);
        const bf16* bp = Bt + (size_t)(nt * 16 * NW + (lane & 15)) * ldb + 8 * (lane >> 4);
        f32x4 acc[NW];
#pragma unroll
        for (int w = 0; w < NW; ++w) acc[w] = (f32x4){0.f, 0.f, 0.f, 0.f};
#pragma unroll 8
        for (int k = 0; k < K; k += 32) { const bf16x8 a = *(const bf16x8*)(ap + k);
#pragma unroll
            for (int w = 0; w < NW; ++w) { const bf16x8 b = *(const bf16x8*)(bp + (size_t)w * 16 * ldb + k); acc[w] = mfma16(a, b, acc[w]); } }
#pragma unroll
        for (int w = 0; w < NW; ++w) E(acc[w], mt, nt * NW + w, lane);
    }
}
template <class E, class = void> struct epi_rowstat { static constexpr bool value = false; };
template <class E> struct epi_rowstat<E, decltype((void)E::ROWSTAT)> { static constexpr bool value = E::ROWSTAT; };
template <int NW, class Epi> __device__ __forceinline__ void skinny_gemm_splitk(const Ctx& C, const bf16* A, int lda, const bf16* Bt, int ldb, int MT, int NTG, int K, const Epi& E) {
    const int lane = C.lane, w = C.wave, tid = C.tid, KW = K / 8;
    LAS float* part = (LAS float*)(C.lds + RING_OFF);
    for (int bu = C.bid; bu < MT * ((NTG + 7) & ~7); bu += C.G) {
        const int g8 = bu / (8 * MT), r8 = bu % (8 * MT), mt = r8 >> 3, ntg = g8 * 8 + (r8 & 7);
        if (ntg >= NTG) continue;
        const bf16* ap = A + (size_t)(mt * 16 + (lane & 15)) * lda + w * KW + 8 * (lane >> 4);
        const bf16* bp = Bt + (size_t)(ntg * 16 * NW + (lane & 15)) * ldb + w * KW + 8 * (lane >> 4);
        f32x4 acc[NW];
#pragma unroll
        for (int q = 0; q < NW; ++q) acc[q] = (f32x4){0.f, 0.f, 0.f, 0.f};
#pragma unroll 4
        for (int k = 0; k < KW; k += 32) { const bf16x8 a = *(const bf16x8*)(ap + k);
#pragma unroll
            for (int q = 0; q < NW; ++q) { const bf16x8 b = *(const bf16x8*)(bp + (size_t)q * 16 * ldb + k); acc[q] = mfma16(a, b, acc[q]); } }
#pragma unroll
        for (int q = 0; q < NW; ++q) *(LAS f32x4*)(part + ((w * NW + q) * 64 + lane) * 4) = acc[q];
        __syncthreads();
        if constexpr (epi_rowstat<Epi>::value) {
            LAS float* sq = part + 8 * NW * 256;
            for (int e = tid; e < 256 * NW; e += 512) { const int q = e >> 8, ln = (e >> 2) & 63, i = e & 3; float s = 0.f;
#pragma unroll
                for (int ww = 0; ww < 8; ++ww) s += part[((ww * NW + q) * 64 + ln) * 4 + i];
                const float v = E.elem(s, mt * 16 + 4 * (ln >> 4) + i, (ntg * NW + q) * 16 + (ln & 15)); sq[(4 * (ln >> 4) + i) * (16 * NW) + q * 16 + (ln & 15)] = v * v; }
            __syncthreads();
            if (tid < 16) { float s = 0.f; for (int k = 0; k < 16 * NW; ++k) s += sq[tid * (16 * NW) + k]; E.rowstat(mt * 16 + tid, s); }
        } else {
            for (int e = tid; e < 256 * NW; e += 512) { const int q = e >> 8, ln = (e >> 2) & 63, i = e & 3; float s = 0.f;
#pragma unroll
                for (int ww = 0; ww < 8; ++ww) s += part[((ww * NW + q) * 64 + ln) * 4 + i];
                E.elem(s, mt * 16 + 4 * (ln >> 4) + i, (ntg * NW + q) * 16 + (ln & 15)); }
        }
        __syncthreads();
    }
}
struct EpiSkBf16 { bf16* O; int ldc;
    __device__ __forceinline__ void elem(float v, int row, int col) const { O[(size_t)(MP + row) * ldc + col] = (bf16)f2bf(v); }
    __device__ __forceinline__ void operator()(const f32x4& acc, int mt, int nt, int lane) const {
#pragma unroll
        for (int i = 0; i < 4; ++i) O[(size_t)(MP + mt * 16 + 4 * (lane >> 4) + i) * ldc + nt * 16 + (lane & 15)] = (bf16)f2bf(acc[i]); } };
struct EpiSB { float* SB;
    __device__ __forceinline__ void elem(float v, int row, int col) const { if (row < 144) SB[(size_t)row * UPC + col] = v; } };
struct EpiSkUp { bf16* O; const float* rowss; const float* SB;
    __device__ __forceinline__ void elem(float v0, int row, int np) const { const float v = v0 * rsqrtf(rowss[MP + row] * (1.f / 1024.f) + EPS) + SB[(size_t)(16 + row) * UPC + np]; const int col = (np & 128) ? (DFF + 128 * (np >> 8) + (np & 127)) : (128 * (np >> 8) + (np & 127)); O[(size_t)(MP + row) * UPC + col] = (bf16)f2bf(v); }
    __device__ __forceinline__ void operator()(const f32x4& acc, int mt, int nt, int lane) const {
        const int np = nt * 16 + (lane & 15); const int col = (np & 128) ? (DFF + 128 * (np >> 8) + (np & 127)) : (128 * (np >> 8) + (np & 127));
#pragma unroll
        for (int i = 0; i < 4; ++i) O[(size_t)(MP + mt * 16 + 4 * (lane >> 4) + i) * UPC + col] = (bf16)f2bf(acc[i]); } };
template <bool BASE_BF16, bool OUT_BF16, bool XG> struct EpiSkResGate { const void* base; void* out; const float* mod; int goff; bf16* xg; const float* g2; float* rowss;
    __device__ __forceinline__ float elem(float a, int s, int c) const { const size_t o = (size_t)s * 1024 + c;
        const float bs = BASE_BF16 ? bf2f(((const bf16*)base)[o]) : ((const float*)base)[o];
        const float v = bs + mod[(size_t)(16 + s) * MODC + goff + c] * a;
        if (OUT_BF16) ((bf16*)out)[o] = (bf16)f2bf(v); else ((float*)out)[o] = v;
        if (XG) xg[o] = (bf16)f2bf(v * g2[c] * (1.0f + mod[(size_t)(16 + s) * MODC + 4096 + c]));
        return v; }
    static constexpr bool ROWSTAT = XG;
    __device__ __forceinline__ void rowstat(int s, float sumsq) const { __hip_atomic_fetch_add(rowss + s, sumsq, __ATOMIC_RELAXED, __HIP_MEMORY_SCOPE_AGENT); }
};

struct EpiMod { float* mod; const float* bias; bf16* sh2;
    __device__ __forceinline__ void elem(float v, int row, int col) const { if (row < 144) { const float o = v + bias[col]; mod[(size_t)row * MODC + col] = o; if (col >= 3072 && col < 4096) sh2[(size_t)row * 1024 + col - 3072] = (bf16)f2bf(o); } }
    __device__ __forceinline__ void operator()(const f32x4& acc, int mt, int nt, int lane) const {
        const int col = nt * 16 + (lane & 15); const float b = bias[col];
#pragma unroll
        for (int i = 0; i < 4; ++i) { const int row = mt * 16 + 4 * (lane >> 4) + i; if (row < 144) mod[(size_t)row * MODC + col] = acc[i] + b; }
    } };
__device__ __forceinline__ void phase_p0b(const Ctx& C, const Params& P) {
    EpiMod E{WSP(float, WS_MOD), P.in[11], WSP(bf16, WS_SH2)};
    skinny_gemm_splitk<8>(C, WSP(bf16, WS_SC), 1024, WSP(bf16, WS_WADA), 1024, 9, MODC / 128, 1024, E);
}

__device__ __forceinline__ const float* mod_row(const Params& P, int r) { return WSP(const float, WS_MOD) + (size_t)((r < MP) ? (r >> 11) : (16 + r - MP)) * MODC; }
template <bool SECOND> __device__ __forceinline__ void phase_norm_mod(const Ctx& C, const Params& P) {
    const int gw = C.bid * NWAVES + C.wave, NGW = C.G * NWAVES, lane = C.lane;
    const float* g = P.in[SECOND ? 32 : 12]; bf16* H = WSP(bf16, WS_H1);
    constexpr int SH = SECOND ? 3072 : 0, SC = SECOND ? 4096 : 1024;
    for (int r0 = gw; r0 < MR; r0 += 2 * NGW) {
        f32x4 v[2][4]; int rr[2];
#pragma unroll
        for (int u = 0; u < 2; ++u) { const int r = (r0 + u * NGW < MR) ? r0 + u * NGW : r0; rr[u] = r;
            if (r < MREAL) {
                if (SECOND) { const bf16* xb = WSP(const bf16, WS_X1) + (size_t)r * 1024;
#pragma unroll
                    for (int j = 0; j < 4; ++j) { const v2u w = *((const v2u*)xb + lane + 64 * j); v[u][j] = (f32x4){bflo(w.x), bfhi(w.x), bflo(w.y), bfhi(w.y)}; } }
                else { const float* xr = (r < MP) ? P.in[0] + (size_t)r * 1024 : P.in[1] + (size_t)(r - MP) * 1024;
#pragma unroll
                    for (int j = 0; j < 4; ++j) v[u][j] = *((const f32x4*)xr + lane + 64 * j); } }
            else {
#pragma unroll
                for (int j = 0; j < 4; ++j) v[u][j] = (f32x4){0.f, 0.f, 0.f, 0.f}; } }
#pragma unroll
        for (int u = 0; u < 2; ++u) { const int r = rr[u];
            GAS unsigned long long* o8 = (GAS unsigned long long*)(H + (size_t)r * 1024) + lane;
            if (r >= MREAL) {
#pragma unroll
                for (int j = 0; j < 4; ++j) o8[64 * j] = 0ull;
                continue; }
            const float* md = mod_row(P, r);
            float s = 0.f;
#pragma unroll
            for (int j = 0; j < 4; ++j) s += (v[u][j].x * v[u][j].x + v[u][j].y * v[u][j].y) + (v[u][j].z * v[u][j].z + v[u][j].w * v[u][j].w);
            const float rstd = rsqrtf(wave_sum(s) * (1.f / 1024.f) + EPS);
#pragma unroll
            for (int j = 0; j < 4; ++j) { const int c = 4 * (lane + 64 * j);
                const f32x4 gg = *(const f32x4*)(g + c), sc = *(const f32x4*)(md + SC + c), sh = *(const f32x4*)(md + SH + c);
                const f32x4 h = v[u][j] * rstd * gg * (sc + 1.0f) + sh;
                o8[64 * j] = (unsigned long long)pk2(h.x, h.y) | ((unsigned long long)pk2(h.z, h.w) << 32); }
        }
    }
}

__device__ __forceinline__ void phase_p3a(const Ctx& C, const Params& P) {
    const int gw = C.bid * NWAVES + C.wave, NGW = C.G * NWAVES, lane = C.lane;
    const bf16* Z = WSP(const bf16, WS_Z); bf16* QN = WSP(bf16, WS_QN); bf16* KVN = WSP(bf16, WS_KVN); bf16* KR = WSP(bf16, WS_KR);
    const float* rope = WSP(const float, WS_ROPE);
    const f32x4 gq = *(const f32x4*)(P.in[21] + 4 * lane); const f32x2 gkv = *(const f32x2*)(P.in[25] + 2 * lane); const float gkr = P.in[26][lane & 31];
    for (int r0 = gw; r0 < MREAL; r0 += 2 * NGW) {
        v2u wq[2]; unsigned wk[2]; unsigned short wr[2]; v4u wx[2]; int rr[2];
#pragma unroll
        for (int u = 0; u < 2; ++u) { const int r = (r0 + u * NGW < MREAL) ? r0 + u * NGW : r0; rr[u] = r; const bf16* z = Z + (size_t)r * ZC;
            wq[u] = *(const v2u*)(z + 1024 + 4 * lane); wk[u] = *(const unsigned*)(z + 1280 + 2 * lane); wr[u] = z[1408 + (lane & 31)];
            wx[u] = (v4u){0u, 0u, 0u, 0u}; if (r >= MP || (r & 2047) >= 2045) wx[u] = *(const v4u*)(z + 8 * lane); }
#pragma unroll
        for (int u = 0; u < 2; ++u) { const int r = rr[u];
            const bool smp = r >= MP; const int s_ = r - MP, b = r >> 11, t = r & 2047;
            { const float a0 = bflo(wq[u].x), a1 = bfhi(wq[u].x), a2 = bflo(wq[u].y), a3 = bfhi(wq[u].y);
              const float rstd = rsqrtf(wave_sum(a0 * a0 + a1 * a1 + a2 * a2 + a3 * a3) * (1.f / 256.f) + EPS);
              v2u o; o.x = pk2(a0 * rstd * gq.x, a1 * rstd * gq.y); o.y = pk2(a2 * rstd * gq.z, a3 * rstd * gq.w); *(v2u*)(QN + (size_t)r * 256 + 4 * lane) = o; }
            { const float a0 = bflo(wk[u]), a1 = bfhi(wk[u]);
              const float rstd = rsqrtf(wave_sum(a0 * a0 + a1 * a1) * (1.f / 128.f) + EPS);
              const float o0 = a0 * rstd * gkv.x, o1 = a1 * rstd * gkv.y;
              float* dst = P.out + (smp ? O_KVS + (size_t)s_ * 128 : O_KVP + (size_t)r * 128); *(f32x2*)(dst + 2 * lane) = (f32x2){o0, o1};
              *(unsigned*)(KVN + (size_t)r * 256 + 2 * lane) = pk2(o0, o1); *(unsigned*)(KVN + (size_t)r * 256 + 128 + 2 * lane) = 0u; }
            { const float a = (lane < 32) ? bf2f(wr[u]) : 0.f; const float rstd = rsqrtf(wave_sum(a * a) * (1.f / 32.f) + EPS);
              const float v = a * rstd * gkr; const float pr = lane_xor16(v, lane);
              const f32x2 cs = *(const f32x2*)(rope + ((size_t)(smp ? 2048 : t) * 16 + (lane & 15)) * 2);
              const float o = (lane & 16) ? (v * cs.x + pr * cs.y) : (v * cs.x - pr * cs.y);
              if (lane < 32) { float* dst = P.out + (smp ? O_KRS + (size_t)s_ * 32 : O_KRP + (size_t)r * 32); dst[lane] = o; KR[(size_t)r * 32 + lane] = (bf16)f2bf(o); } }
            const v4u w = wx[u];
            if (smp) { float* d2 = P.out + O_LCS + (size_t)s_ * 1536; const float* st = P.in[5] + (size_t)s_ * 1536;
                *(f32x4*)(d2 + 8 * lane) = *(const f32x4*)(st + 512 + 8 * lane); *(f32x4*)(d2 + 8 * lane + 4) = *(const f32x4*)(st + 512 + 8 * lane + 4);
                *(f32x4*)(d2 + 512 + 8 * lane) = *(const f32x4*)(st + 1024 + 8 * lane); *(f32x4*)(d2 + 512 + 8 * lane + 4) = *(const f32x4*)(st + 1024 + 8 * lane + 4);
                *(f32x4*)(d2 + 1024 + 8 * lane) = (f32x4){bflo(w.x), bfhi(w.x), bflo(w.y), bfhi(w.y)}; *(f32x4*)(d2 + 1024 + 8 * lane + 4) = (f32x4){bflo(w.z), bfhi(w.z), bflo(w.w), bfhi(w.w)}; }
            else if (t >= 2045) { float* d2 = P.out + O_LCP + ((size_t)b * 3 + (t - 2045)) * 512;
                *(f32x4*)(d2 + 8 * lane) = (f32x4){bflo(w.x), bfhi(w.x), bflo(w.y), bfhi(w.y)}; *(f32x4*)(d2 + 8 * lane + 4) = (f32x4){bflo(w.z), bfhi(w.z), bflo(w.w), bfhi(w.w)}; }
        }
    }
}

template <bool SMP> __device__ __forceinline__ void phase_p3b(const Ctx& C, const Params& P) {
    LAS float* L = (LAS float*)(C.lds + RING_OFF);
    for (int i = C.tid; i < 2048; i += 512) L[i] = P.in[14][i];
    { const int i = C.tid; L[2048 + i] = P.in[15][i]; L[2560 + i] = P.in[17][i]; L[3072 + i] = P.in[19][i];
      const float nl = -P.in[20][i]; L[3584 + i] = fmaxf(nl, 0.f) + log1pf(__expf(-fabsf(nl))); }
    __syncthreads();
    const int lane0 = C.lane, h = C.wave;
    const bf16* Z = WSP(const bf16, WS_Z); bf16* HL = WSP(bf16, WS_HL); bf16* AC = WSP(bf16, WS_AC); float* SUM = WSP(float, WS_SUM);
    const bf16* WG = WSP(const bf16, WS_WG);
    bf16x8 idf[2];
#pragma unroll
    for (int s2 = 0; s2 < 2; ++s2) { bf16x8 f;
#pragma unroll
        for (int j = 0; j < 8; ++j) f[j] = (16 * s2 + 8 * (lane0 >> 5) + j == (lane0 & 31)) ? (short)0x3F80 : (short)0;
        idf[s2] = f; }
    const int NIT = SMP ? 4 : NBATCH * 32;
    for (int it0 = C.bid; it0 < NIT; it0 += C.G) {
        constexpr bool smp = SMP; const int it = SMP ? it0 + NBATCH * 32 : it0;
        int lane = lane0; asm volatile("" : "+v"(lane));
        const int tk = lane & 31, hh = lane >> 5;
        const int b = it >> 5, chunk = it & 31;
        float carP[2] = {1.f, 1.f}, carS[2] = {0.f, 0.f};
#pragma unroll 1
        for (int sub = 0; sub < (smp ? 1 : 2); ++sub) {
            const int t0 = smp ? 0 : chunk * 64 + sub * 32;
            const int sq = (it - NBATCH * 32) * 32;
            const size_t rowA = smp ? (size_t)(MP + sq + tk) : (size_t)b * SEQ + t0 + tk;
            bf16x8 af[4];
            int hhc = hh; asm volatile("" : "+v"(hhc));
            v4u zn[4];
#define P3B_LOADZ(s_) do { const int chn_ = 64 * h + 16 * (s_) + 8 * hhc; _Pragma("unroll") for (int tap = 0; tap < 4; ++tap) { const int tt = t0 + tk - 3 + tap; zn[tap] = (v4u){0u, 0u, 0u, 0u}; \
                if (!(smp && tap < 3) && (smp || tt >= 0)) zn[tap] = *(const v4u*)(Z + (rowA - 3 + tap) * ZC + chn_); } } while (0)
            P3B_LOADZ(0);
#pragma unroll
            for (int s = 0; s < 4; ++s) {
                const int ch0 = 64 * h + 16 * s + 8 * hhc;
                v4u zc[4];
#pragma unroll
                for (int tap = 0; tap < 4; ++tap) zc[tap] = zn[tap];
                if (s < 3) P3B_LOADZ(s + 1);
                float xc[8];
#pragma unroll
                for (int j = 0; j < 8; ++j) xc[j] = L[2048 + ch0 + j];
#pragma unroll
                for (int tap = 0; tap < 4; ++tap) {
                    float xv[8];
                    if (smp && tap < 3) { const float* st = P.in[5] + ((size_t)(sq + tk) * 3 + tap) * 512 + ch0; const f32x4 a = *(const f32x4*)st, bq = *(const f32x4*)(st + 4);
                        xv[0] = a.x; xv[1] = a.y; xv[2] = a.z; xv[3] = a.w; xv[4] = bq.x; xv[5] = bq.y; xv[6] = bq.z; xv[7] = bq.w; }
                    else unpack8f(zc[tap], xv);
#pragma unroll
                    for (int j = 0; j < 8; ++j) xc[j] += L[tap * 512 + ch0 + j] * xv[j];
                }
                af[s] = pack8(xc);
                asm volatile("" ::: "memory"); __builtin_amdgcn_sched_barrier(0);
            }
#undef P3B_LOADZ
#pragma unroll 1
            for (int cb = 0; cb < 2; ++cb) {
                f32x16 ra = {}, ia = {}, xq = {};
                { unsigned woff = (unsigned)(((h * 2) * 64 + 32 * cb + tk) * 64 + 8 * hh); asm volatile("" : "+v"(woff));
                  const bf16* wp = WG + woff;
#pragma unroll
                  for (int s = 0; s < 4; ++s) { const bf16x8 wa = *(const bf16x8*)(wp + 16 * s), wx = *(const bf16x8*)(wp + 4096 + 16 * s); ra = mfma32(af[s], wa, ra); ia = mfma32(af[s], wx, ia); } }
                { const bf16x8 afa = cb ? af[2] : af[0], afb = cb ? af[3] : af[1]; xq = mfma32(afa, idf[0], xq); xq = mfma32(afb, idf[1], xq); }
                const int ch = 64 * h + 32 * cb + tk;
                const float spc = L[3584 + ch], bac = L[2560 + ch], bxc = L[3072 + ch];
                float av[16], hv[16];
#pragma unroll
                for (int rr = 0; rr < 16; ++rr) {
                    const float rg = sigmoidf_(ra[rr] + bac), ig = sigmoidf_(ia[rr] + bxc);
                    const float la = -8.0f * spc * rg; const float a = __builtin_amdgcn_exp2f(1.4426950408889634f * la);
                    const float x2 = 2.0f * la;
                    const float ser = -x2 * (1.0f + x2 * (0.5f + x2 * (0.16666667f + x2 * (0.041666668f + x2 * (0.008333334f + x2 * 0.0013888889f)))));
                    float mult = __builtin_amdgcn_sqrtf(x2 > -0.25f ? ser : 1.0f - a * a);
                    if (!smp && (t0 + crow(rr, hh)) == 0) mult = 1.0f;
                    av[rr] = a; hv[rr] = mult * ig * xq[rr];
                    if ((rr & 3) == 3) __builtin_amdgcn_sched_barrier(0);
                }
                if (smp) {
#pragma unroll
                    for (int rr = 0; rr < 16; ++rr) { const int sI = sq + crow(rr, hh); const float h0 = P.in[4][(size_t)sI * 512 + ch];
                        const float hn = av[rr] * h0 + hv[rr]; P.out[O_LHS + (size_t)sI * 512 + ch] = hn;
                        HL[(size_t)(MP + sI) * 512 + ch] = (bf16)f2bf(hn); AC[(size_t)(MP + sI) * 512 + ch] = (bf16)0; }
                } else {
#pragma unroll
                    for (int gi = 0; gi < 4; ++gi)
#pragma unroll
                        for (int j = 1; j < 4; ++j) { hv[4 * gi + j] = av[4 * gi + j] * hv[4 * gi + j - 1] + hv[4 * gi + j]; av[4 * gi + j] = av[4 * gi + j] * av[4 * gi + j - 1]; }
                    float Pc = cb ? carP[1] : carP[0], Sc = cb ? carS[1] : carS[0];
#pragma unroll
                    for (int gi = 0; gi < 4; ++gi) {
                        const float oA = av[4 * gi + 3], oH = hv[4 * gi + 3];
                        const float pA = lane_xor32(oA, lane), pH = lane_xor32(oH, lane);
                        const float loA = hh ? pA : oA, loH = hh ? pH : oH, hiA = hh ? oA : pA, hiH = hh ? oH : pH;
                        const float S1 = loH + loA * Sc, P1 = loA * Pc;
                        const float Sin = hh ? S1 : Sc, Pin = hh ? P1 : Pc;
#pragma unroll
                        for (int j = 0; j < 4; ++j) { const int rr = 4 * gi + j; hv[rr] = hv[rr] + av[rr] * Sin; av[rr] = av[rr] * Pin; }
                        Sc = hiH + hiA * S1; Pc = hiA * P1;
                    }
                    if (cb) { carP[1] = Pc; carS[1] = Sc; } else { carP[0] = Pc; carS[0] = Sc; }
                    { const unsigned ob = (unsigned)(((b * SEQ + t0 + 4 * hh) * 512 + ch) * 2);
#pragma unroll
                      for (int rr = 0; rr < 16; ++rr) { const unsigned o2 = ob + (unsigned)(((rr & 3) + 8 * (rr >> 2)) * 1024);
                          const unsigned w2 = pk2(hv[rr], av[rr]); *(bf16*)((char*)HL + o2) = (bf16)w2; *(bf16*)((char*)AC + o2) = (bf16)(w2 >> 16); } }
                }
            }
        }
        if (!smp) { int lq = lane; asm volatile("" : "+v"(lq));
            if (lq < 32) {
#pragma unroll
                for (int cb = 0; cb < 2; ++cb) { const int ch = 64 * h + 32 * cb + lq; *(f32x2*)(SUM + (((size_t)b * 32 + chunk) * 512 + ch) * 2) = (f32x2){carP[cb], carS[cb]}; } }
        }
    }
    __syncthreads();
}

__device__ __forceinline__ float g8_sum(float v) { v += DPPF0(v, 0xB1); v += DPPF0(v, 0x4E); v += DPPF0(v, 0x141); return v; }
__device__ __forceinline__ void phase_p5(const Ctx& C, const Params& P) {
    const int gw = C.bid * NWAVES + C.wave, NGW = C.G * NWAVES, lane = C.lane, hd = lane >> 3, sub = lane & 7;
    const bf16* QRAW = WSP(const bf16, WS_QRAW); const bf16* KVRAW = WSP(const bf16, WS_KVRAW); const bf16* KR = WSP(const bf16, WS_KR);
    bf16* Q = WSP(bf16, WS_Q); bf16* KF = WSP(bf16, WS_KF);
    const float* rope = WSP(const float, WS_ROPE);
    float gkn[8];
#pragma unroll
    for (int j = 0; j < 8; ++j) gkn[j] = P.in[28][8 * sub + j];
    for (int r0 = gw; r0 < MREAL; r0 += 4 * NGW) {
        v4u wkn[4]; v2u wkr[4]; int rr[4];
#pragma unroll
        for (int u = 0; u < 4; ++u) { const int r = (r0 + u * NGW < MREAL) ? r0 + u * NGW : r0; rr[u] = r;
            wkn[u] = *(const v4u*)(KVRAW + (size_t)r * 1024 + hd * 128 + 8 * sub); wkr[u] = *(const v2u*)(KR + (size_t)r * 32 + 4 * sub); }
#pragma unroll
        for (int u = 0; u < 4; ++u) { const int r = rr[u];
            float v[8]; unpack8f(wkn[u], v); float ss = 0.f;
#pragma unroll
            for (int j = 0; j < 8; ++j) ss += v[j] * v[j];
            const float rstd = rsqrtf(g8_sum(ss) * (1.f / 64.f) + EPS);
#pragma unroll
            for (int j = 0; j < 8; ++j) v[j] = v[j] * rstd * gkn[j];
            *(bf16x8*)(KF + (size_t)r * 768 + hd * 96 + 8 * sub) = pack8(v);
            *(v2u*)(KF + (size_t)r * 768 + hd * 96 + 64 + 4 * sub) = wkr[u];
        }
    }
    for (int r = MP + gw; r < MREAL; r += NGW) {
        const bf16* q = QRAW + (size_t)r * 768 + hd * 96;
        float v[8]; unpack8f(*(const v4u*)(q + 8 * sub), v); float ss = 0.f;
#pragma unroll
        for (int j = 0; j < 8; ++j) ss += v[j] * v[j];
        const float rstd = rsqrtf(g8_sum(ss) * (1.f / 64.f) + EPS) * C2;
#pragma unroll
        for (int j = 0; j < 8; ++j) v[j] = v[j] * rstd * P.in[23][8 * sub + j];
        *(bf16x8*)(Q + (size_t)r * 768 + hd * 96 + 8 * sub) = pack8(v);
        const v2u wq = *(const v2u*)(q + 64 + 4 * sub); float x[4] = {bflo(wq.x), bfhi(wq.x), bflo(wq.y), bfhi(wq.y)};
        const float rs2 = rsqrtf(g8_sum(x[0] * x[0] + x[1] * x[1] + x[2] * x[2] + x[3] * x[3]) * (1.f / 32.f) + EPS);
        float o[4];
#pragma unroll
        for (int j = 0; j < 4; ++j) { const float me = x[j] * rs2 * P.in[24][4 * sub + j]; const float pr = __shfl_xor(me, 4);
            const f32x2 cs = *(const f32x2*)(rope + ((size_t)2048 * 16 + 4 * (sub & 3) + j) * 2);
            o[j] = ((sub & 4) ? (me * cs.x + pr * cs.y) : (me * cs.x - pr * cs.y)) * C2; }
        v2u ow; ow.x = pk2(o[0], o[1]); ow.y = pk2(o[2], o[3]); *(v2u*)(Q + (size_t)r * 768 + hd * 96 + 64 + 4 * sub) = ow;
    }
}

__device__ __forceinline__ void phase_carry(const Ctx& C, const Params& P) {
    const float* SUM = WSP(const float, WS_SUM); float* CAR = WSP(float, WS_CARRY);
    const int t = C.tid; if (t >= 32) return;
    for (int idx = C.bid * 32 + t; idx < NBATCH * 512; idx += C.G * 32) {
        const int b = idx >> 9, ch = idx & 511; f32x2 ps[32];
#pragma unroll
        for (int k = 0; k < 32; ++k) ps[k] = *(const f32x2*)(SUM + (((size_t)b * 32 + k) * 512 + ch) * 2);
        float H = 0.f;
#pragma unroll
        for (int k = 0; k < 32; ++k) { CAR[((size_t)b * 32 + k) * 512 + ch] = H; H = ps[k].x * H + ps[k].y; }
        P.out[O_LHP + idx] = H;
    }
}

constexpr int KT_PITCH = 208, VT_PITCH = 192;
constexpr int KT_BYTES = 64 * KT_PITCH, VT_BYTES = 64 * VT_PITCH, ATT_BUF = KT_BYTES + VT_BYTES;
__device__ __forceinline__ s16x4 tr_read(unsigned addr) { s16x4 r; asm volatile("ds_read_b64_tr_b16 %0, %1\n\ts_waitcnt lgkmcnt(0)" : "=&v"(r) : "v"(addr) : "memory"); return r; }
__device__ __forceinline__ void attn_unit(const Ctx& C, const Params& P, int bh, int qb) {
    const int lane = C.lane, wid = C.wave, tid = C.tid, r32 = lane & 31, hh = lane >> 5;
    const int b = bh >> 3, h = bh & 7;
    const bf16* QRAW = WSP(const bf16, WS_QRAW); const bf16* KF = WSP(const bf16, WS_KF); const bf16* KVRAW = WSP(const bf16, WS_KVRAW); bf16* ATT = WSP(bf16, WS_ATT);
    const size_t rowbase = (size_t)b * SEQ; const int q0 = qb * 256 + wid * 32;
    const unsigned lds0 = (unsigned)(uintptr_t)(C.lds + RING_OFF);
    bf16x8 qf[6];
    { float qv[6][8];
#pragma unroll
      for (int s = 0; s < 6; ++s) { const v4u w = *(const v4u*)(QRAW + (rowbase + q0 + r32) * 768 + h * 96 + 16 * s + 8 * hh); unpack8f(w, qv[s]); }
      float sn = 0.f, sr = 0.f;
#pragma unroll
      for (int j = 0; j < 8; ++j) { sn += qv[0][j] * qv[0][j] + qv[1][j] * qv[1][j] + qv[2][j] * qv[2][j] + qv[3][j] * qv[3][j]; sr += qv[4][j] * qv[4][j] + qv[5][j] * qv[5][j]; }
      const float rn = rsqrtf(xhalf_sum(sn) * (1.f / 64.f) + EPS) * C2, rr = rsqrtf(xhalf_sum(sr) * (1.f / 32.f) + EPS);
      const float* gqn = P.in[23]; const float* gqr = P.in[24]; const float* rope = WSP(const float, WS_ROPE) + (size_t)(q0 + r32) * 32;
#pragma unroll
      for (int s = 0; s < 4; ++s) {
#pragma unroll
          for (int j = 0; j < 8; ++j) qv[s][j] *= rn * gqn[16 * s + 8 * hh + j];
          qf[s] = pack8(qv[s]); }
#pragma unroll
      for (int j = 0; j < 8; ++j) { const int i = 8 * hh + j; const float x1 = qv[4][j] * rr * gqr[i], x2 = qv[5][j] * rr * gqr[16 + i]; const f32x2 cs = *(const f32x2*)(rope + 2 * i);
          qv[4][j] = (x1 * cs.x - x2 * cs.y) * C2; qv[5][j] = (x2 * cs.x + x1 * cs.y) * C2; }
      qf[4] = pack8(qv[4]); qf[5] = pack8(qv[5]); }
    const int NT = 4 * (qb + 1);
    const int kc0 = tid, kr0 = kc0 / 12, kk0 = kc0 % 12, kc1 = 512 + tid, kr1 = kc1 / 12, kk1 = kc1 % 12; const bool k2 = tid < 256;
    const int vr = tid >> 3, vk = tid & 7;
    const bf16* kg0 = KF + (rowbase + kr0) * 768 + h * 96 + kk0 * 8; const bf16* kg1 = KF + (rowbase + kr1) * 768 + h * 96 + kk1 * 8;
    const bf16* vg = KVRAW + (rowbase + vr) * 1024 + h * 128 + 64 + vk * 8;
    v4u sk0, sk1 = (v4u){0u, 0u, 0u, 0u}, sv;
    sk0 = *(const v4u*)kg0; if (k2) sk1 = *(const v4u*)kg1; sv = *(const v4u*)vg;
    { LAS unsigned char* bufp = C.lds + RING_OFF; *(LAS v4u*)(bufp + kr0 * KT_PITCH + kk0 * 16) = sk0; if (k2) *(LAS v4u*)(bufp + kr1 * KT_PITCH + kk1 * 16) = sk1; *(LAS v4u*)(bufp + KT_BYTES + vr * VT_PITCH + vk * 16) = sv; }
    __syncthreads();
    float m_run = -INFINITY, l_run = 0.f; f32x16 o[2]; o[0] = f32x16{}; o[1] = f32x16{};
    for (int t = 0; t < NT; ++t) {
        const int cur = t & 1; const bool more = (t + 1 < NT);
        if (more) { const size_t adv = (size_t)(t + 1) * 64; sk0 = *(const v4u*)(kg0 + adv * 768); if (k2) sk1 = *(const v4u*)(kg1 + adv * 768); sv = *(const v4u*)(vg + adv * 1024); }
        LAS unsigned char* Kb = C.lds + RING_OFF + cur * ATT_BUF; const unsigned Vb = lds0 + cur * ATT_BUF + KT_BYTES;
        if (64 * t <= q0 + 31) {
        f32x16 p[2];
#pragma unroll
        for (int kh = 0; kh < 2; ++kh) { f32x16 acc = f32x16{};
#pragma unroll
            for (int s = 0; s < 6; ++s) { const bf16x8 kf = *(const LAS bf16x8*)(Kb + (32 * kh + r32) * KT_PITCH + (16 * s + 8 * hh) * 2); acc = mfma32(kf, qf[s], acc); }
            p[kh] = acc; }
        s16x4 vl[2][2][2], vh[2][2][2];
        { const int i16 = lane & 15, q4 = i16 >> 2, p4 = i16 & 3, blk = (lane >> 4) & 1;
          const unsigned a0 = Vb + (4 * hh + q4) * VT_PITCH + (16 * blk + 4 * p4) * 2;
#define TRV(kh, s2) asm volatile("ds_read_b64_tr_b16 %0, %4 offset:%5\n\tds_read_b64_tr_b16 %1, %4 offset:%6\n\tds_read_b64_tr_b16 %2, %4 offset:%7\n\tds_read_b64_tr_b16 %3, %4 offset:%8" \
              : "=&v"(vl[kh][s2][0]), "=&v"(vh[kh][s2][0]), "=&v"(vl[kh][s2][1]), "=&v"(vh[kh][s2][1]) : "v"(a0), "i"((32 * kh + 16 * s2) * VT_PITCH), "i"((32 * kh + 16 * s2 + 8) * VT_PITCH), \
                "i"((32 * kh + 16 * s2) * VT_PITCH + 64), "i"((32 * kh + 16 * s2 + 8) * VT_PITCH + 64) : "memory")
          TRV(0, 0); TRV(0, 1); TRV(1, 0); TRV(1, 1);
#undef TRV
        }
        if (64 * t + 63 > q0) { const int qq = q0 + r32;
#pragma unroll
            for (int kh = 0; kh < 2; ++kh)
#pragma unroll
                for (int r = 0; r < 16; ++r) if (64 * t + 32 * kh + crow(r, hh) > qq) p[kh][r] = -INFINITY; }
        float mx = p[0][0];
#pragma unroll
        for (int r = 1; r < 16; ++r) mx = fmaxf(mx, p[0][r]);
#pragma unroll
        for (int r = 0; r < 16; ++r) mx = fmaxf(mx, p[1][r]);
        { auto rr = __builtin_amdgcn_permlane32_swap(__float_as_uint(mx), __float_as_uint(mx), false, false); mx = fmaxf(__uint_as_float(rr[0]), __uint_as_float(rr[1])); }
        const float m_new = fmaxf(m_run, mx); const float alpha = __builtin_amdgcn_exp2f(m_run - m_new); m_run = m_new;
        float ps = 0.f;
#pragma unroll
        for (int kh = 0; kh < 2; ++kh)
#pragma unroll
            for (int r = 0; r < 16; ++r) { const float e = __builtin_amdgcn_exp2f(p[kh][r] - m_new); p[kh][r] = e; ps += e; }
        l_run = l_run * alpha + ps;
#pragma unroll
        for (int dt = 0; dt < 2; ++dt)
#pragma unroll
            for (int r = 0; r < 16; ++r) o[dt][r] *= alpha;
        asm volatile("s_waitcnt lgkmcnt(0)" : "+v"(vl[0][0][0]), "+v"(vh[0][0][0]), "+v"(vl[0][0][1]), "+v"(vh[0][0][1]), "+v"(vl[0][1][0]), "+v"(vh[0][1][0]), "+v"(vl[0][1][1]), "+v"(vh[0][1][1]),
                     "+v"(vl[1][0][0]), "+v"(vh[1][0][0]), "+v"(vl[1][0][1]), "+v"(vh[1][0][1]), "+v"(vl[1][1][0]), "+v"(vh[1][1][0]), "+v"(vl[1][1][1]), "+v"(vh[1][1][1]) :: "memory");
#pragma unroll
        for (int kh = 0; kh < 2; ++kh)
#pragma unroll
            for (int s2 = 0; s2 < 2; ++s2) {
                float pv[8];
#pragma unroll
                for (int j = 0; j < 8; ++j) pv[j] = p[kh][8 * s2 + j];
                const bf16x8 pf = pack8(pv);
                o[0] = mfma32(__builtin_shufflevector(vl[kh][s2][0], vh[kh][s2][0], 0, 1, 2, 3, 4, 5, 6, 7), pf, o[0]);
                o[1] = mfma32(__builtin_shufflevector(vl[kh][s2][1], vh[kh][s2][1], 0, 1, 2, 3, 4, 5, 6, 7), pf, o[1]);
            }
        }
        if (more) { LAS unsigned char* nb = C.lds + RING_OFF + (cur ^ 1) * ATT_BUF;
            *(LAS v4u*)(nb + kr0 * KT_PITCH + kk0 * 16) = sk0; if (k2) *(LAS v4u*)(nb + kr1 * KT_PITCH + kk1 * 16) = sk1; *(LAS v4u*)(nb + KT_BYTES + vr * VT_PITCH + vk * 16) = sv; }
        __syncthreads();
    }
    const float linv = 1.0f / xhalf_sum(l_run);
    bf16* orow = ATT + (rowbase + q0 + r32) * 512 + h * 64;
#pragma unroll
    for (int dt = 0; dt < 2; ++dt)
#pragma unroll
        for (int g = 0; g < 4; ++g) { v2u w; w.x = pk2(o[dt][4 * g] * linv, o[dt][4 * g + 1] * linv); w.y = pk2(o[dt][4 * g + 2] * linv, o[dt][4 * g + 3] * linv);
            *(v2u*)(orow + 32 * dt + 8 * g + 4 * hh) = w; }
}
__device__ __forceinline__ void phase_attn_prompt(const Ctx& C, const Params& P) {
    for (int pi = C.bid; pi < 512; pi += C.G) {
        const int bh = pi >> 2, pr = pi & 3;
        attn_unit(C, P, bh, 7 - pr);
        attn_unit(C, P, bh, pr);
    }
}

constexpr int LK_PITCH = 272, LT_PITCH = 272, LKR_PITCH = 80;
constexpr int SA_LK = 0, SA_LT = 128 * LK_PITCH, SA_LT_BUF = 128 * LT_PITCH, SA_KR = SA_LT + 2 * SA_LT_BUF, SA_P = SA_KR + 128 * LKR_PITCH, SA_P_BUF = 8 * 256, SA_AL = SA_P + 2 * SA_P_BUF, SA_QG = SA_AL + 2 * 32, SA_END = SA_QG + 8 * 256;
static_assert(SA_END <= RING_BYTES, "sample attention LDS");
constexpr int PART_STRIDE = 8 * 132;
__device__ __forceinline__ float xhalf_sum_pl(float v) { auto rr = __builtin_amdgcn_permlane32_swap(__float_as_uint(v), __float_as_uint(v), false, false); return __uint_as_float(rr[0]) + __uint_as_float(rr[1]); }
__device__ __forceinline__ void phase_attn_sample(const Ctx& C, const Params& P) {
    const int lane = C.lane, h = C.wave, tid = C.tid, r32 = lane & 31, hh = lane >> 5;
    const bf16* WUKV = WSP(const bf16, WS_WUKV); const bf16* Q = WSP(const bf16, WS_Q); float* PART = WSP(float, WS_PART);
    const float* cache_lat = P.in[2]; const float* cache_kr = P.in[3]; const int* ptab = (const int*)P.in[7]; const float* gkn = P.in[28];
    LAS unsigned char* S = C.lds + RING_OFF;
    bf16x8 wk[2][8];
#pragma unroll
    for (int rt = 0; rt < 2; ++rt)
#pragma unroll
        for (int s = 0; s < 8; ++s) wk[rt][s] = *(const bf16x8*)(WUKV + (size_t)(h * 128 + 32 * rt + r32) * 256 + 16 * s + 8 * hh);
    const int kg = tid >> 5, dq = tid & 31;
    for (int u = C.bid; u < 256; u += C.G) {
        const int sq = u >> 1, half = u & 1; const size_t qrow = (size_t)(MP + sq);
        { const int l2 = fresh_lane(); *(LAS float*)(S + SA_QG + h * 256 + l2 * 4) = bf2f(Q[qrow * 768 + h * 96 + l2]) * gkn[l2]; }
        bf16x8 qv[2];
        { const bf16x8 qfr = *(const bf16x8*)(Q + qrow * 768 + h * 96 + 64 + 8 * (lane >> 4));
          qv[0] = ((lane & 7) == 0) ? qfr : bf16x8{}; qv[1] = ((lane & 7) == 4) ? qfr : bf16x8{}; }
        float m_run = -INFINITY, l_run = 0.f; f32x4 ctx = (f32x4){0.f, 0.f, 0.f, 0.f};
        f32x4 pl[8]; f32x4 pk[2];
        const int pgs = ptab[sq * NPAGES + half * 64 + lane];
#define SA_PREFETCH(pgidx) do { const int pg_ = __builtin_amdgcn_readlane(pgs, (pgidx)); \
          const char* lb_ = (const char*)(cache_lat + (size_t)pg_ * (PAGE * KVLR)); const char* kb_ = (const char*)(cache_kr + (size_t)pg_ * (PAGE * ROPE_D)); \
          const unsigned lo_ = (unsigned)((tid >> 5) * 4096 + (tid & 31) * 16), ko_ = (unsigned)(tid * 16); \
          _Pragma("unroll") for (int i = 0; i < 8; ++i) pl[i] = __builtin_nontemporal_load((const f32x4*)(lb_ + lo_ + i * 512)); \
          pk[0] = __builtin_nontemporal_load((const f32x4*)(kb_ + ko_)); pk[1] = __builtin_nontemporal_load((const f32x4*)(kb_ + 8192 + ko_)); } while (0)
        SA_PREFETCH(0);
#pragma unroll 1
        for (int pgi = 0; pgi < 64; ++pgi) {
            const int pb = pgi & 1;
#ifndef SA_REP_STAGE
#define SA_REP_STAGE 1
#endif
#ifndef SA_REP_TILE
#define SA_REP_TILE 1
#endif
            for (int rs_ = 0; rs_ < SA_REP_STAGE; ++rs_) { asm volatile("" ::: "memory");
            { unsigned lo[8], hi2[8];
#pragma unroll
              for (int i = 0; i < 8; ++i) { lo[i] = pk2(pl[i].x, pl[i].y); hi2[i] = pk2(pl[i].z, pl[i].w); *(LAS v2u*)(S + SA_LK + (8 * kg + i) * LK_PITCH + dq * 8) = (v2u){lo[i], hi2[i]}; }
              v4u w0, w1, w2, w3;
#pragma unroll
              for (int i = 0; i < 4; ++i) { w0[i] = __builtin_amdgcn_perm(lo[2 * i + 1], lo[2 * i], 0x05040100u); w1[i] = __builtin_amdgcn_perm(lo[2 * i + 1], lo[2 * i], 0x07060302u);
                                            w2[i] = __builtin_amdgcn_perm(hi2[2 * i + 1], hi2[2 * i], 0x05040100u); w3[i] = __builtin_amdgcn_perm(hi2[2 * i + 1], hi2[2 * i], 0x07060302u); }
              LAS unsigned char* T = S + SA_LT + pb * SA_LT_BUF + kg * 16;
              *(LAS v4u*)(T + (4 * dq + 0) * LT_PITCH) = w0; *(LAS v4u*)(T + (4 * dq + 1) * LT_PITCH) = w1; *(LAS v4u*)(T + (4 * dq + 2) * LT_PITCH) = w2; *(LAS v4u*)(T + (4 * dq + 3) * LT_PITCH) = w3; }
#pragma unroll
            for (int i = 0; i < 2; ++i) { const int c = tid + 512 * i, key = c >> 3, part = c & 7; *(LAS v2u*)(S + SA_KR + key * LKR_PITCH + part * 8) = (v2u){pk2(pk[i].x, pk[i].y), pk2(pk[i].z, pk[i].w)}; }
            }
            if (pgi + 1 < 64) SA_PREFETCH(pgi + 1);
            __syncthreads();
            float sc[4];
            for (int rt_ = 0; rt_ < SA_REP_TILE; ++rt_) { asm volatile("" ::: "memory");
            { f32x16 a0, a1; f32x4 r4; bf16x8 bf[8], kb0, kb1; float ssx, ssy, dtx, dty;
#define SA_LOADB(kt) do { _Pragma("unroll") for (int s = 0; s < 8; ++s) bf[s] = *(const LAS bf16x8*)(S + SA_LK + (32 * (kt) + r32) * LK_PITCH + (16 * s + 8 * hh) * 2); \
                const LAS unsigned char* kr_ = S + SA_KR + (32 * (kt) + (lane & 15)) * LKR_PITCH + (lane >> 4) * 16; kb0 = *(const LAS bf16x8*)kr_; kb1 = *(const LAS bf16x8*)(kr_ + 16 * LKR_PITCH); } while (0)
#define SA_ROPE() do { r4 = (f32x4){0.f, 0.f, 0.f, 0.f}; r4 = mfma16(qv[0], kb0, r4); r4 = mfma16(qv[1], kb1, r4); } while (0)
#define SA_MF(A, rt) do { A = f32x16{}; _Pragma("unroll") for (int s = 0; s < 8; ++s) A = mfma32(wk[rt][s], bf[s], A); } while (0)
#define SA_RED(A, rt) do { f32x4 q_[4]; _Pragma("unroll") for (int g = 0; g < 4; ++g) q_[g] = *(const LAS f32x4*)(S + SA_QG + h * 256 + (32 * (rt) + 8 * g + 4 * hh) * 4); \
                _Pragma("unroll") for (int g = 0; g < 4; ++g) { ssx += A[4 * g] * A[4 * g]; ssy += A[4 * g + 1] * A[4 * g + 1]; ssx += A[4 * g + 2] * A[4 * g + 2]; ssy += A[4 * g + 3] * A[4 * g + 3]; } \
                _Pragma("unroll") for (int g = 0; g < 4; ++g) { dtx += A[4 * g] * q_[g].x; dty += A[4 * g + 1] * q_[g].y; dtx += A[4 * g + 2] * q_[g].z; dty += A[4 * g + 3] * q_[g].w; } } while (0)
#define SA_FIN(kt, RV) do { const float ss_ = xhalf_sum_pl(ssx + ssy), dot_ = xhalf_sum_pl(dtx + dty); sc[kt] = __builtin_amdgcn_rsqf(ss_ * (1.f / 64.f) + EPS) * dot_ + (RV); } while (0)
#define SA_SB() __builtin_amdgcn_sched_barrier(0)
              float rv;
              SA_LOADB(0); SA_ROPE(); SA_MF(a0, 0); SA_SB();
#pragma unroll
              for (int kt = 0; kt < 4; ++kt) {
                  ssx = 0.f; ssy = 0.f; dtx = 0.f; dty = 0.f; rv = r4[0];
                  SA_MF(a1, 1); SA_SB();
                  if (kt < 3) { SA_LOADB(kt + 1); SA_SB(); }
                  SA_RED(a0, 0); SA_SB();
                  if (kt < 3) { SA_ROPE(); SA_MF(a0, 0); SA_SB(); }
                  SA_RED(a1, 1); SA_FIN(kt, rv); SA_SB();
              }
#undef SA_LOADB
#undef SA_ROPE
#undef SA_MF
#undef SA_RED
#undef SA_FIN
#undef SA_SB
            } }
            float mx = half_max32(fmaxf(fmaxf(sc[0], sc[1]), fmaxf(sc[2], sc[3])));
            const float m_new = fmaxf(m_run, mx); const float alpha = __builtin_amdgcn_exp2f(m_run - m_new); m_run = m_new;
            float ps = 0.f;
#pragma unroll
            for (int kt = 0; kt < 4; ++kt) { const float e = __builtin_amdgcn_exp2f(sc[kt] - m_new); ps += e; if (hh == 0) *(LAS bf16*)(S + SA_P + pb * SA_P_BUF + h * 256 + (32 * kt + r32) * 2) = (bf16)f2bf(e); }
            l_run = l_run * alpha + ps;
            if (lane == 0) *(LAS float*)(S + SA_AL + pb * 32 + h * 4) = alpha;
            __syncthreads();
            { const int g4 = lane >> 4, n16 = lane & 15;
              if (g4 < 2) { const f32x4 al = *(const LAS f32x4*)(S + SA_AL + pb * 32 + 16 * g4); ctx = ctx * al; }
#pragma unroll
              for (int ks = 0; ks < 4; ++ks) {
                  bf16x8 af = *(const LAS bf16x8*)(S + SA_P + pb * SA_P_BUF + (n16 & 7) * 256 + (32 * ks + 8 * g4) * 2); if (n16 >= 8) af = bf16x8{};
                  const bf16x8 bfr = *(const LAS bf16x8*)(S + SA_LT + pb * SA_LT_BUF + (16 * h + n16) * LT_PITCH + (32 * ks + 8 * g4) * 2);
                  ctx = mfma16(af, bfr, ctx); } }
        }
#undef SA_PREFETCH
        { const int ln = fresh_lane(); const int g4 = ln >> 4, n16 = ln & 15; float* pu = PART + (size_t)u * PART_STRIDE;
          if (g4 < 2) {
#pragma unroll
              for (int i = 0; i < 4; ++i) pu[(4 * g4 + i) * 132 + 16 * h + n16] = ctx[i]; }
          const float lsum = wave_sum(l_run) * 0.5f;
          if (ln == 0) { pu[h * 132 + 128] = m_run; pu[h * 132 + 129] = lsum; } }
        __syncthreads();
    }
}

typedef int v8i __attribute__((ext_vector_type(8)));
constexpr int L8_PITCH = 144;
constexpr int S8_LK = 0, S8_LK_BUF = 128 * L8_PITCH, S8_LT = 2 * S8_LK_BUF, S8_LT_BUF = 128 * LT_PITCH, S8_KR = S8_LT + 2 * S8_LT_BUF, S8_KR_BUF = 128 * LKR_PITCH,
              S8_DOT = S8_KR + 2 * S8_KR_BUF, S8_ROPE = S8_DOT + 4096, S8_P = S8_ROPE + 4096, S8_AL = S8_P + 2048, S8_QA = S8_AL + 32, S8_QG = S8_QA + 2048, S8_END = S8_QG + 2048;
static_assert(S8_END <= RING_BYTES, "fp8 sample attention LDS");
__device__ __forceinline__ int fp8x4(float a, float b, float c, float d) { int w = 0; w = __builtin_amdgcn_cvt_pk_fp8_f32(a, b, w, false); w = __builtin_amdgcn_cvt_pk_fp8_f32(c, d, w, true); return w; }
__device__ __forceinline__ f32x16 mfma8(v8i a, v8i b, f32x16 c) { return __builtin_amdgcn_mfma_scale_f32_32x32x64_f8f6f4(a, b, c, 0, 0, 0, 127, 0, 127); }
__device__ __forceinline__ void phase_attn_sample8(const Ctx& C, const Params& P) {
    const int lane = C.lane, h = C.wave, tid = C.tid, r32 = lane & 31, hh = lane >> 5;
    const bf16* WUKV = WSP(const bf16, WS_WUKV); const bf16* Q = WSP(const bf16, WS_Q); float* PART = WSP(float, WS_PART);
    const float* cache_lat = P.in[2]; const float* cache_kr = P.in[3]; const int* ptab = (const int*)P.in[7]; const float* gkn = P.in[28];
    LAS unsigned char* S = C.lds + RING_OFF; const unsigned lds0 = (unsigned)(uintptr_t)S;
    v8i wk8[2][2];
#pragma unroll
    for (int rt = 0; rt < 2; ++rt)
#pragma unroll
        for (int ks = 0; ks < 2; ++ks) { const bf16* wp = WUKV + (size_t)(h * 128 + 32 * rt + r32) * 256 + 64 * ks + 32 * hh;
#pragma unroll
            for (int q = 0; q < 4; ++q) { const v4u w = *(const v4u*)(wp + 8 * q); float f[8]; unpack8f(w, f);
                wk8[rt][ks][2 * q] = fp8x4(16.f * f[0], 16.f * f[1], 16.f * f[2], 16.f * f[3]); wk8[rt][ks][2 * q + 1] = fp8x4(16.f * f[4], 16.f * f[5], 16.f * f[6], 16.f * f[7]); } }
    const int kg = tid >> 5, dq = tid & 31;
    for (int u = C.bid; u < 256; u += C.G) {
        const int sq = u >> 1, half = u & 1; const size_t qrow = (size_t)(MP + sq);
        { const int l2 = fresh_lane(); *(LAS float*)(S + S8_QG + h * 256 + l2 * 4) = bf2f(Q[qrow * 768 + h * 96 + l2]) * gkn[l2];
          const int kc = l2 & 15, dg = l2 >> 4; float acc[8] = {0.f, 0.f, 0.f, 0.f, 0.f, 0.f, 0.f, 0.f};
          asm volatile("s_waitcnt lgkmcnt(0)" ::: "memory");
#pragma unroll 4
          for (int i = 0; i < 16; ++i) { const int d = dg + 4 * i; const v4u w = *(const v4u*)(WUKV + (size_t)(h * 128 + d) * 256 + 8 * kc); float f[8]; unpack8f(w, f);
              const float qd = *(const LAS float*)(S + S8_QG + h * 256 + d * 4);
#pragma unroll
              for (int j = 0; j < 8; ++j) acc[j] += f[j] * qd; }
#pragma unroll
          for (int j = 0; j < 8; ++j) { acc[j] += lane_xor16(acc[j], l2); acc[j] += lane_xor32(acc[j], l2); }
          if (dg == 0) *(LAS bf16x8*)(S + S8_QA + h * 256 + kc * 16) = pack8(acc); }
        float m_run = -INFINITY, l_run = 0.f; f32x4 ctx = (f32x4){0.f, 0.f, 0.f, 0.f};
        f32x4 pl[8]; f32x4 pk[2];
        const int pgs = ptab[sq * NPAGES + half * 64 + lane];
#define S8_PREFETCH(pgidx) do { const int pg_ = __builtin_amdgcn_readlane(pgs, (pgidx)); \
          const char* lb_ = (const char*)(cache_lat + (size_t)pg_ * (PAGE * KVLR)); const char* kb_ = (const char*)(cache_kr + (size_t)pg_ * (PAGE * ROPE_D)); \
          const unsigned lo_ = (unsigned)((tid >> 5) * 4096 + (tid & 31) * 16), ko_ = (unsigned)(tid * 16); \
          _Pragma("unroll") for (int i = 0; i < 8; ++i) pl[i] = __builtin_nontemporal_load((const f32x4*)(lb_ + lo_ + i * 512)); \
          pk[0] = __builtin_nontemporal_load((const f32x4*)(kb_ + ko_)); pk[1] = __builtin_nontemporal_load((const f32x4*)(kb_ + 8192 + ko_)); } while (0)
#define S8_STAGE(nb) do { \
          unsigned lo[8], hi2[8]; \
          _Pragma("unroll") for (int i = 0; i < 8; ++i) { lo[i] = pk2(pl[i].x, pl[i].y); hi2[i] = pk2(pl[i].z, pl[i].w); \
              *(LAS int*)(S + S8_LK + (nb) * S8_LK_BUF + (8 * kg + i) * L8_PITCH + dq * 4) = fp8x4(pl[i].x, pl[i].y, pl[i].z, pl[i].w); } \
          v4u w0, w1, w2, w3; \
          _Pragma("unroll") for (int i = 0; i < 4; ++i) { w0[i] = __builtin_amdgcn_perm(lo[2 * i + 1], lo[2 * i], 0x05040100u); w1[i] = __builtin_amdgcn_perm(lo[2 * i + 1], lo[2 * i], 0x07060302u); \
                                            w2[i] = __builtin_amdgcn_perm(hi2[2 * i + 1], hi2[2 * i], 0x05040100u); w3[i] = __builtin_amdgcn_perm(hi2[2 * i + 1], hi2[2 * i], 0x07060302u); } \
          LAS unsigned char* T = S + S8_LT + (nb) * S8_LT_BUF + kg * 16; \
          *(LAS v4u*)(T + (4 * dq + 0) * LT_PITCH) = w0; *(LAS v4u*)(T + (4 * dq + 1) * LT_PITCH) = w1; *(LAS v4u*)(T + (4 * dq + 2) * LT_PITCH) = w2; *(LAS v4u*)(T + (4 * dq + 3) * LT_PITCH) = w3; \
          _Pragma("unroll") for (int i = 0; i < 2; ++i) { const int c = tid + 512 * i, key = c >> 3, part = c & 7; \
              *(LAS v2u*)(S + S8_KR + (nb) * S8_KR_BUF + key * LKR_PITCH + part * 8) = (v2u){pk2(pk[i].x, pk[i].y), pk2(pk[i].z, pk[i].w)}; } } while (0)
#define S8_DOTROPE(nb) do { \
          const int n16_ = lane & 15, g4_ = lane >> 4, q4_ = n16_ >> 2, p4_ = n16_ & 3; \
          f32x4 dacc = (f32x4){0.f, 0.f, 0.f, 0.f}, racc = (f32x4){0.f, 0.f, 0.f, 0.f}; \
          const unsigned tb_ = lds0 + S8_LT + (nb) * S8_LT_BUF + (8 * g4_ + q4_) * LT_PITCH + (16 * h + 4 * p4_) * 2; \
          s16x4 tl_[4], th_[4]; \
          asm volatile("ds_read_b64_tr_b16 %0, %8\n\tds_read_b64_tr_b16 %1, %8 offset:%9\n\tds_read_b64_tr_b16 %2, %8 offset:%10\n\tds_read_b64_tr_b16 %3, %8 offset:%11\n\t" \
                       "ds_read_b64_tr_b16 %4, %8 offset:%12\n\tds_read_b64_tr_b16 %5, %8 offset:%13\n\tds_read_b64_tr_b16 %6, %8 offset:%14\n\tds_read_b64_tr_b16 %7, %8 offset:%15\n\ts_waitcnt lgkmcnt(0)" \
                       : "=&v"(tl_[0]), "=&v"(th_[0]), "=&v"(tl_[1]), "=&v"(th_[1]), "=&v"(tl_[2]), "=&v"(th_[2]), "=&v"(tl_[3]), "=&v"(th_[3]) \
                       : "v"(tb_), "i"(4 * LT_PITCH), "i"(32 * LT_PITCH), "i"(36 * LT_PITCH), "i"(64 * LT_PITCH), "i"(68 * LT_PITCH), "i"(96 * LT_PITCH), "i"(100 * LT_PITCH) : "memory"); \
          _Pragma("unroll") for (int ks = 0; ks < 4; ++ks) dacc = mfma16(qa[ks], __builtin_shufflevector(tl_[ks], th_[ks], 0, 1, 2, 3, 4, 5, 6, 7), dacc); \
          { const bf16x8 kb_ = *(const LAS bf16x8*)(S + S8_KR + (nb) * S8_KR_BUF + (16 * h + n16_) * LKR_PITCH + g4_ * 16); racc = mfma16(qr, kb_, racc); } \
          if (g4_ < 2) { _Pragma("unroll") for (int i = 0; i < 4; ++i) { *(LAS float*)(S + S8_DOT + ((4 * g4_ + i) * 128 + 16 * h + n16_) * 4) = dacc[i]; *(LAS float*)(S + S8_ROPE + ((4 * g4_ + i) * 128 + 16 * h + n16_) * 4) = racc[i]; } } } while (0)
        S8_PREFETCH(0);
        __syncthreads();
        bf16x8 qa[4], qr;
        { const int n16 = lane & 15, g4 = lane >> 4;
#pragma unroll
          for (int ks = 0; ks < 4; ++ks) { bf16x8 f = *(const LAS bf16x8*)(S + S8_QA + (n16 & 7) * 256 + (32 * ks + 8 * g4) * 2); if (n16 >= 8) f = bf16x8{}; qa[ks] = f; }
          qr = bf16x8{}; if (n16 < 8) qr = *(const bf16x8*)(Q + qrow * 768 + n16 * 96 + 64 + 8 * g4); }
        S8_STAGE(0); S8_PREFETCH(1);
        __syncthreads();
        S8_DOTROPE(0);
#pragma unroll 1
        for (int pgi = 0; pgi < 64; ++pgi) {
            const int pb = pgi & 1;
            __syncthreads();
            float sc[4];
            { v8i bA0, bA1, bB0, bB1; f32x16 xa0, xa1, ya0, ya1; float dvA, rvA, dvB, rvB;
#define S8_LOADB(kt, B0, B1, DV, RV) do { const LAS unsigned char* bp_ = S + S8_LK + pb * S8_LK_BUF + (32 * (kt) + r32) * L8_PITCH + 32 * hh; \
                const v4u b00_ = *(const LAS v4u*)bp_, b01_ = *(const LAS v4u*)(bp_ + 16), b10_ = *(const LAS v4u*)(bp_ + 64), b11_ = *(const LAS v4u*)(bp_ + 80); \
                DV = *(const LAS float*)(S + S8_DOT + (h * 128 + 32 * (kt) + r32) * 4); RV = *(const LAS float*)(S + S8_ROPE + (h * 128 + 32 * (kt) + r32) * 4); \
                B0 = (v8i){(int)b00_.x, (int)b00_.y, (int)b00_.z, (int)b00_.w, (int)b01_.x, (int)b01_.y, (int)b01_.z, (int)b01_.w}; \
                B1 = (v8i){(int)b10_.x, (int)b10_.y, (int)b10_.z, (int)b10_.w, (int)b11_.x, (int)b11_.y, (int)b11_.z, (int)b11_.w}; } while (0)
#define S8_MF(B0, B1, A0, A1) do { A0 = f32x16{}; A1 = f32x16{}; A0 = mfma8(wk8[0][0], B0, A0); A1 = mfma8(wk8[1][0], B0, A1); A0 = mfma8(wk8[0][1], B1, A0); A1 = mfma8(wk8[1][1], B1, A1); } while (0)
#define S8_RED(kt, A0, A1, DV, RV) do { float sx_ = 0.f, sy_ = 0.f; \
                _Pragma("unroll") for (int r = 0; r < 16; r += 2) { sx_ += A0[r] * A0[r]; sy_ += A0[r + 1] * A0[r + 1]; sx_ += A1[r] * A1[r]; sy_ += A1[r + 1] * A1[r + 1]; } \
                const float ss_ = xhalf_sum_pl(sx_ + sy_); sc[kt] = __builtin_amdgcn_rsqf(ss_ * (1.f / (64.f * 256.f)) + EPS) * (DV) + (RV); } while (0)
#define S8_SB() __builtin_amdgcn_sched_barrier(0)
              S8_LOADB(0, bA0, bA1, dvA, rvA); S8_LOADB(1, bB0, bB1, dvB, rvB); S8_MF(bA0, bA1, xa0, xa1); S8_SB();
              { const float d0 = dvA, r0 = rvA; S8_MF(bB0, bB1, ya0, ya1); S8_LOADB(2, bA0, bA1, dvA, rvA); S8_RED(0, xa0, xa1, d0, r0); S8_SB(); }
              { const float d1 = dvB, r1 = rvB; S8_MF(bA0, bA1, xa0, xa1); S8_LOADB(3, bB0, bB1, dvB, rvB); S8_RED(1, ya0, ya1, d1, r1); S8_SB(); }
              S8_MF(bB0, bB1, ya0, ya1); S8_RED(2, xa0, xa1, dvA, rvA); S8_SB();
              S8_RED(3, ya0, ya1, dvB, rvB);
#undef S8_LOADB
#undef S8_MF
#undef S8_RED
#undef S8_SB
            }
            float mx = half_max32(fmaxf(fmaxf(sc[0], sc[1]), fmaxf(sc[2], sc[3])));
            const float m_new = fmaxf(m_run, mx); const float alpha = __builtin_amdgcn_exp2f(m_run - m_new); m_run = m_new;
            float ps = 0.f;
#pragma unroll
            for (int kt = 0; kt < 4; ++kt) { const float e = __builtin_amdgcn_exp2f(sc[kt] - m_new); ps += e; if (hh == 0) *(LAS bf16*)(S + S8_P + h * 256 + (32 * kt + r32) * 2) = (bf16)f2bf(e); }
            l_run = l_run * alpha + ps;
            if (lane == 0) *(LAS float*)(S + S8_AL + h * 4) = alpha;
            if (pgi + 1 < 64) { S8_STAGE(pb ^ 1); if (pgi + 2 < 64) S8_PREFETCH(pgi + 2); }
            __syncthreads();
            { const int g4 = lane >> 4, n16 = lane & 15;
              const f32x4 al = *(const LAS f32x4*)(S + S8_AL + 16 * (g4 & 1));
              bf16x8 af[4], bfr[4];
#pragma unroll
              for (int ks = 0; ks < 4; ++ks) { af[ks] = *(const LAS bf16x8*)(S + S8_P + (n16 & 7) * 256 + (32 * ks + 8 * g4) * 2);
                  bfr[ks] = *(const LAS bf16x8*)(S + S8_LT + pb * S8_LT_BUF + (16 * h + n16) * LT_PITCH + (32 * ks + 8 * g4) * 2); }
              if (g4 < 2) ctx = ctx * al;
#pragma unroll
              for (int ks = 0; ks < 4; ++ks) { if (n16 >= 8) af[ks] = bf16x8{}; ctx = mfma16(af[ks], bfr[ks], ctx); } }
            if (pgi + 1 < 64) S8_DOTROPE(pb ^ 1);
        }
#undef S8_PREFETCH
#undef S8_STAGE
#undef S8_DOTROPE
        { const int ln = fresh_lane(); const int g4 = ln >> 4, n16 = ln & 15; float* pu = PART + (size_t)u * PART_STRIDE;
          if (g4 < 2) {
#pragma unroll
              for (int i = 0; i < 4; ++i) pu[(4 * g4 + i) * 132 + 16 * h + n16] = ctx[i]; }
          const float lsum = wave_sum(l_run) * 0.5f;
          if (ln == 0) { pu[h * 132 + 128] = m_run; pu[h * 132 + 129] = lsum; } }
        __syncthreads();
    }
}

__device__ __forceinline__ void phase_sample_combine(const Ctx& C, const Params& P) {
    const int gw = C.bid * NWAVES + C.wave, NGW = C.G * NWAVES, lane = C.lane;
    const float* PART = WSP(const float, WS_PART); const bf16* Q = WSP(const bf16, WS_Q); const bf16* KF = WSP(const bf16, WS_KF); const bf16* KVRAW = WSP(const bf16, WS_KVRAW);
    bf16* ATT = WSP(bf16, WS_ATT); const float* wukv = P.in[27];
    for (int it = gw; it < MS * NHEAD; it += NGW) {
        const int sq = it >> 3, h = it & 7; const size_t row = (size_t)(MP + sq);
        const float* p0 = PART + (size_t)(2 * sq) * PART_STRIDE + h * 132; const float* p1 = p0 + PART_STRIDE;
        float sn = 0.f; if (lane < 48) { const unsigned qa = *(const unsigned*)(Q + row * 768 + h * 96 + 2 * lane), ka = *(const unsigned*)(KF + row * 768 + h * 96 + 2 * lane); sn = bflo(qa) * bflo(ka) + bfhi(qa) * bfhi(ka); }
        sn = wave_sum(sn);
        const float m0 = p0[128], l0 = p0[129], m1 = p1[128], l1 = p1[129];
        const float M = fmaxf(fmaxf(m0, m1), sn); const float w0 = exp2f(m0 - M), w1 = exp2f(m1 - M), wn = exp2f(sn - M);
        const float Lt = l0 * w0 + l1 * w1 + wn;
        const float c_lo = p0[lane] * w0 + p1[lane] * w1, c_hi = p0[64 + lane] * w0 + p1[64 + lane] * w1;
        float acc = 0.f; const float* wv = wukv + h * 128 + 64 + lane;
#pragma unroll
        for (int k = 0; k < 64; ++k) { acc += __builtin_bit_cast(float, __builtin_amdgcn_readlane(__builtin_bit_cast(int, c_lo), k)) * wv[(size_t)k * 1024];
                                       acc += __builtin_bit_cast(float, __builtin_amdgcn_readlane(__builtin_bit_cast(int, c_hi), k)) * wv[(size_t)(64 + k) * 1024]; }
        const float outv = (acc + wn * bf2f(KVRAW[row * 1024 + h * 128 + 64 + lane])) / Lt;
        ATT[row * 512 + h * 64 + lane] = (bf16)f2bf(outv);
    }
}

__device__ __forceinline__ void phase_mix(const Ctx& C, const Params& P) {
    const int gw = C.bid * NWAVES + C.wave, NGW = C.G * NWAVES, lane = C.lane;
    const bf16* Z = WSP(const bf16, WS_Z); const bf16* HL = WSP(const bf16, WS_HL); const bf16* AC = WSP(const bf16, WS_AC); const bf16* ATT = WSP(const bf16, WS_ATT);
    const float* CAR = WSP(const float, WS_CARRY); bf16* MIX = WSP(bf16, WS_MIX);
    const int c = 8 * lane;
    float glo[8], gmo[8];
#pragma unroll
    for (int j = 0; j < 8; ++j) { glo[j] = P.in[29][c + j]; gmo[j] = P.in[30][c + j]; }
    for (int r0 = gw; r0 < MREAL; r0 += 2 * NGW) {
        v4u wh[2], wa[2], wg[2], wt[2]; f32x4 c0[2], c1[2]; int rr[2];
#pragma unroll
        for (int u = 0; u < 2; ++u) { const int r = (r0 + u * NGW < MREAL) ? r0 + u * NGW : r0; rr[u] = r;
            wh[u] = *(const v4u*)(HL + (size_t)r * 512 + c); wa[u] = *(const v4u*)(AC + (size_t)r * 512 + c); wg[u] = *(const v4u*)(Z + (size_t)r * ZC + 512 + c); wt[u] = *(const v4u*)(ATT + (size_t)r * 512 + c);
            c0[u] = (f32x4){0.f, 0.f, 0.f, 0.f}; c1[u] = c0[u];
            if (r < MP) { const float* cp = CAR + ((size_t)(r >> 11) * 32 + ((r & 2047) >> 6)) * 512 + c; c0[u] = *(const f32x4*)cp; c1[u] = *(const f32x4*)(cp + 4); } }
#pragma unroll
        for (int u = 0; u < 2; ++u) { const int r = rr[u];
            float hv[8], av[8], gv[8], tv[8]; unpack8f(wh[u], hv); unpack8f(wa[u], av); unpack8f(wg[u], gv); unpack8f(wt[u], tv);
            const float cin[8] = {c0[u].x, c0[u].y, c0[u].z, c0[u].w, c1[u].x, c1[u].y, c1[u].z, c1[u].w};
            float ss = 0.f, s2 = 0.f;
#pragma unroll
            for (int j = 0; j < 8; ++j) { hv[j] = (hv[j] + av[j] * cin[j]) * gelu_tanh(gv[j]); ss += hv[j] * hv[j]; s2 += tv[j] * tv[j]; }
            const float rstd = rsqrtf(wave_sum(ss) * (1.f / 512.f) + EPS), rs2 = rsqrtf(wave_sum(s2) * (1.f / 512.f) + EPS);
#pragma unroll
            for (int j = 0; j < 8; ++j) { hv[j] = hv[j] * rstd * glo[j]; tv[j] = tv[j] * rs2 * gmo[j]; }
            *(bf16x8*)(MIX + (size_t)r * 1024 + c) = pack8(hv); *(bf16x8*)(MIX + (size_t)r * 1024 + 512 + c) = pack8(tv);
        }
    }
}

__device__ __forceinline__ void unpack8(const v4u& w, float* v) { v[0] = bflo(w.x); v[1] = bfhi(w.x); v[2] = bflo(w.y); v[3] = bfhi(w.y); v[4] = bflo(w.z); v[5] = bfhi(w.z); v[6] = bflo(w.w); v[7] = bfhi(w.w); }
__device__ __forceinline__ void phase_ffn_fixup(const Ctx& C, const Params& P) {
    const float* RAW = WSP(const float, WS_RAW); const bf16* UP = WSP(const bf16, WS_UP); bf16* ACT = WSP(bf16, WS_ACT); const float* fw = P.in[34]; const float* fb = P.in[35];
    const int gt = C.bid * 512 + C.tid, NGT = C.G * 512;
    for (int idx = gt; idx < 256 * 704; idx += NGT) {
        const int blk = idx / 704, c = 4 * (idx - blk * 704);
        if ((blk & 15) == 0) continue;
        const float* r0 = RAW + (size_t)(blk - 1) * 4 * UPC; const float* r1 = RAW + (size_t)blk * 4 * UPC;
        const f32x4 wv0 = *(const f32x4*)(fw + c), wv1 = *(const f32x4*)(fw + UPC + c), wv2 = *(const f32x4*)(fw + 2 * UPC + c), bv = *(const f32x4*)(fb + c);
        const f32x4 wg0 = *(const f32x4*)(fw + DFF + c), wg1 = *(const f32x4*)(fw + UPC + DFF + c), wg2 = *(const f32x4*)(fw + 2 * UPC + DFF + c), bg = *(const f32x4*)(fb + DFF + c);
        const f32x4 vm2 = *(const f32x4*)(r0 + c), vm1 = *(const f32x4*)(r0 + UPC + c), v0 = *(const f32x4*)(r1 + 2 * UPC + c), v1 = *(const f32x4*)(r1 + 3 * UPC + c);
        const f32x4 gm2 = *(const f32x4*)(r0 + DFF + c), gm1 = *(const f32x4*)(r0 + UPC + DFF + c), g0 = *(const f32x4*)(r1 + 2 * UPC + DFF + c), g1 = *(const f32x4*)(r1 + 3 * UPC + DFF + c);
        const f32x4 va = bv + wv0 * vm2 + wv1 * vm1 + wv2 * v0, ga = bg + wg0 * gm2 + wg1 * gm1 + wg2 * g0;
        const f32x4 vb = bv + wv0 * vm1 + wv1 * v0 + wv2 * v1, gb = bg + wg0 * gm1 + wg1 * g0 + wg2 * g1;
        v2u oa, ob; oa.x = pk2(gelu_tanh(ga.x) * va.x, gelu_tanh(ga.y) * va.y); oa.y = pk2(gelu_tanh(ga.z) * va.z, gelu_tanh(ga.w) * va.w);
        ob.x = pk2(gelu_tanh(gb.x) * vb.x, gelu_tanh(gb.y) * vb.y); ob.y = pk2(gelu_tanh(gb.z) * vb.z, gelu_tanh(gb.w) * vb.w);
        *(v2u*)(ACT + (size_t)(blk * 128) * DFF + c) = oa; *(v2u*)(ACT + (size_t)(blk * 128 + 1) * DFF + c) = ob;
    }
    for (int idx = gt; idx < NBATCH * 2 * (UPC / 4); idx += NGT) { const int b = idx / (2 * (UPC / 4)), rem = idx - b * (2 * (UPC / 4)), s = rem / (UPC / 4), c = 4 * (rem - s * (UPC / 4));
        *(f32x4*)(P.out + O_FCP + ((size_t)b * 2 + s) * UPC + c) = *(const f32x4*)(RAW + ((size_t)(16 * b + 15) * 4 + s) * UPC + c); }
    for (int idx = gt; idx < MS * 352; idx += NGT) {
        const int s_ = idx / 352, c = 8 * (idx - s_ * 352); const int r = MP + s_;
        float v0[8], g0[8]; unpack8(*(const v4u*)(UP + (size_t)r * UPC + c), v0); unpack8(*(const v4u*)(UP + (size_t)r * UPC + DFF + c), g0);
        const float* st = P.in[6] + (size_t)s_ * 2 * UPC; float* d = P.out + O_FCS + (size_t)s_ * 2 * UPC;
        float o[8];
#pragma unroll
        for (int q = 0; q < 2; ++q) { const int cc = c + 4 * q;
            const f32x4 v2 = *(const f32x4*)(st + cc), g2 = *(const f32x4*)(st + DFF + cc), v1 = *(const f32x4*)(st + UPC + cc), g1 = *(const f32x4*)(st + UPC + DFF + cc);
            const f32x4 vv = (f32x4){v0[4 * q], v0[4 * q + 1], v0[4 * q + 2], v0[4 * q + 3]}, gg = (f32x4){g0[4 * q], g0[4 * q + 1], g0[4 * q + 2], g0[4 * q + 3]};
            *(f32x4*)(d + cc) = v1; *(f32x4*)(d + DFF + cc) = g1; *(f32x4*)(d + UPC + cc) = vv; *(f32x4*)(d + UPC + DFF + cc) = gg;
            const f32x4 val = *(const f32x4*)(fb + cc) + *(const f32x4*)(fw + cc) * v2 + *(const f32x4*)(fw + UPC + cc) * v1 + *(const f32x4*)(fw + 2 * UPC + cc) * vv;
            const f32x4 gt_ = *(const f32x4*)(fb + DFF + cc) + *(const f32x4*)(fw + DFF + cc) * g2 + *(const f32x4*)(fw + UPC + DFF + cc) * g1 + *(const f32x4*)(fw + 2 * UPC + DFF + cc) * gg;
#pragma unroll
            for (int e = 0; e < 4; ++e) o[4 * q + e] = gelu_tanh(gt_[e]) * val[e]; }
        *(bf16x8*)(ACT + (size_t)r * DFF + c) = pack8(o);
    }
}

__device__ __forceinline__ void phase_stream_probe(const Ctx& C, const Params& P) {
    const float* cache_lat = P.in[2]; const float* cache_kr = P.in[3]; const int* ptab = (const int*)P.in[7]; const int tid = C.tid, lane = C.lane;
    float accum = 0.f;
    for (int u = C.bid; u < 256; u += C.G) {
        const int sq = u >> 1, half = u & 1;
        const int pgs = ptab[sq * NPAGES + half * 64 + lane];
        f32x4 pl[8], pk[2];
#define PR_PREFETCH(pgidx) do { const int pg_ = __builtin_amdgcn_readlane(pgs, (pgidx)); \
          const char* lb_ = (const char*)(cache_lat + (size_t)pg_ * (PAGE * KVLR)); const char* kb_ = (const char*)(cache_kr + (size_t)pg_ * (PAGE * ROPE_D)); \
          const unsigned lo_ = (unsigned)((tid >> 5) * 4096 + (tid & 31) * 16), ko_ = (unsigned)(tid * 16); \
          _Pragma("unroll") for (int i = 0; i < 8; ++i) pl[i] = __builtin_nontemporal_load((const f32x4*)(lb_ + lo_ + i * 512)); \
          pk[0] = __builtin_nontemporal_load((const f32x4*)(kb_ + ko_)); pk[1] = __builtin_nontemporal_load((const f32x4*)(kb_ + 8192 + ko_)); } while (0)
        PR_PREFETCH(0);
#pragma unroll 1
        for (int pgi = 0; pgi < 64; ++pgi) {
            float s = 0.f;
#pragma unroll
            for (int i = 0; i < 8; ++i) s += (pl[i].x + pl[i].y) + (pl[i].z + pl[i].w);
            s += pk[0].x + pk[1].y;
            if (pgi + 1 < 64) PR_PREFETCH(pgi + 1);
            accum += s;
        }
#undef PR_PREFETCH
    }
    WSP(float, WS_END)[C.bid * 512 + tid] = accum;
}
#ifndef SA_FP8
#define SA_FP8 1
#endif

constexpr int N_LAUNCHES = MK_N_LAUNCHES;
constexpr int N_PHASES = 16;
template <int PHASE_MASK> __global__ void __launch_bounds__(NWAVES * 64, 2) mk_fwd(Params P) {
    extern __shared__ __attribute__((aligned(16))) unsigned char lds[];
    Ctx C0; C0.lds = (LAS unsigned char*)lds; C0.tid = threadIdx.x; C0.lane = C0.tid & 63; C0.wave = __builtin_amdgcn_readfirstlane(C0.tid >> 6); C0.G = gridDim.x; C0.bid = blockIdx.x; C0.p = nullptr;
    const Ctx& C = C0;
    volatile LAS unsigned* MISC = (volatile LAS unsigned*)(C.lds + MISC_OFF);
    for (int u = C.tid; u < (LDS_BYTES - LDSCTL_OFF) / 4; u += NWAVES * 64) ((LAS unsigned*)(C.lds + LDSCTL_OFF))[u] = 0u;
    __syncthreads();
    gu32* ctl = (gu32*)(P.ws + WS_CTL);
    XcdBarrier bar; bar.bar = (unsigned*)(ctl + CW_BAR); bar.x = 0; bar.st = nullptr;
    if (N_LAUNCHES == 1) bar = xcd_barrier_post((unsigned*)(ctl + CW_BAR), MISC + 8, C0.tid);
    const int lo = P.ph_lo, hi = P.ph_hi;
#define IN(k) (((PHASE_MASK >> (k)) & 1) && lo <= (k) && (k) < hi)
#ifndef EXTRA_BARRIERS
#define EXTRA_BARRIERS 0
#endif
#define SEAM(k) do { if (IN(k) && IN((k) + 1)) { PHASE_CTX(); xcd_barrier(bar, C.tid); for (int xb_ = 0; xb_ < EXTRA_BARRIERS; ++xb_) xcd_barrier(bar, C.tid); } } while (0)
#ifndef REPEAT_MASK
#define REPEAT_MASK 0
#endif
#define NREP(k) (((REPEAT_MASK >> (k)) & 1) ? 2 : 1)
#define PHASE_CTX() Ctx C = C0; asm volatile("v_mbcnt_lo_u32_b32 %0, -1, 0\n\tv_mbcnt_hi_u32_b32 %0, -1, %0" : "=v"(C.lane)); C.tid = C0.wave * 64 + C.lane

    if (IN(0)) for (int rep_ = 0; rep_ < NREP(0); ++rep_) { PHASE_CTX(); phase_p0a(C, P); } SEAM(0);
    if (IN(1)) for (int rep_ = 0; rep_ < NREP(1); ++rep_) { PHASE_CTX(); phase_p0b(C, P); } SEAM(1);
    if (IN(2)) for (int rep_ = 0; rep_ < NREP(2); ++rep_) { PHASE_CTX();
        { EpiSB Es{WSP(float, WS_SB)}; skinny_gemm_splitk<8>(C, WSP(const bf16, WS_SH2), 1024, WSP(const bf16, WS_WUP), 1024, 9, UPC / 128, 1024, Es); }
        phase_norm_mod<false>(C, P); } SEAM(2);
    if (IN(3)) for (int rep_ = 0; rep_ < NREP(3); ++rep_) { PHASE_CTX();
        { EpiSkBf16 Es{WSP(bf16, WS_Z), ZC}; skinny_gemm_splitk<2>(C, WSP(const bf16, WS_H1) + (size_t)MP * 1024, 1024, WSP(const bf16, WS_WIN), 1024, 8, ZC / 32, 1024, Es); }
        pg8::Gemm g{WSP(const pg8::bf16_t, WS_H1), WSP(const pg8::bf16_t, WS_WIN), MP, ZC, 1024}; pg8::StaticOrder S; S.init(MP, ZC, C.G, C.bid);
        pg8::EpiBf16<0> E{WSP(pg8::bf16_t, WS_Z), ZC, nullptr, 0, 0, 1.f};
        pg8::gemm_phase<pg8::EpiBf16<0>, pg8::StaticOrder, true, true>(C.lds + RING_OFF, g, S, E, C.tid);
    } SEAM(3);
    if (IN(4)) for (int rep_ = 0; rep_ < NREP(4); ++rep_) { PHASE_CTX(); phase_p3a(C, P); phase_p3b<false>(C, P); } SEAM(4);
    if (IN(5)) for (int rep_ = 0; rep_ < NREP(5); ++rep_) { PHASE_CTX();
        { EpiSkBf16 Es{WSP(bf16, WS_QRAW), 768}; skinny_gemm<2>(C, WSP(const bf16, WS_QN) + (size_t)MP * 256, 256, WSP(const bf16, WS_WUQ), 256, 8, 768 / 32, 256, Es); }
        { EpiSkBf16 Es{WSP(bf16, WS_KVRAW), 1024}; skinny_gemm<2>(C, WSP(const bf16, WS_KVN) + (size_t)MP * 256, 256, WSP(const bf16, WS_WUKV), 256, 8, 1024 / 32, 128, Es); }
        pg8::Gemm g{WSP(const pg8::bf16_t, WS_QN), WSP(const pg8::bf16_t, WS_WUQ), MP, 768, 256}; pg8::StaticOrder S; S.init(MP, 768, C.G, C.bid);
        pg8::EpiBf16<0> E{WSP(pg8::bf16_t, WS_QRAW), 768, nullptr, 0, 0, 1.f};
        pg8::gemm_phase<pg8::EpiBf16<0>, pg8::StaticOrder, true, true>(C.lds + RING_OFF, g, S, E, C.tid);
        { Ctx C2 = C; C2.bid = (C.bid + 4) % C.G; if (C2.bid < 4) phase_p3b<true>(C2, P); }
    }
    if (IN(6)) for (int rep_ = 0; rep_ < NREP(6); ++rep_) { PHASE_CTX();
        pg8::Gemm g{WSP(const pg8::bf16_t, WS_KVN), WSP(const pg8::bf16_t, WS_WUKV), MP, 1024, 256}; pg8::StaticOrder S; S.init(MP, 1024, C.G, C.bid);
        pg8::EpiBf16<0> E{WSP(pg8::bf16_t, WS_KVRAW), 1024, nullptr, 0, 0, 1.f};
        pg8::gemm_phase<pg8::EpiBf16<0>, pg8::StaticOrder, true, true>(C.lds + RING_OFF, g, S, E, C.tid);
    } SEAM(6);
    if (IN(7)) for (int rep_ = 0; rep_ < NREP(7); ++rep_) { PHASE_CTX(); phase_p5(C, P); } SEAM(7);
    if (IN(8)) { { PHASE_CTX(); phase_carry(C, P); } for (int rep_ = 0; rep_ < NREP(16); ++rep_) { PHASE_CTX();
#if SA_FP8
            phase_attn_sample8(C, P);
#else
            phase_attn_sample(C, P);
#endif
        } if ((REPEAT_MASK >> 18) & 1) { PHASE_CTX(); phase_stream_probe(C, P); } for (int rep_ = 0; rep_ < NREP(17); ++rep_) { PHASE_CTX(); phase_attn_prompt(C, P); } } SEAM(8);
    if (IN(9)) for (int rep_ = 0; rep_ < NREP(9); ++rep_) { PHASE_CTX(); phase_sample_combine(C, P); } SEAM(9);
    if (IN(10)) for (int rep_ = 0; rep_ < NREP(10); ++rep_) { PHASE_CTX(); phase_mix(C, P); } SEAM(10);
    if (IN(11)) for (int rep_ = 0; rep_ < NREP(11); ++rep_) { PHASE_CTX();
        { EpiSkResGate<false, true, true> Es{P.in[1], WSP(bf16, WS_X1) + (size_t)MP * 1024, WSP(const float, WS_MOD), 2048, WSP(bf16, WS_H1) + (size_t)MP * 1024, P.in[32], WSP(float, WS_ROWSS) + MP}; skinny_gemm_splitk<2>(C, WSP(const bf16, WS_MIX) + (size_t)MP * 1024, 1024, WSP(const bf16, WS_WO), 1024, 8, 1024 / 32, 1024, Es); }
        pg8::Gemm g{WSP(const pg8::bf16_t, WS_MIX), WSP(const pg8::bf16_t, WS_WO), MP, 1024, 1024}; pg8::StaticOrder S; S.init(MP, 1024, C.G, C.bid);
        pg8::EpiResGate<false, true, true> E{P.in[0], WSP(bf16, WS_X1), WSP(const float, WS_MOD), 2048, WSP(pg8::bf16_t, WS_H1), P.in[32], WSP(float, WS_ROWSS)};
        pg8::gemm_phase<pg8::EpiResGate<false, true, true>, pg8::StaticOrder, true, true>(C.lds + RING_OFF, g, S, E, C.tid);
        if ((REPEAT_MASK >> 21) & 1) { pg8::EpiNull<false> En; pg8::gemm_phase<pg8::EpiNull<false>, pg8::StaticOrder, true, true>(C.lds + RING_OFF, g, S, En, C.tid); }
    } SEAM(11);
    if (IN(13)) for (int rep_ = 0; rep_ < NREP(13); ++rep_) { PHASE_CTX();
        { EpiSkUp Es{WSP(bf16, WS_UP), WSP(const float, WS_ROWSS), WSP(const float, WS_SB)}; skinny_gemm_splitk<8>(C, WSP(const bf16, WS_H1) + (size_t)MP * 1024, 1024, WSP(const bf16, WS_WUP), 1024, 8, UPC / 128, 1024, Es); }
        pg8::Gemm g{WSP(const pg8::bf16_t, WS_H1), WSP(const pg8::bf16_t, WS_WUP), MP, UPC, 1024}; pg8::StaticOrder S; S.init(MP, UPC, C.G, C.bid);
        pg8::EpiConvGelu E{WSP(pg8::bf16_t, WS_ACT), WSP(float, WS_RAW), P.in[34], P.in[35], WSP(const float, WS_ROWSS), WSP(const float, WS_SB)};
        pg8::gemm_phase<pg8::EpiConvGelu, pg8::StaticOrder, true, true>(C.lds + RING_OFF, g, S, E, C.tid);
    } SEAM(13);
    if (IN(14)) for (int rep_ = 0; rep_ < NREP(14); ++rep_) { PHASE_CTX(); phase_ffn_fixup(C, P); }
    if (((REPEAT_MASK >> 20) & 1) && IN(14)) { PHASE_CTX(); pg8::Gemm g{WSP(const pg8::bf16_t, WS_H1), WSP(const pg8::bf16_t, WS_WUP), MP, UPC, 1024}; pg8::StaticOrder S; S.init(MP, UPC, C.G, C.bid);
        pg8::EpiNull<true> En; pg8::gemm_phase<pg8::EpiNull<true>, pg8::StaticOrder, true, true>(C.lds + RING_OFF, g, S, En, C.tid); }
    SEAM(14);
    if (IN(15)) for (int rep_ = 0; rep_ < NREP(15); ++rep_) { PHASE_CTX();
        { EpiSkResGate<true, false, false> Es{WSP(const bf16, WS_X1) + (size_t)MP * 1024, P.out + (size_t)MP * 1024, WSP(const float, WS_MOD), 5120, nullptr, nullptr, nullptr}; skinny_gemm_splitk<2>(C, WSP(const bf16, WS_ACT) + (size_t)MP * DFF, DFF, WSP(const bf16, WS_WDN), DFF, 8, 1024 / 32, DFF, Es);
          if ((REPEAT_MASK >> 26) & 1) skinny_gemm_splitk<2>(C, WSP(const bf16, WS_ACT) + (size_t)MP * DFF, DFF, WSP(const bf16, WS_WDN), DFF, 8, 1024 / 32, DFF, Es); }
        pg8::Gemm g{WSP(const pg8::bf16_t, WS_ACT), WSP(const pg8::bf16_t, WS_WDN), MP, 1024, DFF}; pg8::StaticOrder S; S.init(MP, 1024, C.G, C.bid);
        pg8::EpiResGate<true, false, false> E{WSP(const bf16, WS_X1), P.out, WSP(const float, WS_MOD), 5120, nullptr, nullptr, nullptr};
        pg8::gemm_phase<pg8::EpiResGate<true, false, false>, pg8::StaticOrder, true, true>(C.lds + RING_OFF, g, S, E, C.tid);
        if ((REPEAT_MASK >> 22) & 1) { pg8::EpiProbe<0> En{(float*)(P.ws + WS_UP + 64 * MiB), nullptr}; pg8::gemm_phase<pg8::EpiProbe<0>, pg8::StaticOrder, true, true>(C.lds + RING_OFF, g, S, En, C.tid); }
        if ((REPEAT_MASK >> 23) & 1) { pg8::EpiProbe<1> En{nullptr, WSP(const pg8::bf16_t, WS_X1)}; pg8::gemm_phase<pg8::EpiProbe<1>, pg8::StaticOrder, true, true>(C.lds + RING_OFF, g, S, En, C.tid); }
        if ((REPEAT_MASK >> 24) & 1) { pg8::EpiProbe<2> En{(float*)(P.ws + WS_UP + 64 * MiB), nullptr}; pg8::gemm_phase<pg8::EpiProbe<2>, pg8::StaticOrder, true, true>(C.lds + RING_OFF, g, S, En, C.tid); }
        if ((REPEAT_MASK >> 25) & 1) { pg8::EpiResGate<true, false, false> En{WSP(const bf16, WS_X1), (float*)(P.ws + WS_UP + 64 * MiB), WSP(const float, WS_MOD), 5120, nullptr, nullptr, nullptr}; pg8::gemm_phase<pg8::EpiResGate<true, false, false>, pg8::StaticOrder, true, true>(C.lds + RING_OFF, g, S, En, C.tid); }
        if ((REPEAT_MASK >> 19) & 1) { pg8::EpiNull<false> En; pg8::gemm_phase<pg8::EpiNull<false>, pg8::StaticOrder, true, true>(C.lds + RING_OFF, g, S, En, C.tid); }
    }
#undef IN
#undef SEAM
}

typedef void (*KernFn)(Params);
template <int... I> struct Seq {};
static KernFn phase_kernel(int k) {
    if constexpr (N_LAUNCHES == 1) { return mk_fwd<0xffff>; }
    else {
        switch (k) {
#define PK(i) case i: return mk_fwd<(1 << i)>;
            PK(0) PK(1) PK(2) PK(3) PK(4) PK(5) PK(6) PK(7) PK(8) PK(9) PK(10) PK(11) PK(12) PK(13) PK(14) PK(15)
#undef PK
            default: return nullptr;
        }
    }
}
extern "C" void kernel_launch(void* const* d_in, const int* in_sizes, int n_in, void* d_out, int out_size, void* d_ws, size_t ws_size, hipStream_t stream) {
    static int grid = 0;
    static KernFn fns[N_PHASES];
    if (grid == 0) {
        if (n_in != 37 || out_size != (int)O_END || ws_size < WS_END + 4 * MiB) { fprintf(stderr, "kernel_launch: unexpected shapes: n_in %d out %d ws %zu\n", n_in, out_size, ws_size); grid = -1; return; }
        int dev = 0, cus = 0, per_cu = 0;
        if (hipGetDevice(&dev) != hipSuccess || hipDeviceGetAttribute(&cus, hipDeviceAttributeMultiprocessorCount, dev) != hipSuccess) { grid = -1; return; }
        for (int li = 0; li < N_LAUNCHES; ++li) {
            fns[li] = (N_LAUNCHES == 1) ? phase_kernel(99) : phase_kernel(li);
            if (hipFuncSetAttribute((const void*)fns[li], hipFuncAttributeMaxDynamicSharedMemorySize, LDS_BYTES) != hipSuccess) { fprintf(stderr, "kernel_launch: hipFuncSetAttribute failed\n"); grid = -1; return; }
            if (hipOccupancyMaxActiveBlocksPerMultiprocessor(&per_cu, (const void*)fns[li], NWAVES * 64, LDS_BYTES) != hipSuccess || per_cu < 1) { fprintf(stderr, "kernel_launch: occupancy query says %d for launch %d\n", per_cu, li); }
        }
        (void)hipGetLastError();
        grid = cus;
    }
    if (grid < 0) return;
    if (hipMemsetAsync((char*)d_ws + WS_CTL, 0, CTL_ZERO_BYTES, stream) != hipSuccess) return;
    Params p{};
    for (int i = 0; i < 37; ++i) p.in[i] = (const float*)d_in[i];
    p.out = (float*)d_out; p.ws = (unsigned char*)d_ws;
    for (int li = 0; li < N_LAUNCHES; ++li) {
        if (N_LAUNCHES == 1) { p.ph_lo = 0; p.ph_hi = N_PHASES; } else { p.ph_lo = li; p.ph_hi = li + 1; }
        hipLaunchKernelGGL(fns[li], dim3(grid), dim3(NWAVES * 64), LDS_BYTES, stream, p);
        const hipError_t le = hipPeekAtLastError();
        if (le != hipSuccess) { fprintf(stderr, "kernel_launch: launch %d failed: %s\n", li, hipGetErrorName(le)); break; }
    }
}
```

```cpp
#include <hip/hip_runtime.h>
#include <cstdio>
#include <cstdint>
#include <cmath>

#ifndef MK_N_LAUNCHES
#define MK_N_LAUNCHES 1
#endif

constexpr int MP = 32768;
constexpr int MS = 128;
constexpr int MREAL = MP + MS;
constexpr int MR = 33024;
constexpr int DM = 1024, SEQ = 2048, NBATCH = 16;
constexpr int ZC = 1536;
constexpr int LRU_W = 512, NHEAD = 8;
constexpr int QLR = 256, KVLR = 128, ROPE_D = 32, NOPE_D = 64, QKD = 96, VD = 64;
constexpr int DFF = 2816, UPC = 5632;
constexpr int NPAGES = 128, PAGE = 128;
constexpr int MODC = 6144;
constexpr float EPS = 1e-6f;
constexpr float C2 = 0.10206207261596575f * 1.4426950408889634f;

constexpr size_t O_YP = 0, O_YS = 33554432, O_KVP = 33685504, O_KRP = 37879808, O_LHP = 38928384, O_LCP = 38936576, O_FCP = 38961152,
                 O_KVS = 39141376, O_KRS = 39157760, O_LHS = 39161856, O_LCS = 39227392, O_FCS = 39424000, O_END = 40865792;

constexpr size_t MiB = 1u << 20;
constexpr size_t WS_CTL = 0, CTL_ZERO_BYTES = 1 * MiB;
constexpr size_t WS_WIN = 1 * MiB;
constexpr size_t WS_WUQ = 4 * MiB;
constexpr size_t WS_WUKV = 5 * MiB;
constexpr size_t WS_WO = 6 * MiB;
constexpr size_t WS_WUP = 8 * MiB;
constexpr size_t WS_WDN = 20 * MiB;
constexpr size_t WS_WADA = 26 * MiB;
constexpr size_t WS_WG = 38 * MiB;
constexpr size_t WS_SC = 39 * MiB;
constexpr size_t WS_MOD = 40 * MiB;
constexpr size_t WS_ROPE = 44 * MiB;
constexpr size_t WS_SUM = 45 * MiB;
constexpr size_t WS_CARRY = 47 * MiB;
constexpr size_t WS_PART = 48 * MiB;
constexpr size_t WS_H1 = 64 * MiB;
constexpr size_t WS_Z = 130 * MiB;
constexpr size_t WS_QN = 228 * MiB;
constexpr size_t WS_KVN = 246 * MiB;
constexpr size_t WS_KR = 264 * MiB;
constexpr size_t WS_HL = 268 * MiB;
constexpr size_t WS_AC = 302 * MiB;
constexpr size_t WS_QRAW = 336 * MiB;
constexpr size_t WS_KVRAW = 386 * MiB;
constexpr size_t WS_Q = 452 * MiB;
constexpr size_t WS_KF = 502 * MiB;
constexpr size_t WS_V = 552 * MiB;
constexpr size_t WS_ATT = 586 * MiB;
constexpr size_t WS_MIX = 620 * MiB;
constexpr size_t WS_UP = 686 * MiB;
constexpr size_t WS_ACT = 1042 * MiB;
constexpr size_t WS_RAW = 1221 * MiB;
constexpr size_t WS_X1 = 1246 * MiB;
constexpr size_t WS_SH2 = 1312 * MiB;
constexpr size_t WS_SB = 1313 * MiB;
constexpr size_t WS_ROWSS = WS_CTL + 256 * 1024;
constexpr size_t WS_END = 1318 * MiB;
constexpr int CW_TMO = 0, CW_BAR = 4096;

constexpr int RING_OFF = 0, RING_BYTES = 143360;
constexpr int LDSCTL_OFF = RING_BYTES, MISC_OFF = LDSCTL_OFF + 320;
constexpr int LDS_BYTES = 147456;
constexpr int NWAVES = 8;

namespace pg8 {
#define PG8_LAS __attribute__((address_space(3)))
typedef unsigned short bf16_t;
typedef short bf16x8 __attribute__((ext_vector_type(8)));
typedef float f32x4 __attribute__((ext_vector_type(4)));
typedef unsigned u32x4 __attribute__((ext_vector_type(4)));
constexpr int BM = 256, BK = 64, HALF = 128, HTB = HALF * BK * 2  , STAGE_BYTES = 8 * HTB, NXCD = 8, WGM = 8;

__host__ __device__ __forceinline__ int lds_byte(int r, int c) { const int st = (r >> 4) * 2 + (c >> 5), rr = r & 15, cc = c & 31, ob = rr * 64 + cc * 2; return st * 1024 + (ob ^ (((ob >> 9) & 1) << 5)); }
__host__ __device__ __forceinline__ void stage_rc(int b, int& R, int& C) { const int st = b / 1024, sb = b % 1024, swz = sb ^ (((sb >> 9) & 1) << 5); R = (st >> 1) * 16 + swz / 64; C = (st & 1) * 32 + (swz % 64) / 2; }
__host__ __device__ __forceinline__ int perm32(int rho) { const int n = rho >> 4, i = rho & 15; return 8 * (i >> 2) + 4 * n + (i & 3); }

struct Unit { int pm, pn; };
struct Gemm { const bf16_t* A; const bf16_t* Bt; int M, N, K; };

struct StaticOrder {
    int nM, nN, nwg, G, c;
    __host__ __device__ void init(int M, int N, int G_, int c_) { nM = M / BM; nN = N / BM; nwg = nM * nN; G = G_; c = c_; }
    __host__ __device__ bool next(int i, Unit& u) const {
        const long L = (long)i * G + c; if (L >= nwg) return false;
        int wgid = (int)L; { const int q = nwg / NXCD, r = nwg % NXCD, xcd = wgid % NXCD, off = wgid / NXCD; wgid = (xcd < r ? xcd * (q + 1) : r * (q + 1) + (xcd - r) * q) + off; }
        const int nig = WGM * nN, gid = wgid / nig, fm = gid * WGM, gsz = (nM - fm) < WGM ? (nM - fm) : WGM;
        u.pm = fm + ((wgid % nig) % gsz); u.pn = (wgid % nig) / gsz; return true;
    }
    __device__ __forceinline__ void a_ready(const Unit&) const {}
    __device__ __forceinline__ void done(const Unit&) const {}
};

__device__ __forceinline__ unsigned cvt_pk_bf16(float lo, float hi) { unsigned r; asm volatile("v_cvt_pk_bf16_f32 %0, %1, %2" : "=v"(r) : "v"(lo), "v"(hi)); return r; }
typedef float f32x2 __attribute__((ext_vector_type(2)));
__device__ __forceinline__ f32x2 gelu_pk(f32x2 v) {
    const f32x2 av = __builtin_elementwise_abs(v), d = av * 0.2316418882f + 1.0f;
    f32x2 t; t.x = __builtin_amdgcn_rcpf(d.x); t.y = __builtin_amdgcn_rcpf(d.y);
    f32x2 q = t * 0.5307027145f + (-0.7265760135f); q = q * t + 0.7107068705f; q = q * t + (-0.142248368f); q = q * t + 0.127414796f; q = q * t;
    const f32x2 s = (v * v) * (-0.72134752044f);
    f32x2 e; e.x = __builtin_amdgcn_exp2f(s.x); e.y = __builtin_amdgcn_exp2f(s.y);
    const f32x2 m = v * (q * e), r = v - m;
    f32x2 o; o.x = v.x < 0.f ? m.x : r.x; o.y = v.y < 0.f ? m.y : r.y; return o;
}

template <int ACT  > struct EpiBf16 {
    static constexpr bool PERM = true, AFTER_DRAIN = false, PERMA = false; static_assert(ACT == 0 || ACT == 1, "EpiBf16: ACT is 0 (none) or 1 (gelu_pk)");
    bf16_t* O; int ldc; const float* bias; int split_cols; size_t split_stride; float scale0;
    __device__ __forceinline__ void operator()(const f32x4 (&acc)[2][2][4][2], const Unit& u, int wr, int wc, int fr, int fq) const {
        const int row0 = u.pm * BM + wr * 64 + fr; int colt = u.pn * BM; bf16_t* base = O;
        float sc = 1.f; if (split_cols) { const int t = colt / split_cols; base += (size_t)t * split_stride; colt -= t * split_cols; if (t == 0) sc = scale0; }
        const int col0 = colt + wc * 32 + 8 * fq, bcol0 = u.pn * BM + wc * 32 + 8 * fq;
        f32x4 bv[2][2];
#pragma unroll
        for (int bj = 0; bj < 2; ++bj)
#pragma unroll
            for (int n = 0; n < 2; ++n) bv[bj][n] = bias ? *(const f32x4*)(bias + bcol0 + bj * HALF + 4 * n) : (f32x4){0.f, 0.f, 0.f, 0.f};
#pragma unroll
        for (int ai = 0; ai < 2; ++ai)
#pragma unroll
            for (int m = 0; m < 4; ++m) { bf16_t* rowp = base + (size_t)(row0 + ai * HALF + m * 16) * ldc + col0;
#pragma unroll
                for (int bj = 0; bj < 2; ++bj) { f32x4 v0 = acc[ai][bj][m][0] + bv[bj][0], v1 = acc[ai][bj][m][1] + bv[bj][1];
                    if (ACT == 1) { f32x2 a = gelu_pk((f32x2){v0[0], v0[1]}), b = gelu_pk((f32x2){v0[2], v0[3]}), c = gelu_pk((f32x2){v1[0], v1[1]}), d = gelu_pk((f32x2){v1[2], v1[3]});
                        v0 = (f32x4){a.x, a.y, b.x, b.y}; v1 = (f32x4){c.x, c.y, d.x, d.y}; }
                    v0 = v0 * sc; v1 = v1 * sc; u32x4 w; w.x = cvt_pk_bf16(v0[0], v0[1]); w.y = cvt_pk_bf16(v0[2], v0[3]); w.z = cvt_pk_bf16(v1[0], v1[1]); w.w = cvt_pk_bf16(v1[2], v1[3]);
                    *(u32x4*)(rowp + bj * HALF) = w; } }
    }
};

template <bool BASE_BF16, bool OUT_BF16, bool XG> struct EpiResGate {
    static constexpr bool PERM = OUT_BF16, AFTER_DRAIN = false, PERMA = false;
    static constexpr int CN = PERM ? 4 : 16, CQ = PERM ? 8 : 4;
    const void* base; void* out; const float* mod; int goff; bf16_t* xg; const float* g2; float* rowss;
    typedef unsigned u32x2e __attribute__((ext_vector_type(2)));
    static constexpr int GM = BASE_BF16 ? 4 : 2, NG = 8 / GM;
    template <class BT> __device__ __forceinline__ void load_group(BT (&b)[GM * 4], int g, const Unit& u, int wr, int fr, int col0) const {
#pragma unroll
        for (int q = 0; q < GM; ++q) { const int am = g * GM + q; const size_t row = (size_t)(u.pm * BM + (am >> 2) * HALF + wr * 64 + (am & 3) * 16 + fr);
#pragma unroll
            for (int bj = 0; bj < 2; ++bj)
#pragma unroll
                for (int n = 0; n < 2; ++n) b[q * 4 + bj * 2 + n] = *(const BT*)((const typename std::conditional<BASE_BF16, bf16_t, float>::type*)base + row * 1024 + col0 + bj * HALF + n * CN); }
    }
    __device__ __forceinline__ void operator()(const f32x4 (&acc)[2][2][4][2], const Unit& u, int wr, int wc, int fr, int fq) const {
        typedef typename std::conditional<BASE_BF16, u32x2e, f32x4>::type BT;
        const int col0 = u.pn * BM + wc * 32 + CQ * fq;
        const float* mrow = mod + (size_t)((u.pm * BM) >> 11) * 6144;
        BT ring[2][GM * 4];
        load_group(ring[0], 0, u, wr, fr, col0);
        f32x4 gt[2][2], G2[2][2];
#pragma unroll
        for (int bj = 0; bj < 2; ++bj)
#pragma unroll
            for (int n = 0; n < 2; ++n) { const int c = col0 + bj * HALF + n * CN; gt[bj][n] = *(const f32x4*)(mrow + goff + c);
                if (XG) G2[bj][n] = *(const f32x4*)(g2 + c) * (*(const f32x4*)(mrow + 4096 + c) + 1.0f); }
#pragma unroll
        for (int g = 0; g < NG; ++g) {
            if (g + 1 < NG) load_group(ring[(g + 1) & 1], g + 1, u, wr, fr, col0);
            asm volatile("" ::: "memory");
#pragma unroll
            for (int q = 0; q < GM; ++q) { const int am = g * GM + q, ai = am >> 2, m = am & 3;
                const size_t row = (size_t)(u.pm * BM + ai * HALF + wr * 64 + m * 16 + fr);
                float ss = 0.f;
#pragma unroll
                for (int bj = 0; bj < 2; ++bj) { u32x2e wo[2], wx[2];
#pragma unroll
                    for (int n = 0; n < 2; ++n) { const int c = col0 + bj * HALF + n * CN;
                        f32x4 bs;
                        if constexpr (BASE_BF16) { const u32x2e w = ring[g & 1][q * 4 + bj * 2 + n]; bs = (f32x4){__uint_as_float(w.x << 16), __uint_as_float(w.x & 0xffff0000u), __uint_as_float(w.y << 16), __uint_as_float(w.y & 0xffff0000u)}; }
                        else bs = ring[g & 1][q * 4 + bj * 2 + n];
                        const f32x4 o = bs + gt[bj][n] * acc[ai][bj][m][n];
                        if (OUT_BF16) { wo[n].x = cvt_pk_bf16(o[0], o[1]); wo[n].y = cvt_pk_bf16(o[2], o[3]); if (!PERM) *(u32x2e*)((bf16_t*)out + row * 1024 + c) = wo[n]; }
                        else *(f32x4*)((float*)out + row * 1024 + c) = o;
                        if (XG) { const f32x4 x = o * G2[bj][n]; wx[n].x = cvt_pk_bf16(x[0], x[1]); wx[n].y = cvt_pk_bf16(x[2], x[3]); if (!PERM) *(u32x2e*)(xg + row * 1024 + c) = wx[n];
                            ss += (o[0] * o[0] + o[1] * o[1]) + (o[2] * o[2] + o[3] * o[3]); } }
                    if (PERM) { const int c8 = col0 + bj * HALF;
                        if (OUT_BF16) *(u32x4*)((bf16_t*)out + row * 1024 + c8) = (u32x4){wo[0].x, wo[0].y, wo[1].x, wo[1].y};
                        if (XG) *(u32x4*)(xg + row * 1024 + c8) = (u32x4){wx[0].x, wx[0].y, wx[1].x, wx[1].y}; } }
                if (XG) {
                    { auto rr = __builtin_amdgcn_permlane16_swap(__float_as_uint(ss), __float_as_uint(ss), false, false); ss = __uint_as_float(rr[0]) + __uint_as_float(rr[1]); }
                    { auto rr = __builtin_amdgcn_permlane32_swap(__float_as_uint(ss), __float_as_uint(ss), false, false); ss = __uint_as_float(rr[0]) + __uint_as_float(rr[1]); }
                    if (fq == 0) __hip_atomic_fetch_add(rowss + row, ss, __ATOMIC_RELAXED, __HIP_MEMORY_SCOPE_AGENT); }
            }
        }
    }
};


__device__ __forceinline__ float dpp_shr1(float v) { return __builtin_bit_cast(float, __builtin_amdgcn_update_dpp(0, __builtin_bit_cast(int, v), 0x111, 0xf, 0xf, false)); }
__device__ __forceinline__ float gelu_tanh_e(float x) { const float u = 0.7978845608028654f * (x + 0.044715f * x * x * x); return x * __builtin_amdgcn_rcpf(1.0f + __builtin_amdgcn_exp2f(-2.8853900817779268f * u)); }
#ifndef CW1_AT
#define CW1_AT 7
#endif
struct EpiConvGelu {
    static constexpr bool PERM = true, AFTER_DRAIN = false, PERMA = true;
    bf16_t* ACT; float* RAW; const float* fw; const float* fb; const float* rowss; const float* SB;
    __device__ __forceinline__ void operator()(const f32x4 (&acc_)[2][2][4][2], const Unit& u, int wr, int wc, int fr_, int fq_) const {
        f32x4 (&acc)[2][2][4][2] = const_cast<f32x4 (&)[2][2][4][2]>(acc_);
        int ln_; asm volatile("v_mbcnt_lo_u32_b32 %0, -1, 0\n\tv_mbcnt_hi_u32_b32 %0, -1, %0" : "=v"(ln_)); const int fr = ln_ & 15, fq = ln_ >> 4; (void)fr_; (void)fq_;
        const int tb = u.pm * BM + wr * 128 + fr * 8;
        { const f32x4 s0 = *(const f32x4*)(rowss + tb), s1 = *(const f32x4*)(rowss + tb + 4);
          float rs[8]; rs[0] = s0[0]; rs[1] = s0[1]; rs[2] = s0[2]; rs[3] = s0[3]; rs[4] = s1[0]; rs[5] = s1[1]; rs[6] = s1[2]; rs[7] = s1[3];
#pragma unroll
          for (int j = 0; j < 8; ++j) rs[j] = __builtin_amdgcn_rsqf(rs[j] * (1.f / 1024.f) + 1e-6f);
          const float* sbp = SB + (size_t)((u.pm * BM) >> 11) * 5632 + u.pn * BM + wc * 32 + fq * 8;
#pragma unroll
          for (int bj = 0; bj < 2; ++bj)
#pragma unroll
              for (int n = 0; n < 2; ++n) { const f32x4 sb = *(const f32x4*)(sbp + bj * HALF + 4 * n);
#pragma unroll
                  for (int j = 0; j < 8; ++j) acc[j >> 2][bj][j & 3][n] = acc[j >> 2][bj][j & 3][n] * rs[j] + sb; } }
        const int cb = u.pn * 128 + wc * 32 + fq * 8;
        const int blk = u.pm * 2 + wr;
        f32x4 cw[2][8]; unsigned hold[8][2];
#define CW_LOAD(n) do { const int c0_ = cb + 4 * (n); \
            cw[n][0] = *(const f32x4*)(fw + c0_); cw[n][1] = *(const f32x4*)(fw + 5632 + c0_); cw[n][2] = *(const f32x4*)(fw + 11264 + c0_); cw[n][3] = *(const f32x4*)(fb + c0_); \
            cw[n][4] = *(const f32x4*)(fw + 2816 + c0_); cw[n][5] = *(const f32x4*)(fw + 5632 + 2816 + c0_); cw[n][6] = *(const f32x4*)(fw + 11264 + 2816 + c0_); cw[n][7] = *(const f32x4*)(fb + 2816 + c0_); } while (0)
#pragma unroll
        for (int n = 0; n < 2; ++n) {
            const int c0 = cb + 4 * n;
            if (n == 0) CW_LOAD(0);
            const f32x4 wv0 = cw[n][0], wv1 = cw[n][1], wv2 = cw[n][2], bv = cw[n][3], wg0 = cw[n][4], wg1 = cw[n][5], wg2 = cw[n][6], bg = cw[n][7];
            f32x4 pv1, pv2, pg1, pg2;
#pragma unroll
            for (int e = 0; e < 4; ++e) { pv1[e] = dpp_shr1(acc[1][0][3][n][e]); pv2[e] = dpp_shr1(acc[1][0][2][n][e]); pg1[e] = dpp_shr1(acc[1][1][3][n][e]); pg2[e] = dpp_shr1(acc[1][1][2][n][e]); }
#pragma unroll
            for (int j = 0; j < 8; ++j) { const int ai = j >> 2, m = j & 3;
                if (n == 0 && j == 1) {
                    if (fr == 15) { float* r = RAW + (size_t)blk * 4 * 5632;
#pragma unroll
                        for (int n2 = 0; n2 < 2; ++n2) { const int c2 = cb + 4 * n2;
                            *(f32x4*)(r + c2) = acc[1][0][2][n2]; *(f32x4*)(r + 2816 + c2) = acc[1][1][2][n2]; *(f32x4*)(r + 5632 + c2) = acc[1][0][3][n2]; *(f32x4*)(r + 5632 + 2816 + c2) = acc[1][1][3][n2]; } }
                    if (fr == 0) { float* r = RAW + ((size_t)blk * 4 + 2) * 5632;
#pragma unroll
                        for (int n2 = 0; n2 < 2; ++n2) { const int c2 = cb + 4 * n2;
                            *(f32x4*)(r + c2) = acc[0][0][0][n2]; *(f32x4*)(r + 2816 + c2) = acc[0][1][0][n2]; *(f32x4*)(r + 5632 + c2) = acc[0][0][1][n2]; *(f32x4*)(r + 5632 + 2816 + c2) = acc[0][1][1][n2]; } } }
                if (n == 0 && j == CW1_AT) CW_LOAD(1);
                const f32x4 v = acc[ai][0][m][n], g = acc[ai][1][m][n];
                const f32x4 val = bv + wv0 * pv2 + wv1 * pv1 + wv2 * v, gt = bg + wg0 * pg2 + wg1 * pg1 + wg2 * g;
                u32x4 dummy; (void)dummy;
                const unsigned p0 = cvt_pk_bf16(gelu_tanh_e(gt[0]) * val[0], gelu_tanh_e(gt[1]) * val[1]), p1 = cvt_pk_bf16(gelu_tanh_e(gt[2]) * val[2], gelu_tanh_e(gt[3]) * val[3]);
                if (n == 0) { hold[j][0] = p0; hold[j][1] = p1; }
                else *(u32x4*)(ACT + (size_t)(tb + j) * 2816 + cb) = (u32x4){hold[j][0], hold[j][1], p0, p1};
                pv2 = pv1; pv1 = v; pg2 = pg1; pg1 = g; }
        }
#undef CW_LOAD
    }
};

template <bool PA> struct EpiNull {
    static constexpr bool PERM = false, AFTER_DRAIN = false, PERMA = PA;
    __device__ __forceinline__ void operator()(const f32x4 (&acc)[2][2][4][2], const Unit& u, int wr, int wc, int fr, int fq) const {
#pragma unroll
        for (int i = 0; i < 32; ++i) asm volatile("" :: "v"(acc[i >> 4][(i >> 3) & 1][(i >> 1) & 3][i & 1]));
    }
};

template <int MODE> struct EpiProbe {
    static constexpr bool PERM = false, AFTER_DRAIN = false, PERMA = false;
    float* out; const bf16_t* base;
    __device__ __forceinline__ void operator()(const f32x4 (&acc)[2][2][4][2], const Unit& u, int wr, int wc, int fr, int fq) const {
        typedef unsigned u32x2e __attribute__((ext_vector_type(2)));
        const int col0 = u.pn * BM + wc * 32 + 4 * fq;
#pragma unroll
        for (int am = 0; am < 8; ++am) { const int ai = am >> 2, m = am & 3; const size_t row = (size_t)(u.pm * BM + ai * HALF + wr * 64 + m * 16 + fr);
#pragma unroll
            for (int bj = 0; bj < 2; ++bj)
#pragma unroll
                for (int n = 0; n < 2; ++n) { const int c = col0 + bj * HALF + n * 16;
                    if (MODE == 0) *(f32x4*)(out + row * 1024 + c) = acc[ai][bj][m][n];
                    else if (MODE == 1) { const u32x2e w = *(const u32x2e*)(base + row * 1024 + c); asm volatile("" :: "v"(w), "v"(acc[ai][bj][m][n])); }
                    else { u32x2e w; w.x = cvt_pk_bf16(acc[ai][bj][m][n][0], acc[ai][bj][m][n][1]); w.y = cvt_pk_bf16(acc[ai][bj][m][n][2], acc[ai][bj][m][n][3]); *(u32x2e*)((bf16_t*)out + row * 1024 + c) = w; } } }
    }
};
template <class Epi, class Sched, bool ALIGN_EPI = false, bool SP2 = false>
__device__ __forceinline__ void gemm_phase(PG8_LAS unsigned char* lds, const Gemm g, const Sched& S, const Epi& E, const int tid) {
    const int wid = __builtin_amdgcn_readfirstlane(tid >> 6), lane = tid & 63, wr = wid >> 2, wc = wid & 3, fr = lane & 15, fq = lane >> 4;
    const int K = g.K, nt = K / BK;
    unsigned voffA[2], voffB[2];
#pragma unroll
    for (int i = 0; i < 2; ++i) { int R, C; stage_rc(tid * 16 + i * 8192, R, C); const int Rb = Epi::PERM ? ((R & ~31) + perm32(R & 31)) : R;
        const int Ra = Epi::PERMA ? (128 * (R >> 6) + 8 * (R & 15) + ((R >> 4) & 3)) : R;
        voffA[i] = (unsigned)(Ra * K + C) * 2u; voffB[i] = (unsigned)(Rb * K + C) * 2u; }
    const size_t kstep = (size_t)(BK * 2);
    const size_t hstep = (size_t)HALF * K * 2;
    const size_t hstepA = Epi::PERMA ? (size_t)4 * K * 2 : hstep;
    const size_t tstep = 2 * hstep;
    const unsigned ldsw = (unsigned)wid * 1024u;
    const int aoff = lds_byte(wr * 64 + fr, fq * 8), boff = lds_byte(wc * 32 + fr, fq * 8);
#define PG8_SA(b, h) (((b) * 2 + (h)) * HTB)
#define PG8_SB(b, h) ((4 + (b) * 2 + (h)) * HTB)
#define PG8_STAGE(bufoff, gbase, voff) do { _Pragma("unroll") for (int _i = 0; _i < 2; ++_i) \
        __builtin_amdgcn_global_load_lds((const unsigned*)((const char*)(gbase) + (voff)[_i]), (PG8_LAS unsigned*)(lds + (bufoff) + ldsw + _i * 8192), 16, 0, 0); } while (0)
#define PG8_LDA(dst, b, h) do { _Pragma("unroll") for (int m = 0; m < 4; ++m) _Pragma("unroll") for (int k = 0; k < 2; ++k) dst[m][k] = *(const PG8_LAS bf16x8*)(lds + PG8_SA(b, h) + aoff + m * 2048 + k * 1024); } while (0)
#define PG8_LDB(dst, b, h) do { _Pragma("unroll") for (int n = 0; n < 2; ++n) _Pragma("unroll") for (int k = 0; k < 2; ++k) dst[n][k] = *(const PG8_LAS bf16x8*)(lds + PG8_SB(b, h) + boff + n * 2048 + k * 1024); } while (0)
#define PG8_MMA(ai, bj, At, Bt) do { __builtin_amdgcn_s_setprio(1); _Pragma("unroll") for (int m = 0; m < 4; ++m) _Pragma("unroll") for (int n = 0; n < 2; ++n) _Pragma("unroll") for (int k = 0; k < 2; ++k) \
        acc[ai][bj][m][n] = __builtin_amdgcn_mfma_f32_16x16x32_bf16(Bt[n][k], At[m][k], acc[ai][bj][m][n], 0, 0, 0); __builtin_amdgcn_s_setprio(0); } while (0)
#define PG8_WAIT_V(n) asm volatile("s_waitcnt vmcnt(" #n ")" ::: "memory")
#define PG8_WAIT_L(n) asm volatile("s_waitcnt lgkmcnt(" #n ")" ::: "memory")
#define PG8_BAR __builtin_amdgcn_s_barrier()
#define PG8_SCHED __builtin_amdgcn_sched_barrier(0)
    Unit cur, nxt; int ui = 0;
    if (!S.next(0, cur)) return;
    f32x4 acc[2][2][4][2];
#pragma unroll
    for (int a = 0; a < 2; ++a)
#pragma unroll
        for (int b = 0; b < 2; ++b)
#pragma unroll
            for (int m = 0; m < 4; ++m)
#pragma unroll
                for (int n = 0; n < 2; ++n) acc[a][b][m][n] = (f32x4){0.f, 0.f, 0.f, 0.f};
    bf16x8 At[4][2], B0[2][2], B1[2][2];
    const char* cA = (const char*)g.A + (size_t)cur.pm * tstep; const char* cB = (const char*)g.Bt + (size_t)cur.pn * tstep;
    S.a_ready(cur);
    if constexpr (SP2) {
        PG8_STAGE(PG8_SB(0, 0), cB, voffB); PG8_STAGE(PG8_SB(0, 1), cB + hstep, voffB); PG8_STAGE(PG8_SA(0, 0), cA, voffA); PG8_STAGE(PG8_SA(0, 1), cA + hstepA, voffA);
        if (wr == 1) PG8_BAR;
        PG8_WAIT_V(2); PG8_BAR;
        PG8_STAGE(PG8_SB(1, 0), cB + kstep, voffB); PG8_STAGE(PG8_SA(1, 0), cA + kstep, voffA); PG8_STAGE(PG8_SB(1, 1), cB + hstep + kstep, voffB);
        PG8_WAIT_V(6); PG8_BAR;
    } else {
        PG8_STAGE(PG8_SB(0, 0), cB, voffB); PG8_STAGE(PG8_SA(0, 0), cA, voffA); PG8_STAGE(PG8_SB(0, 1), cB + hstep, voffB); PG8_STAGE(PG8_SA(0, 1), cA + hstepA, voffA);
        if (wr == 1) PG8_BAR;
        PG8_WAIT_V(4); PG8_BAR;
        PG8_STAGE(PG8_SB(1, 0), cB + kstep, voffB); PG8_STAGE(PG8_SA(1, 0), cA + kstep, voffA); PG8_STAGE(PG8_SB(1, 1), cB + hstep + kstep, voffB);
        PG8_WAIT_V(6); PG8_BAR;
    }
    for (;;) {
        const bool has_next = S.next(ui + 1, nxt);
        const char* nA = has_next ? (const char*)g.A + (size_t)nxt.pm * tstep : cA; const char* nB = has_next ? (const char*)g.Bt + (size_t)nxt.pn * tstep : cB;
        for (int t = 0; t < nt; t += 2) {
            const bool last = (t == nt - 2);
            const char* a1 = cA + (size_t)(t + 1) * kstep;
            const char* a2 = last ? nA : cA + (size_t)(t + 2) * kstep; const char* b2 = last ? nB : cB + (size_t)(t + 2) * kstep;
            const char* a3 = a2 + kstep; const char* b3 = b2 + kstep;
            if (last && has_next) S.a_ready(nxt);
            if constexpr (SP2) {
            PG8_LDB(B0, 0, 0); PG8_LDB(B1, 0, 1); PG8_SCHED; PG8_LDA(At, 0, 0); PG8_STAGE(PG8_SA(1, 1), a1 + hstepA, voffA);
            PG8_WAIT_V(8); PG8_WAIT_L(0); PG8_BAR; PG8_MMA(0, 0, At, B0); PG8_MMA(0, 1, At, B1); PG8_BAR; PG8_SCHED;
            PG8_LDA(At, 0, 1); PG8_STAGE(PG8_SB(0, 0), b2, voffB); PG8_STAGE(PG8_SB(0, 1), b2 + hstep, voffB); PG8_STAGE(PG8_SA(0, 0), a2, voffA);
            PG8_WAIT_V(8); PG8_WAIT_L(0); PG8_BAR; PG8_MMA(1, 0, At, B0); PG8_MMA(1, 1, At, B1); PG8_BAR; PG8_SCHED;
            PG8_LDB(B0, 1, 0); PG8_LDB(B1, 1, 1); PG8_SCHED; PG8_LDA(At, 1, 0); PG8_STAGE(PG8_SA(0, 1), a2 + hstepA, voffA);
            PG8_WAIT_V(8); PG8_WAIT_L(0); PG8_BAR; PG8_MMA(0, 0, At, B0); PG8_MMA(0, 1, At, B1); PG8_BAR; PG8_SCHED;
            PG8_LDA(At, 1, 1); PG8_STAGE(PG8_SB(1, 0), b3, voffB); PG8_STAGE(PG8_SB(1, 1), b3 + hstep, voffB); PG8_STAGE(PG8_SA(1, 0), a3, voffA);
            PG8_WAIT_V(8); PG8_WAIT_L(0); PG8_BAR; PG8_MMA(1, 0, At, B0); PG8_MMA(1, 1, At, B1); PG8_BAR; PG8_SCHED;
            } else {
            PG8_LDB(B0, 0, 0); PG8_SCHED; PG8_LDA(At, 0, 0); PG8_STAGE(PG8_SA(1, 1), a1 + hstepA, voffA);
            PG8_WAIT_L(8); PG8_BAR; PG8_WAIT_L(0); PG8_MMA(0, 0, At, B0); PG8_BAR; PG8_SCHED;
            PG8_LDB(B1, 0, 1); PG8_STAGE(PG8_SB(0, 0), b2, voffB);
            PG8_BAR; PG8_WAIT_L(0); PG8_MMA(0, 1, At, B1); PG8_BAR;
            PG8_LDA(At, 0, 1); PG8_STAGE(PG8_SA(0, 0), a2, voffA);
            PG8_BAR; PG8_WAIT_L(0); PG8_MMA(1, 0, At, B0); PG8_BAR; PG8_SCHED;
            PG8_STAGE(PG8_SB(0, 1), b2 + hstep, voffB);
            PG8_WAIT_V(6); PG8_BAR; PG8_MMA(1, 1, At, B1); PG8_BAR;
            PG8_LDB(B0, 1, 0); PG8_SCHED; PG8_LDA(At, 1, 0); PG8_STAGE(PG8_SA(0, 1), a2 + hstepA, voffA);
            PG8_WAIT_L(8); PG8_BAR; PG8_WAIT_L(0); PG8_MMA(0, 0, At, B0); PG8_BAR; PG8_SCHED;
            PG8_LDB(B1, 1, 1); PG8_STAGE(PG8_SB(1, 0), b3, voffB);
            PG8_BAR; PG8_WAIT_L(0); PG8_MMA(0, 1, At, B1); PG8_BAR;
            PG8_LDA(At, 1, 1); PG8_STAGE(PG8_SA(1, 0), a3, voffA);
            PG8_BAR; PG8_WAIT_L(0); PG8_MMA(1, 0, At, B0); PG8_BAR; PG8_SCHED;
            PG8_STAGE(PG8_SB(1, 1), b3 + hstep, voffB);
            PG8_WAIT_V(6); PG8_BAR; PG8_MMA(1, 1, At, B1); PG8_BAR;
            }
        }
        if constexpr (ALIGN_EPI) { if (wr == 0) PG8_BAR; }
        if constexpr (!Epi::AFTER_DRAIN) { E(acc, cur, wr, wc, fr, fq); S.done(cur); }
        if (!has_next) break;
#pragma unroll
        for (int a = 0; a < 2; ++a)
#pragma unroll
            for (int b = 0; b < 2; ++b)
#pragma unroll
                for (int m = 0; m < 4; ++m)
#pragma unroll
                    for (int n = 0; n < 2; ++n) acc[a][b][m][n] = (f32x4){0.f, 0.f, 0.f, 0.f};
        cur = nxt; cA = nA; cB = nB; ++ui;
        if constexpr (ALIGN_EPI) { if (wr == 1) PG8_BAR; }
    }
    PG8_WAIT_V(0);
    if constexpr (!ALIGN_EPI) { if (wr == 0) PG8_BAR; }
    PG8_BAR;
    if constexpr (Epi::AFTER_DRAIN) { E.fused(acc, cur, wr, wc, fr, fq, lds, wid, lane); S.done(cur); }
#undef PG8_SA
#undef PG8_SB
#undef PG8_STAGE
#undef PG8_LDA
#undef PG8_LDB
#undef PG8_MMA
#undef PG8_WAIT_V
#undef PG8_WAIT_L
#undef PG8_BAR
#undef PG8_SCHED
}
}
#define GAS __attribute__((address_space(1)))
#define LAS __attribute__((address_space(3)))
typedef unsigned short bf16;
typedef unsigned v4u __attribute__((ext_vector_type(4)));
typedef float f32x4 __attribute__((ext_vector_type(4)));
typedef short bf16x8 __attribute__((ext_vector_type(8)));
typedef GAS unsigned gu32;
typedef GAS unsigned long long gu64;
#define RLX_AGENT __ATOMIC_RELAXED, __HIP_MEMORY_SCOPE_AGENT
#define LDS_WAIT() asm volatile("s_waitcnt lgkmcnt(0)" ::: "memory")
#define VM_WAIT() asm volatile("s_waitcnt vmcnt(0)" ::: "memory")
__device__ __forceinline__ unsigned long long rt() { return __builtin_amdgcn_s_memrealtime(); }
typedef float f32x2_cv __attribute__((ext_vector_type(2))); typedef __bf16 bf16x2_cv __attribute__((ext_vector_type(2)));
__device__ __forceinline__ unsigned pk2(float lo, float hi) { f32x2_cv v = {lo, hi}; bf16x2_cv b = __builtin_convertvector(v, bf16x2_cv); return __builtin_bit_cast(unsigned, b); }
__device__ __forceinline__ unsigned f2bf(float f) { return pk2(f, f) & 0xffffu; }
#define XB_TMO      128
#define XB_XCNT(j)  (256  + 64 * (j))
#define XB_XSUB(j)  (1280 + 64 * (j))
#define XB_XGEN(j)  (2304 + 64 * (j))
#define XB_TOP      3328
#define XB_TOPGEN   3392
#define XCD_BAR_WORDS 3456
#define XB_SPIN_CAP (1u << 18)

__device__ __forceinline__ unsigned xb_ld(unsigned* p)              { return __hip_atomic_load(p, __ATOMIC_RELAXED, __HIP_MEMORY_SCOPE_AGENT); }
__device__ __forceinline__ unsigned xb_add(unsigned* p, unsigned v) { return __hip_atomic_fetch_add(p, v, __ATOMIC_RELAXED, __HIP_MEMORY_SCOPE_AGENT); }
__device__ __forceinline__ unsigned xb_xcc_id() { return (unsigned)__builtin_amdgcn_s_getreg((3 << 11) | 20) & 0xFu; }
#define XB_SPIN(cond, bar) do { unsigned _sp = 0; while (cond) { __builtin_amdgcn_s_sleep(1); \
    if ((++_sp & 255u) == 0u) { if (xb_ld(&(bar)[XB_TMO])) break; if (_sp > XB_SPIN_CAP) { atomicAdd(&(bar)[XB_TMO], 1u); break; } } } } while (0)

struct XcdBarrier {
    unsigned* bar; unsigned x;
    volatile LAS unsigned* st;
};

__device__ __forceinline__ XcdBarrier xcd_barrier_post(unsigned* bar, volatile LAS unsigned* st, int tid) {
    XcdBarrier b; b.bar = bar; b.x = xb_xcc_id(); b.st = st;
    if (tid == 0) (void)xb_add(&bar[XB_XCNT(b.x)], 1u);
    return b;
}
__device__ __forceinline__ void xcd_barrier_complete(unsigned* bar, unsigned x, unsigned& nloc, unsigned& nx) {
    const unsigned G = gridDim.x * gridDim.y * gridDim.z;
    unsigned sum, cnt, mine, sp = 0u;
    for (;;) {
        sum = 0u; cnt = 0u; mine = 0u;
#pragma unroll
        for (unsigned j = 0; j < 16; ++j) { const unsigned c = xb_ld(&bar[XB_XCNT(j)]); sum += c; cnt += (c > 0u) ? 1u : 0u; mine = (j == x) ? c : mine; }
        if (sum == G) break;
        __builtin_amdgcn_s_sleep(1);
        if ((++sp & 255u) == 0u) { if (xb_ld(&bar[XB_TMO])) break; if (sp > XB_SPIN_CAP) { atomicAdd(&bar[XB_TMO], 1u); break; } }
    }
    nloc = mine > 0u ? mine : 1u; nx = cnt > 0u ? cnt : 1u;
}

__device__ __forceinline__ void xcd_barrier(const XcdBarrier& b, int tid) {
    asm volatile("s_waitcnt vmcnt(0)" ::: "memory");
    __syncthreads();
    if (tid == 0) {
        unsigned* bar = b.bar;
        __builtin_amdgcn_s_waitcnt(0);
        unsigned nloc = b.st[0], nx = b.st[1];
        if (nloc == 0u) { xcd_barrier_complete(bar, b.x, nloc, nx); b.st[0] = nloc; b.st[1] = nx; }
        const unsigned old = xb_add(&bar[XB_XSUB(b.x)], 1u);
        const unsigned gen = old / nloc;
        if (old + 1u == (gen + 1u) * nloc) {
            __builtin_amdgcn_fence(__ATOMIC_RELEASE, "agent");
            asm volatile("s_waitcnt vmcnt(0)" ::: "memory");
            const unsigned og = xb_add(&bar[XB_TOP], 1u);
            const unsigned tg = og / nx;
            if (og + 1u == (tg + 1u) * nx) xb_add(&bar[XB_TOPGEN], 1u);
            else XB_SPIN(xb_ld(&bar[XB_TOPGEN]) == tg, bar);
            __builtin_amdgcn_fence(__ATOMIC_ACQUIRE, "agent");
            xb_add(&bar[XB_XGEN(b.x)], 1u);
            asm volatile("s_waitcnt vmcnt(0)" ::: "memory");
        } else {
            XB_SPIN(xb_ld(&bar[XB_XGEN(b.x)]) == gen, bar);
            __builtin_amdgcn_fence(__ATOMIC_ACQUIRE, "agent");
            asm volatile("s_waitcnt vmcnt(0)" ::: "memory");
        }
    }
    __syncthreads();
}

typedef float f32x16 __attribute__((ext_vector_type(16)));
typedef float f32x2 __attribute__((ext_vector_type(2)));
typedef unsigned v2u __attribute__((ext_vector_type(2)));
typedef short s16x4 __attribute__((ext_vector_type(4)));

struct Params { const float* in[37]; float* out; unsigned char* ws; int ph_lo, ph_hi; };

__device__ __forceinline__ float bf2f(unsigned short b) { return __uint_as_float(((unsigned)b) << 16); }
__device__ __forceinline__ float bflo(unsigned w) { return __uint_as_float(w << 16); }
__device__ __forceinline__ float bfhi(unsigned w) { return __uint_as_float(w & 0xffff0000u); }
#define DPPF0(v, ctrl) __builtin_bit_cast(float, __builtin_amdgcn_update_dpp(__builtin_bit_cast(int, v), __builtin_bit_cast(int, v), ctrl, 0xf, 0xf, false))
__device__ __forceinline__ float row16_sum(float v) { v += DPPF0(v, 0xB1); v += DPPF0(v, 0x4E); v += DPPF0(v, 0x141); v += DPPF0(v, 0x140); return v; }
__device__ __forceinline__ float lane_xor16(float v, int lane) { auto rr = __builtin_amdgcn_permlane16_swap(__float_as_uint(v), __float_as_uint(v), false, false); return __uint_as_float((lane & 16) ? rr[0] : rr[1]); }
__device__ __forceinline__ float lane_xor32(float v, int lane) { auto rr = __builtin_amdgcn_permlane32_swap(__float_as_uint(v), __float_as_uint(v), false, false); return __uint_as_float((lane & 32) ? rr[0] : rr[1]); }
__device__ __forceinline__ float wave_sum(float v) {
    v = row16_sum(v);
    { auto rr = __builtin_amdgcn_permlane16_swap(__float_as_uint(v), __float_as_uint(v), false, false); v = __uint_as_float(rr[0]) + __uint_as_float(rr[1]); }
    { auto rr = __builtin_amdgcn_permlane32_swap(__float_as_uint(v), __float_as_uint(v), false, false); v = __uint_as_float(rr[0]) + __uint_as_float(rr[1]); }
    return v;
}
__device__ __forceinline__ void unpack8f(const v4u& w, float* v) { v[0] = bflo(w.x); v[1] = bfhi(w.x); v[2] = bflo(w.y); v[3] = bfhi(w.y); v[4] = bflo(w.z); v[5] = bfhi(w.z); v[6] = bflo(w.w); v[7] = bfhi(w.w); }
__device__ __forceinline__ float wave_max(float v) {
#pragma unroll
    for (int o = 1; o < 64; o <<= 1) v = fmaxf(v, __shfl_xor(v, o));
    return v;
}
__device__ __forceinline__ float dpp_f(float v, int ctrl_dummy);
#define DPPF(v, ctrl) __builtin_bit_cast(float, __builtin_amdgcn_update_dpp(__builtin_bit_cast(int, v), __builtin_bit_cast(int, v), ctrl, 0xf, 0xf, false))
__device__ __forceinline__ float half_max32(float v) {
    v = fmaxf(v, DPPF(v, 0xB1)); v = fmaxf(v, DPPF(v, 0x4E)); v = fmaxf(v, DPPF(v, 0x141)); v = fmaxf(v, DPPF(v, 0x140));
    auto rr = __builtin_amdgcn_permlane16_swap(__float_as_uint(v), __float_as_uint(v), false, false);
    return fmaxf(__uint_as_float(rr[0]), __uint_as_float(rr[1]));
}
__device__ __forceinline__ float gelu_tanh(float x) {
    const float u = 0.7978845608028654f * (x + 0.044715f * x * x * x);
    return x * __builtin_amdgcn_rcpf(1.0f + __builtin_amdgcn_exp2f(-2.8853900817779268f * u));
}
__device__ __forceinline__ float sigmoidf_(float x) { return __builtin_amdgcn_rcpf(1.0f + __builtin_amdgcn_exp2f(-1.4426950408889634f * x)); }
__device__ __forceinline__ f32x16 mfma32(bf16x8 a, bf16x8 b, f32x16 c) { return __builtin_amdgcn_mfma_f32_32x32x16_bf16(a, b, c, 0, 0, 0); }
__device__ __forceinline__ f32x4 mfma16(bf16x8 a, bf16x8 b, f32x4 c) { return __builtin_amdgcn_mfma_f32_16x16x32_bf16(a, b, c, 0, 0, 0); }
__device__ __forceinline__ int crow(int r, int hi) { return (r & 3) + 8 * (r >> 2) + 4 * hi; }
__device__ __forceinline__ bf16x8 pack8(const float* v) { v4u w; w.x = pk2(v[0], v[1]); w.y = pk2(v[2], v[3]); w.z = pk2(v[4], v[5]); w.w = pk2(v[6], v[7]); return __builtin_bit_cast(bf16x8, w); }
__device__ __forceinline__ float xhalf_sum(float v) { auto rr = __builtin_amdgcn_permlane32_swap(__float_as_uint(v), __float_as_uint(v), false, false); return __uint_as_float(rr[0]) + __uint_as_float(rr[1]); }

__device__ __forceinline__ int fresh_lane() { int l; asm volatile("v_mbcnt_lo_u32_b32 %0, -1, 0\n\tv_mbcnt_hi_u32_b32 %0, -1, %0" : "=v"(l)); return l; }
struct Ctx {
    LAS unsigned char* lds; int tid, lane, wave, G, bid;
    const Params* p;
};
#define WSP(T, off) ((T*)(P.ws + (off)))

template <bool UPPERM = false> __device__ __forceinline__ void p0_transpose_item(const float* W, int N, bf16* WT, int ldk, LAS float* scr, int nblk, int item, int lane) {
    const int kb = item / nblk, nb = item % nblk, k0 = 64 * kb, n0 = 32 * nb;
    const int d0 = UPPERM ? ((n0 < DFF) ? (256 * (n0 >> 7) + (n0 & 127)) : (256 * ((n0 - DFF) >> 7) + 128 + ((n0 - DFF) & 127))) : n0;
#pragma unroll 8
    for (int i = 0; i < 32; ++i) { const int kk = 2 * i + (lane >> 5); scr[kk * 33 + (lane & 31)] = W[(size_t)(k0 + kk) * N + n0 + (lane & 31)]; }
    LDS_WAIT(); asm volatile("" ::: "memory");
    const int c = lane & 7;
#pragma unroll
    for (int j = 0; j < 4; ++j) { const int n = (lane >> 3) + 8 * j; const LAS float* s = scr + (8 * c) * 33 + n;
        v4u o; o.x = pk2(s[0 * 33], s[1 * 33]); o.y = pk2(s[2 * 33], s[3 * 33]); o.z = pk2(s[4 * 33], s[5 * 33]); o.w = pk2(s[6 * 33], s[7 * 33]);
        *(GAS v4u*)(WT + (size_t)(d0 + n) * ldk + k0 + 8 * c) = o; }
    LDS_WAIT(); asm volatile("" ::: "memory");
}
__device__ __forceinline__ void phase_p0a(const Ctx& C, const Params& P) {
    LAS float* scr = (LAS float*)(C.lds + RING_OFF + C.wave * 16384);
    const int gw = C.bid * NWAVES + C.wave, NGW = C.G * NWAVES, lane = C.lane;
    constexpr int I_IN = 16 * 45, I_UQ = 4 * 24, I_UKV = 2 * 32, I_O = 16 * 32, I_UP = 16 * 176, I_DN = 44 * 32, I_ADA = 16 * 192, I_G = 32;
    constexpr int NITEMS = I_IN + I_UQ + I_UKV + I_O + I_UP + I_DN + I_ADA + I_G;
    for (int it = gw; it < NITEMS; it += NGW) {
        int r = it;
        if (r < I_UP) { p0_transpose_item<true>(P.in[33], UPC, WSP(bf16, WS_WUP), 1024, scr, 176, r, lane); continue; } r -= I_UP;
        if (r < I_ADA) { p0_transpose_item(P.in[10], MODC, WSP(bf16, WS_WADA), 1024, scr, 192, r, lane); continue; } r -= I_ADA;
        if (r < I_DN) { p0_transpose_item(P.in[36], DM, WSP(bf16, WS_WDN), DFF, scr, 32, r, lane); continue; } r -= I_DN;
        if (r < I_IN) { p0_transpose_item(P.in[13], 1440, WSP(bf16, WS_WIN), 1024, scr, 45, r, lane); continue; } r -= I_IN;
        if (r < I_O) { p0_transpose_item(P.in[31], DM, WSP(bf16, WS_WO), 1024, scr, 32, r, lane); continue; } r -= I_O;
        if (r < I_UQ) { p0_transpose_item(P.in[22], 768, WSP(bf16, WS_WUQ), 256, scr, 24, r, lane); continue; } r -= I_UQ;
        if (r < I_UKV) { p0_transpose_item(P.in[27], 1024, WSP(bf16, WS_WUKV), 256, scr, 32, r, lane); continue; } r -= I_UKV;
        { const int hg = r >> 1, sub = r & 1, h = hg >> 1, gate = hg & 1;
          p0_transpose_item(P.in[gate ? 18 : 16] + (size_t)h * 4096, 64, WSP(bf16, WS_WG) + (size_t)(h * 2 + gate) * 4096, 64, scr, 2, sub, lane); }
    }
    const int gt = C.bid * 512 + C.tid, NGT = C.G * 512;
    { bf16* w = WSP(bf16, WS_WIN) + (size_t)1440 * 1024; for (int i = gt; i < 96 * 1024 / 8; i += NGT) ((v4u*)w)[i] = (v4u){0u, 0u, 0u, 0u}; }
    { bf16* w = WSP(bf16, WS_WUKV); for (int i = gt; i < 1024 * 16; i += NGT) { const int n = i >> 4, c = i & 15; *(v4u*)(w + (size_t)n * 256 + 128 + c * 8) = (v4u){0u, 0u, 0u, 0u}; } }
    { bf16* sc = WSP(bf16, WS_SC);
      for (int i = gt; i < 256 * 1024 / 4; i += NGT) { const int r = i >> 8, c4 = (i & 255) * 4; v2u o = (v2u){0u, 0u};
          if (r < 144) { const float* src = (r < 16) ? P.in[8] + (size_t)r * 1024 : P.in[9] + (size_t)(r - 16) * 1024; const f32x4 v = *(const f32x4*)(src + c4);
              o.x = pk2(v.x * sigmoidf_(v.x), v.y * sigmoidf_(v.y)); o.y = pk2(v.z * sigmoidf_(v.z), v.w * sigmoidf_(v.w)); }
          *(v2u*)(sc + (size_t)r * 1024 + c4) = o; } }
    { float* rt = WSP(float, WS_ROPE);
      for (int i = gt; i < 2049 * 16; i += NGT) { const int pi = i >> 4, k = i & 15; const float pos = (pi == 2048) ? 16384.0f : (float)pi;
          const float inv = powf(10000.0f, -(float)(2 * k) / 32.0f); const float ang = pos * inv; rt[2 * i] = cosf(ang); rt[2 * i + 1] = sinf(ang); } }
}

template <int NW, class Epi> __device__ __forceinline__ void skinny_gemm(const Ctx& C, const bf16* A, int lda, const bf16* Bt, int ldb, int MT, int NT, int K, const Epi& E) {
    const int gw = C.bid * NWAVES + C.wave, NGW = C.G * NWAVES, lane = C.lane;
    for (int wu = gw; wu < MT * NT; wu += NGW) {
        const int mt = wu % MT, nt = wu / MT;
        const bf16* ap = A + (size_t)(mt * 16 + (lane & 15)) * lda + 8 * (lane >> 4);
        const bf16* bp = Bt + (size_t)(nt * 16 * NW + (lane & 15)) * ldb + 8 * (lane >> 4);
        f32x4 acc[NW];
#pragma unroll
        for (int w = 0; w < NW; ++w) acc[w] = (f32x4){0.f, 0.f, 0.f, 0.f};
#pragma unroll 8
        for (int k = 0; k < K; k += 32) { const bf16x8 a = *(const bf16x8*)(ap + k);
#pragma unroll
            for (int w = 0; w < NW; ++w) { const bf16x8 b = *(const bf16x8*)(bp + (size_t)w * 16 * ldb + k); acc[w] = mfma16(a, b, acc[w]); } }
#pragma unroll
        for (int w = 0; w < NW; ++w) E(acc[w], mt, nt * NW + w, lane);
    }
}
template <class E, class = void> struct epi_rowstat { static constexpr bool value = false; };
template <class E> struct epi_rowstat<E, decltype((void)E::ROWSTAT)> { static constexpr bool value = E::ROWSTAT; };
template <int NW, class Epi> __device__ __forceinline__ void skinny_gemm_splitk(const Ctx& C, const bf16* A, int lda, const bf16* Bt, int ldb, int MT, int NTG, int K, const Epi& E) {
    const int lane = C.lane, w = C.wave, tid = C.tid, KW = K / 8;
    LAS float* part = (LAS float*)(C.lds + RING_OFF);
    for (int bu = C.bid; bu < MT * ((NTG + 7) & ~7); bu += C.G) {
        const int g8 = bu / (8 * MT), r8 = bu % (8 * MT), mt = r8 >> 3, ntg = g8 * 8 + (r8 & 7);
        if (ntg >= NTG) continue;
        const bf16* ap = A + (size_t)(mt * 16 + (lane & 15)) * lda + w * KW + 8 * (lane >> 4);
        const bf16* bp = Bt + (size_t)(ntg * 16 * NW + (lane & 15)) * ldb + w * KW + 8 * (lane >> 4);
        f32x4 acc[NW];
#pragma unroll
        for (int q = 0; q < NW; ++q) acc[q] = (f32x4){0.f, 0.f, 0.f, 0.f};
#pragma unroll 4
        for (int k = 0; k < KW; k += 32) { const bf16x8 a = *(const bf16x8*)(ap + k);
#pragma unroll
            for (int q = 0; q < NW; ++q) { const bf16x8 b = *(const bf16x8*)(bp + (size_t)q * 16 * ldb + k); acc[q] = mfma16(a, b, acc[q]); } }
#pragma unroll
        for (int q = 0; q < NW; ++q) *(LAS f32x4*)(part + ((w * NW + q) * 64 + lane) * 4) = acc[q];
        __syncthreads();
        if constexpr (epi_rowstat<Epi>::value) {
            LAS float* sq = part + 8 * NW * 256;
            for (int e = tid; e < 256 * NW; e += 512) { const int q = e >> 8, ln = (e >> 2) & 63, i = e & 3; float s = 0.f;
#pragma unroll
                for (int ww = 0; ww < 8; ++ww) s += part[((ww * NW + q) * 64 + ln) * 4 + i];
                const float v = E.elem(s, mt * 16 + 4 * (ln >> 4) + i, (ntg * NW + q) * 16 + (ln & 15)); sq[(4 * (ln >> 4) + i) * (16 * NW) + q * 16 + (ln & 15)] = v * v; }
            __syncthreads();
            if (tid < 16) { float s = 0.f; for (int k = 0; k < 16 * NW; ++k) s += sq[tid * (16 * NW) + k]; E.rowstat(mt * 16 + tid, s); }
        } else {
            for (int e = tid; e < 256 * NW; e += 512) { const int q = e >> 8, ln = (e >> 2) & 63, i = e & 3; float s = 0.f;
#pragma unroll
                for (int ww = 0; ww < 8; ++ww) s += part[((ww * NW + q) * 64 + ln) * 4 + i];
                E.elem(s, mt * 16 + 4 * (ln >> 4) + i, (ntg * NW + q) * 16 + (ln & 15)); }
        }
        __syncthreads();
    }
}
struct EpiSkBf16 { bf16* O; int ldc;
    __device__ __forceinline__ void elem(float v, int row, int col) const { O[(size_t)(MP + row) * ldc + col] = (bf16)f2bf(v); }
    __device__ __forceinline__ void operator()(const f32x4& acc, int mt, int nt, int lane) const {
#pragma unroll
        for (int i = 0; i < 4; ++i) O[(size_t)(MP + mt * 16 + 4 * (lane >> 4) + i) * ldc + nt * 16 + (lane & 15)] = (bf16)f2bf(acc[i]); } };
struct EpiSB { float* SB;
    __device__ __forceinline__ void elem(float v, int row, int col) const { if (row < 144) SB[(size_t)row * UPC + col] = v; } };
struct EpiSkUp { bf16* O; const float* rowss; const float* SB;
    __device__ __forceinline__ void elem(float v0, int row, int np) const { const float v = v0 * rsqrtf(rowss[MP + row] * (1.f / 1024.f) + EPS) + SB[(size_t)(16 + row) * UPC + np]; const int col = (np & 128) ? (DFF + 128 * (np >> 8) + (np & 127)) : (128 * (np >> 8) + (np & 127)); O[(size_t)(MP + row) * UPC + col] = (bf16)f2bf(v); }
    __device__ __forceinline__ void operator()(const f32x4& acc, int mt, int nt, int lane) const {
        const int np = nt * 16 + (lane & 15); const int col = (np & 128) ? (DFF + 128 * (np >> 8) + (np & 127)) : (128 * (np >> 8) + (np & 127));
#pragma unroll
        for (int i = 0; i < 4; ++i) O[(size_t)(MP + mt * 16 + 4 * (lane >> 4) + i) * UPC + col] = (bf16)f2bf(acc[i]); } };
template <bool BASE_BF16, bool OUT_BF16, bool XG> struct EpiSkResGate { const void* base; void* out; const float* mod; int goff; bf16* xg; const float* g2; float* rowss;
    __device__ __forceinline__ float elem(float a, int s, int c) const { const size_t o = (size_t)s * 1024 + c;
        const float bs = BASE_BF16 ? bf2f(((const bf16*)base)[o]) : ((const float*)base)[o];
        const float v = bs + mod[(size_t)(16 + s) * MODC + goff + c] * a;
        if (OUT_BF16) ((bf16*)out)[o] = (bf16)f2bf(v); else ((float*)out)[o] = v;
        if (XG) xg[o] = (bf16)f2bf(v * g2[c] * (1.0f + mod[(size_t)(16 + s) * MODC + 4096 + c]));
        return v; }
    static constexpr bool ROWSTAT = XG;
    __device__ __forceinline__ void rowstat(int s, float sumsq) const { __hip_atomic_fetch_add(rowss + s, sumsq, __ATOMIC_RELAXED, __HIP_MEMORY_SCOPE_AGENT); }
};

struct EpiMod { float* mod; const float* bias; bf16* sh2;
    __device__ __forceinline__ void elem(float v, int row, int col) const { if (row < 144) { const float o = v + bias[col]; mod[(size_t)row * MODC + col] = o; if (col >= 3072 && col < 4096) sh2[(size_t)row * 1024 + col - 3072] = (bf16)f2bf(o); } }
    __device__ __forceinline__ void operator()(const f32x4& acc, int mt, int nt, int lane) const {
        const int col = nt * 16 + (lane & 15); const float b = bias[col];
#pragma unroll
        for (int i = 0; i < 4; ++i) { const int row = mt * 16 + 4 * (lane >> 4) + i; if (row < 144) mod[(size_t)row * MODC + col] = acc[i] + b; }
    } };
__device__ __forceinline__ void phase_p0b(const Ctx& C, const Params& P) {
    EpiMod E{WSP(float, WS_MOD), P.in[11], WSP(bf16, WS_SH2)};
    skinny_gemm_splitk<8>(C, WSP(bf16, WS_SC), 1024, WSP(bf16, WS_WADA), 1024, 9, MODC / 128, 1024, E);
}

__device__ __forceinline__ const float* mod_row(const Params& P, int r) { return WSP(const float, WS_MOD) + (size_t)((r < MP) ? (r >> 11) : (16 + r - MP)) * MODC; }
template <bool SECOND> __device__ __forceinline__ void phase_norm_mod(const Ctx& C, const Params& P) {
    const int gw = C.bid * NWAVES + C.wave, NGW = C.G * NWAVES, lane = C.lane;
    const float* g = P.in[SECOND ? 32 : 12]; bf16* H = WSP(bf16, WS_H1);
    constexpr int SH = SECOND ? 3072 : 0, SC = SECOND ? 4096 : 1024;
    for (int r0 = gw; r0 < MR; r0 += 2 * NGW) {
        f32x4 v[2][4]; int rr[2];
#pragma unroll
        for (int u = 0; u < 2; ++u) { const int r = (r0 + u * NGW < MR) ? r0 + u * NGW : r0; rr[u] = r;
            if (r < MREAL) {
                if (SECOND) { const bf16* xb = WSP(const bf16, WS_X1) + (size_t)r * 1024;
#pragma unroll
                    for (int j = 0; j < 4; ++j) { const v2u w = *((const v2u*)xb + lane + 64 * j); v[u][j] = (f32x4){bflo(w.x), bfhi(w.x), bflo(w.y), bfhi(w.y)}; } }
                else { const float* xr = (r < MP) ? P.in[0] + (size_t)r * 1024 : P.in[1] + (size_t)(r - MP) * 1024;
#pragma unroll
                    for (int j = 0; j < 4; ++j) v[u][j] = *((const f32x4*)xr + lane + 64 * j); } }
            else {
#pragma unroll
                for (int j = 0; j < 4; ++j) v[u][j] = (f32x4){0.f, 0.f, 0.f, 0.f}; } }
#pragma unroll
        for (int u = 0; u < 2; ++u) { const int r = rr[u];
            GAS unsigned long long* o8 = (GAS unsigned long long*)(H + (size_t)r * 1024) + lane;
            if (r >= MREAL) {
#pragma unroll
                for (int j = 0; j < 4; ++j) o8[64 * j] = 0ull;
                continue; }
            const float* md = mod_row(P, r);
            float s = 0.f;
#pragma unroll
            for (int j = 0; j < 4; ++j) s += (v[u][j].x * v[u][j].x + v[u][j].y * v[u][j].y) + (v[u][j].z * v[u][j].z + v[u][j].w * v[u][j].w);
            const float rstd = rsqrtf(wave_sum(s) * (1.f / 1024.f) + EPS);
#pragma unroll
            for (int j = 0; j < 4; ++j) { const int c = 4 * (lane + 64 * j);
                const f32x4 gg = *(const f32x4*)(g + c), sc = *(const f32x4*)(md + SC + c), sh = *(const f32x4*)(md + SH + c);
                const f32x4 h = v[u][j] * rstd * gg * (sc + 1.0f) + sh;
                o8[64 * j] = (unsigned long long)pk2(h.x, h.y) | ((unsigned long long)pk2(h.z, h.w) << 32); }
        }
    }
}

__device__ __forceinline__ void phase_p3a(const Ctx& C, const Params& P) {
    const int gw = C.bid * NWAVES + C.wave, NGW = C.G * NWAVES, lane = C.lane;
    const bf16* Z = WSP(const bf16, WS_Z); bf16* QN = WSP(bf16, WS_QN); bf16* KVN = WSP(bf16, WS_KVN); bf16* KR = WSP(bf16, WS_KR);
    const float* rope = WSP(const float, WS_ROPE);
    const f32x4 gq = *(const f32x4*)(P.in[21] + 4 * lane); const f32x2 gkv = *(const f32x2*)(P.in[25] + 2 * lane); const float gkr = P.in[26][lane & 31];
    for (int r0 = gw; r0 < MREAL; r0 += 2 * NGW) {
        v2u wq[2]; unsigned wk[2]; unsigned short wr[2]; v4u wx[2]; int rr[2];
#pragma unroll
        for (int u = 0; u < 2; ++u) { const int r = (r0 + u * NGW < MREAL) ? r0 + u * NGW : r0; rr[u] = r; const bf16* z = Z + (size_t)r * ZC;
            wq[u] = *(const v2u*)(z + 1024 + 4 * lane); wk[u] = *(const unsigned*)(z + 1280 + 2 * lane); wr[u] = z[1408 + (lane & 31)];
            wx[u] = (v4u){0u, 0u, 0u, 0u}; if (r >= MP || (r & 2047) >= 2045) wx[u] = *(const v4u*)(z + 8 * lane); }
#pragma unroll
        for (int u = 0; u < 2; ++u) { const int r = rr[u];
            const bool smp = r >= MP; const int s_ = r - MP, b = r >> 11, t = r & 2047;
            { const float a0 = bflo(wq[u].x), a1 = bfhi(wq[u].x), a2 = bflo(wq[u].y), a3 = bfhi(wq[u].y);
              const float rstd = rsqrtf(wave_sum(a0 * a0 + a1 * a1 + a2 * a2 + a3 * a3) * (1.f / 256.f) + EPS);
              v2u o; o.x = pk2(a0 * rstd * gq.x, a1 * rstd * gq.y); o.y = pk2(a2 * rstd * gq.z, a3 * rstd * gq.w); *(v2u*)(QN + (size_t)r * 256 + 4 * lane) = o; }
            { const float a0 = bflo(wk[u]), a1 = bfhi(wk[u]);
              const float rstd = rsqrtf(wave_sum(a0 * a0 + a1 * a1) * (1.f / 128.f) + EPS);
              const float o0 = a0 * rstd * gkv.x, o1 = a1 * rstd * gkv.y;
              float* dst = P.out + (smp ? O_KVS + (size_t)s_ * 128 : O_KVP + (size_t)r * 128); *(f32x2*)(dst + 2 * lane) = (f32x2){o0, o1};
              *(unsigned*)(KVN + (size_t)r * 256 + 2 * lane) = pk2(o0, o1); *(unsigned*)(KVN + (size_t)r * 256 + 128 + 2 * lane) = 0u; }
            { const float a = (lane < 32) ? bf2f(wr[u]) : 0.f; const float rstd = rsqrtf(wave_sum(a * a) * (1.f / 32.f) + EPS);
              const float v = a * rstd * gkr; const float pr = lane_xor16(v, lane);
              const f32x2 cs = *(const f32x2*)(rope + ((size_t)(smp ? 2048 : t) * 16 + (lane & 15)) * 2);
              const float o = (lane & 16) ? (v * cs.x + pr * cs.y) : (v * cs.x - pr * cs.y);
              if (lane < 32) { float* dst = P.out + (smp ? O_KRS + (size_t)s_ * 32 : O_KRP + (size_t)r * 32); dst[lane] = o; KR[(size_t)r * 32 + lane] = (bf16)f2bf(o); } }
            const v4u w = wx[u];
            if (smp) { float* d2 = P.out + O_LCS + (size_t)s_ * 1536; const float* st = P.in[5] + (size_t)s_ * 1536;
                *(f32x4*)(d2 + 8 * lane) = *(const f32x4*)(st + 512 + 8 * lane); *(f32x4*)(d2 + 8 * lane + 4) = *(const f32x4*)(st + 512 + 8 * lane + 4);
                *(f32x4*)(d2 + 512 + 8 * lane) = *(const f32x4*)(st + 1024 + 8 * lane); *(f32x4*)(d2 + 512 + 8 * lane + 4) = *(const f32x4*)(st + 1024 + 8 * lane + 4);
                *(f32x4*)(d2 + 1024 + 8 * lane) = (f32x4){bflo(w.x), bfhi(w.x), bflo(w.y), bfhi(w.y)}; *(f32x4*)(d2 + 1024 + 8 * lane + 4) = (f32x4){bflo(w.z), bfhi(w.z), bflo(w.w), bfhi(w.w)}; }
            else if (t >= 2045) { float* d2 = P.out + O_LCP + ((size_t)b * 3 + (t - 2045)) * 512;
                *(f32x4*)(d2 + 8 * lane) = (f32x4){bflo(w.x), bfhi(w.x), bflo(w.y), bfhi(w.y)}; *(f32x4*)(d2 + 8 * lane + 4) = (f32x4){bflo(w.z), bfhi(w.z), bflo(w.w), bfhi(w.w)}; }
        }
    }
}

template <bool SMP> __device__ __forceinline__ void phase_p3b(const Ctx& C, const Params& P) {
    LAS float* L = (LAS float*)(C.lds + RING_OFF);
    for (int i = C.tid; i < 2048; i += 512) L[i] = P.in[14][i];
    { const int i = C.tid; L[2048 + i] = P.in[15][i]; L[2560 + i] = P.in[17][i]; L[3072 + i] = P.in[19][i];
      const float nl = -P.in[20][i]; L[3584 + i] = fmaxf(nl, 0.f) + log1pf(__expf(-fabsf(nl))); }
    __syncthreads();
    const int lane0 = C.lane, h = C.wave;
    const bf16* Z = WSP(const bf16, WS_Z); bf16* HL = WSP(bf16, WS_HL); bf16* AC = WSP(bf16, WS_AC); float* SUM = WSP(float, WS_SUM);
    const bf16* WG = WSP(const bf16, WS_WG);
    bf16x8 idf[2];
#pragma unroll
    for (int s2 = 0; s2 < 2; ++s2) { bf16x8 f;
#pragma unroll
        for (int j = 0; j < 8; ++j) f[j] = (16 * s2 + 8 * (lane0 >> 5) + j == (lane0 & 31)) ? (short)0x3F80 : (short)0;
        idf[s2] = f; }
    const int NIT = SMP ? 4 : NBATCH * 32;
    for (int it0 = C.bid; it0 < NIT; it0 += C.G) {
        constexpr bool smp = SMP; const int it = SMP ? it0 + NBATCH * 32 : it0;
        int lane = lane0; asm volatile("" : "+v"(lane));
        const int tk = lane & 31, hh = lane >> 5;
        const int b = it >> 5, chunk = it & 31;
        float carP[2] = {1.f, 1.f}, carS[2] = {0.f, 0.f};
#pragma unroll 1
        for (int sub = 0; sub < (smp ? 1 : 2); ++sub) {
            const int t0 = smp ? 0 : chunk * 64 + sub * 32;
            const int sq = (it - NBATCH * 32) * 32;
            const size_t rowA = smp ? (size_t)(MP + sq + tk) : (size_t)b * SEQ + t0 + tk;
            bf16x8 af[4];
            int hhc = hh; asm volatile("" : "+v"(hhc));
            v4u zn[4];
#define P3B_LOADZ(s_) do { const int chn_ = 64 * h + 16 * (s_) + 8 * hhc; _Pragma("unroll") for (int tap = 0; tap < 4; ++tap) { const int tt = t0 + tk - 3 + tap; zn[tap] = (v4u){0u, 0u, 0u, 0u}; \
                if (!(smp && tap < 3) && (smp || tt >= 0)) zn[tap] = *(const v4u*)(Z + (rowA - 3 + tap) * ZC + chn_); } } while (0)
            P3B_LOADZ(0);
#pragma unroll
            for (int s = 0; s < 4; ++s) {
                const int ch0 = 64 * h + 16 * s + 8 * hhc;
                v4u zc[4];
#pragma unroll
                for (int tap = 0; tap < 4; ++tap) zc[tap] = zn[tap];
                if (s < 3) P3B_LOADZ(s + 1);
                float xc[8];
#pragma unroll
                for (int j = 0; j < 8; ++j) xc[j] = L[2048 + ch0 + j];
#pragma unroll
                for (int tap = 0; tap < 4; ++tap) {
                    float xv[8];
                    if (smp && tap < 3) { const float* st = P.in[5] + ((size_t)(sq + tk) * 3 + tap) * 512 + ch0; const f32x4 a = *(const f32x4*)st, bq = *(const f32x4*)(st + 4);
                        xv[0] = a.x; xv[1] = a.y; xv[2] = a.z; xv[3] = a.w; xv[4] = bq.x; xv[5] = bq.y; xv[6] = bq.z; xv[7] = bq.w; }
                    else unpack8f(zc[tap], xv);
#pragma unroll
                    for (int j = 0; j < 8; ++j) xc[j] += L[tap * 512 + ch0 + j] * xv[j];
                }
                af[s] = pack8(xc);
                asm volatile("" ::: "memory"); __builtin_amdgcn_sched_barrier(0);
            }
#undef P3B_LOADZ
#pragma unroll 1
            for (int cb = 0; cb < 2; ++cb) {
                f32x16 ra = {}, ia = {}, xq = {};
                { unsigned woff = (unsigned)(((h * 2) * 64 + 32 * cb + tk) * 64 + 8 * hh); asm volatile("" : "+v"(woff));
                  const bf16* wp = WG + woff;
#pragma unroll
                  for (int s = 0; s < 4; ++s) { const bf16x8 wa = *(const bf16x8*)(wp + 16 * s), wx = *(const bf16x8*)(wp + 4096 + 16 * s); ra = mfma32(af[s], wa, ra); ia = mfma32(af[s], wx, ia); } }
                { const bf16x8 afa = cb ? af[2] : af[0], afb = cb ? af[3] : af[1]; xq = mfma32(afa, idf[0], xq); xq = mfma32(afb, idf[1], xq); }
                const int ch = 64 * h + 32 * cb + tk;
                const float spc = L[3584 + ch], bac = L[2560 + ch], bxc = L[3072 + ch];
                float av[16], hv[16];
#pragma unroll
                for (int rr = 0; rr < 16; ++rr) {
                    const float rg = sigmoidf_(ra[rr] + bac), ig = sigmoidf_(ia[rr] + bxc);
                    const float la = -8.0f * spc * rg; const float a = __builtin_amdgcn_exp2f(1.4426950408889634f * la);
                    const float x2 = 2.0f * la;
                    const float ser = -x2 * (1.0f + x2 * (0.5f + x2 * (0.16666667f + x2 * (0.041666668f + x2 * (0.008333334f + x2 * 0.0013888889f)))));
                    float mult = __builtin_amdgcn_sqrtf(x2 > -0.25f ? ser : 1.0f - a * a);
                    if (!smp && (t0 + crow(rr, hh)) == 0) mult = 1.0f;
                    av[rr] = a; hv[rr] = mult * ig * xq[rr];
                    if ((rr & 3) == 3) __builtin_amdgcn_sched_barrier(0);
                }
                if (smp) {
#pragma unroll
                    for (int rr = 0; rr < 16; ++rr) { const int sI = sq + crow(rr, hh); const float h0 = P.in[4][(size_t)sI * 512 + ch];
                        const float hn = av[rr] * h0 + hv[rr]; P.out[O_LHS + (size_t)sI * 512 + ch] = hn;
                        HL[(size_t)(MP + sI) * 512 + ch] = (bf16)f2bf(hn); AC[(size_t)(MP + sI) * 512 + ch] = (bf16)0; }
                } else {
#pragma unroll
                    for (int gi = 0; gi < 4; ++gi)
#pragma unroll
                        for (int j = 1; j < 4; ++j) { hv[4 * gi + j] = av[4 * gi + j] * hv[4 * gi + j - 1] + hv[4 * gi + j]; av[4 * gi + j] = av[4 * gi + j] * av[4 * gi + j - 1]; }
                    float Pc = cb ? carP[1] : carP[0], Sc = cb ? carS[1] : carS[0];
#pragma unroll
                    for (int gi = 0; gi < 4; ++gi) {
                        const float oA = av[4 * gi + 3], oH = hv[4 * gi + 3];
                        const float pA = lane_xor32(oA, lane), pH = lane_xor32(oH, lane);
                        const float loA = hh ? pA : oA, loH = hh ? pH : oH, hiA = hh ? oA : pA, hiH = hh ? oH : pH;
                        const float S1 = loH + loA * Sc, P1 = loA * Pc;
                        const float Sin = hh ? S1 : Sc, Pin = hh ? P1 : Pc;
#pragma unroll
                        for (int j = 0; j < 4; ++j) { const int rr = 4 * gi + j; hv[rr] = hv[rr] + av[rr] * Sin; av[rr] = av[rr] * Pin; }
                        Sc = hiH + hiA * S1; Pc = hiA * P1;
                    }
                    if (cb) { carP[1] = Pc; carS[1] = Sc; } else { carP[0] = Pc; carS[0] = Sc; }
                    { const unsigned ob = (unsigned)(((b * SEQ + t0 + 4 * hh) * 512 + ch) * 2);
#pragma unroll
                      for (int rr = 0; rr < 16; ++rr) { const unsigned o2 = ob + (unsigned)(((rr & 3) + 8 * (rr >> 2)) * 1024);
                          const unsigned w2 = pk2(hv[rr], av[rr]); *(bf16*)((char*)HL + o2) = (bf16)w2; *(bf16*)((char*)AC + o2) = (bf16)(w2 >> 16); } }
                }
            }
        }
        if (!smp) { int lq = lane; asm volatile("" : "+v"(lq));
            if (lq < 32) {
#pragma unroll
                for (int cb = 0; cb < 2; ++cb) { const int ch = 64 * h + 32 * cb + lq; *(f32x2*)(SUM + (((size_t)b * 32 + chunk) * 512 + ch) * 2) = (f32x2){carP[cb], carS[cb]}; } }
        }
    }
    __syncthreads();
}

__device__ __forceinline__ float g8_sum(float v) { v += DPPF0(v, 0xB1); v += DPPF0(v, 0x4E); v += DPPF0(v, 0x141); return v; }
__device__ __forceinline__ void phase_p5(const Ctx& C, const Params& P) {
    const int gw = C.bid * NWAVES + C.wave, NGW = C.G * NWAVES, lane = C.lane, hd = lane >> 3, sub = lane & 7;
    const bf16* QRAW = WSP(const bf16, WS_QRAW); const bf16* KVRAW = WSP(const bf16, WS_KVRAW); const bf16* KR = WSP(const bf16, WS_KR);
    bf16* Q = WSP(bf16, WS_Q); bf16* KF = WSP(bf16, WS_KF);
    const float* rope = WSP(const float, WS_ROPE);
    float gkn[8];
#pragma unroll
    for (int j = 0; j < 8; ++j) gkn[j] = P.in[28][8 * sub + j];
    for (int r0 = gw; r0 < MREAL; r0 += 4 * NGW) {
        v4u wkn[4]; v2u wkr[4]; int rr[4];
#pragma unroll
        for (int u = 0; u < 4; ++u) { const int r = (r0 + u * NGW < MREAL) ? r0 + u * NGW : r0; rr[u] = r;
            wkn[u] = *(const v4u*)(KVRAW + (size_t)r * 1024 + hd * 128 + 8 * sub); wkr[u] = *(const v2u*)(KR + (size_t)r * 32 + 4 * sub); }
#pragma unroll
        for (int u = 0; u < 4; ++u) { const int r = rr[u];
            float v[8]; unpack8f(wkn[u], v); float ss = 0.f;
#pragma unroll
            for (int j = 0; j < 8; ++j) ss += v[j] * v[j];
            const float rstd = rsqrtf(g8_sum(ss) * (1.f / 64.f) + EPS);
#pragma unroll
            for (int j = 0; j < 8; ++j) v[j] = v[j] * rstd * gkn[j];
            *(bf16x8*)(KF + (size_t)r * 768 + hd * 96 + 8 * sub) = pack8(v);
            *(v2u*)(KF + (size_t)r * 768 + hd * 96 + 64 + 4 * sub) = wkr[u];
        }
    }
    for (int r = MP + gw; r < MREAL; r += NGW) {
        const bf16* q = QRAW + (size_t)r * 768 + hd * 96;
        float v[8]; unpack8f(*(const v4u*)(q + 8 * sub), v); float ss = 0.f;
#pragma unroll
        for (int j = 0; j < 8; ++j) ss += v[j] * v[j];
        const float rstd = rsqrtf(g8_sum(ss) * (1.f / 64.f) + EPS) * C2;
#pragma unroll
        for (int j = 0; j < 8; ++j) v[j] = v[j] * rstd * P.in[23][8 * sub + j];
        *(bf16x8*)(Q + (size_t)r * 768 + hd * 96 + 8 * sub) = pack8(v);
        const v2u wq = *(const v2u*)(q + 64 + 4 * sub); float x[4] = {bflo(wq.x), bfhi(wq.x), bflo(wq.y), bfhi(wq.y)};
        const float rs2 = rsqrtf(g8_sum(x[0] * x[0] + x[1] * x[1] + x[2] * x[2] + x[3] * x[3]) * (1.f / 32.f) + EPS);
        float o[4];
#pragma unroll
        for (int j = 0; j < 4; ++j) { const float me = x[j] * rs2 * P.in[24][4 * sub + j]; const float pr = __shfl_xor(me, 4);
            const f32x2 cs = *(const f32x2*)(rope + ((size_t)2048 * 16 + 4 * (sub & 3) + j) * 2);
            o[j] = ((sub & 4) ? (me * cs.x + pr * cs.y) : (me * cs.x - pr * cs.y)) * C2; }
        v2u ow; ow.x = pk2(o[0], o[1]); ow.y = pk2(o[2], o[3]); *(v2u*)(Q + (size_t)r * 768 + hd * 96 + 64 + 4 * sub) = ow;
    }
}

__device__ __forceinline__ void phase_carry(const Ctx& C, const Params& P) {
    const float* SUM = WSP(const float, WS_SUM); float* CAR = WSP(float, WS_CARRY);
    const int t = C.tid; if (t >= 32) return;
    for (int idx = C.bid * 32 + t; idx < NBATCH * 512; idx += C.G * 32) {
        const int b = idx >> 9, ch = idx & 511; f32x2 ps[32];
#pragma unroll
        for (int k = 0; k < 32; ++k) ps[k] = *(const f32x2*)(SUM + (((size_t)b * 32 + k) * 512 + ch) * 2);
        float H = 0.f;
#pragma unroll
        for (int k = 0; k < 32; ++k) { CAR[((size_t)b * 32 + k) * 512 + ch] = H; H = ps[k].x * H + ps[k].y; }
        P.out[O_LHP + idx] = H;
    }
}

constexpr int KT_PITCH = 208, VT_PITCH = 192;
constexpr int KT_BYTES = 64 * KT_PITCH, VT_BYTES = 64 * VT_PITCH, ATT_BUF = KT_BYTES + VT_BYTES;
__device__ __forceinline__ s16x4 tr_read(unsigned addr) { s16x4 r; asm volatile("ds_read_b64_tr_b16 %0, %1\n\ts_waitcnt lgkmcnt(0)" : "=&v"(r) : "v"(addr) : "memory"); return r; }
__device__ __forceinline__ void attn_unit(const Ctx& C, const Params& P, int bh, int qb) {
    const int lane = C.lane, wid = C.wave, tid = C.tid, r32 = lane & 31, hh = lane >> 5;
    const int b = bh >> 3, h = bh & 7;
    const bf16* QRAW = WSP(const bf16, WS_QRAW); const bf16* KF = WSP(const bf16, WS_KF); const bf16* KVRAW = WSP(const bf16, WS_KVRAW); bf16* ATT = WSP(bf16, WS_ATT);
    const size_t rowbase = (size_t)b * SEQ; const int q0 = qb * 256 + wid * 32;
    const unsigned lds0 = (unsigned)(uintptr_t)(C.lds + RING_OFF);
    bf16x8 qf[6];
    { float qv[6][8];
#pragma unroll
      for (int s = 0; s < 6; ++s) { const v4u w = *(const v4u*)(QRAW + (rowbase + q0 + r32) * 768 + h * 96 + 16 * s + 8 * hh); unpack8f(w, qv[s]); }
      float sn = 0.f, sr = 0.f;
#pragma unroll
      for (int j = 0; j < 8; ++j) { sn += qv[0][j] * qv[0][j] + qv[1][j] * qv[1][j] + qv[2][j] * qv[2][j] + qv[3][j] * qv[3][j]; sr += qv[4][j] * qv[4][j] + qv[5][j] * qv[5][j]; }
      const float rn = rsqrtf(xhalf_sum(sn) * (1.f / 64.f) + EPS) * C2, rr = rsqrtf(xhalf_sum(sr) * (1.f / 32.f) + EPS);
      const float* gqn = P.in[23]; const float* gqr = P.in[24]; const float* rope = WSP(const float, WS_ROPE) + (size_t)(q0 + r32) * 32;
#pragma unroll
      for (int s = 0; s < 4; ++s) {
#pragma unroll
          for (int j = 0; j < 8; ++j) qv[s][j] *= rn * gqn[16 * s + 8 * hh + j];
          qf[s] = pack8(qv[s]); }
#pragma unroll
      for (int j = 0; j < 8; ++j) { const int i = 8 * hh + j; const float x1 = qv[4][j] * rr * gqr[i], x2 = qv[5][j] * rr * gqr[16 + i]; const f32x2 cs = *(const f32x2*)(rope + 2 * i);
          qv[4][j] = (x1 * cs.x - x2 * cs.y) * C2; qv[5][j] = (x2 * cs.x + x1 * cs.y) * C2; }
      qf[4] = pack8(qv[4]); qf[5] = pack8(qv[5]); }
    const int NT = 4 * (qb + 1);
    const int kc0 = tid, kr0 = kc0 / 12, kk0 = kc0 % 12, kc1 = 512 + tid, kr1 = kc1 / 12, kk1 = kc1 % 12; const bool k2 = tid < 256;
    const int vr = tid >> 3, vk = tid & 7;
    const bf16* kg0 = KF + (rowbase + kr0) * 768 + h * 96 + kk0 * 8; const bf16* kg1 = KF + (rowbase + kr1) * 768 + h * 96 + kk1 * 8;
    const bf16* vg = KVRAW + (rowbase + vr) * 1024 + h * 128 + 64 + vk * 8;
    v4u sk0, sk1 = (v4u){0u, 0u, 0u, 0u}, sv;
    sk0 = *(const v4u*)kg0; if (k2) sk1 = *(const v4u*)kg1; sv = *(const v4u*)vg;
    { LAS unsigned char* bufp = C.lds + RING_OFF; *(LAS v4u*)(bufp + kr0 * KT_PITCH + kk0 * 16) = sk0; if (k2) *(LAS v4u*)(bufp + kr1 * KT_PITCH + kk1 * 16) = sk1; *(LAS v4u*)(bufp + KT_BYTES + vr * VT_PITCH + vk * 16) = sv; }
    __syncthreads();
    float m_run = -INFINITY, l_run = 0.f; f32x16 o[2]; o[0] = f32x16{}; o[1] = f32x16{};
    for (int t = 0; t < NT; ++t) {
        const int cur = t & 1; const bool more = (t + 1 < NT);
        if (more) { const size_t adv = (size_t)(t + 1) * 64; sk0 = *(const v4u*)(kg0 + adv * 768); if (k2) sk1 = *(const v4u*)(kg1 + adv * 768); sv = *(const v4u*)(vg + adv * 1024); }
        LAS unsigned char* Kb = C.lds + RING_OFF + cur * ATT_BUF; const unsigned Vb = lds0 + cur * ATT_BUF + KT_BYTES;
        if (64 * t <= q0 + 31) {
        f32x16 p[2];
#pragma unroll
        for (int kh = 0; kh < 2; ++kh) { f32x16 acc = f32x16{};
#pragma unroll
            for (int s = 0; s < 6; ++s) { const bf16x8 kf = *(const LAS bf16x8*)(Kb + (32 * kh + r32) * KT_PITCH + (16 * s + 8 * hh) * 2); acc = mfma32(kf, qf[s], acc); }
            p[kh] = acc; }
        s16x4 vl[2][2][2], vh[2][2][2];
        { const int i16 = lane & 15, q4 = i16 >> 2, p4 = i16 & 3, blk = (lane >> 4) & 1;
          const unsigned a0 = Vb + (4 * hh + q4) * VT_PITCH + (16 * blk + 4 * p4) * 2;
#define TRV(kh, s2) asm volatile("ds_read_b64_tr_b16 %0, %4 offset:%5\n\tds_read_b64_tr_b16 %1, %4 offset:%6\n\tds_read_b64_tr_b16 %2, %4 offset:%7\n\tds_read_b64_tr_b16 %3, %4 offset:%8" \
              : "=&v"(vl[kh][s2][0]), "=&v"(vh[kh][s2][0]), "=&v"(vl[kh][s2][1]), "=&v"(vh[kh][s2][1]) : "v"(a0), "i"((32 * kh + 16 * s2) * VT_PITCH), "i"((32 * kh + 16 * s2 + 8) * VT_PITCH), \
                "i"((32 * kh + 16 * s2) * VT_PITCH + 64), "i"((32 * kh + 16 * s2 + 8) * VT_PITCH + 64) : "memory")
          TRV(0, 0); TRV(0, 1); TRV(1, 0); TRV(1, 1);
#undef TRV
        }
        if (64 * t + 63 > q0) { const int qq = q0 + r32;
#pragma unroll
            for (int kh = 0; kh < 2; ++kh)
#pragma unroll
                for (int r = 0; r < 16; ++r) if (64 * t + 32 * kh + crow(r, hh) > qq) p[kh][r] = -INFINITY; }
        float mx = p[0][0];
#pragma unroll
        for (int r = 1; r < 16; ++r) mx = fmaxf(mx, p[0][r]);
#pragma unroll
        for (int r = 0; r < 16; ++r) mx = fmaxf(mx, p[1][r]);
        { auto rr = __builtin_amdgcn_permlane32_swap(__float_as_uint(mx), __float_as_uint(mx), false, false); mx = fmaxf(__uint_as_float(rr[0]), __uint_as_float(rr[1])); }
        const float m_new = fmaxf(m_run, mx); const float alpha = __builtin_amdgcn_exp2f(m_run - m_new); m_run = m_new;
        float ps = 0.f;
#pragma unroll
        for (int kh = 0; kh < 2; ++kh)
#pragma unroll
            for (int r = 0; r < 16; ++r) { const float e = __builtin_amdgcn_exp2f(p[kh][r] - m_new); p[kh][r] = e; ps += e; }
        l_run = l_run * alpha + ps;
#pragma unroll
        for (int dt = 0; dt < 2; ++dt)
#pragma unroll
            for (int r = 0; r < 16; ++r) o[dt][r] *= alpha;
        asm volatile("s_waitcnt lgkmcnt(0)" : "+v"(vl[0][0][0]), "+v"(vh[0][0][0]), "+v"(vl[0][0][1]), "+v"(vh[0][0][1]), "+v"(vl[0][1][0]), "+v"(vh[0][1][0]), "+v"(vl[0][1][1]), "+v"(vh[0][1][1]),
                     "+v"(vl[1][0][0]), "+v"(vh[1][0][0]), "+v"(vl[1][0][1]), "+v"(vh[1][0][1]), "+v"(vl[1][1][0]), "+v"(vh[1][1][0]), "+v"(vl[1][1][1]), "+v"(vh[1][1][1]) :: "memory");
#pragma unroll
        for (int kh = 0; kh < 2; ++kh)
#pragma unroll
            for (int s2 = 0; s2 < 2; ++s2) {
                float pv[8];
#pragma unroll
                for (int j = 0; j < 8; ++j) pv[j] = p[kh][8 * s2 + j];
                const bf16x8 pf = pack8(pv);
                o[0] = mfma32(__builtin_shufflevector(vl[kh][s2][0], vh[kh][s2][0], 0, 1, 2, 3, 4, 5, 6, 7), pf, o[0]);
                o[1] = mfma32(__builtin_shufflevector(vl[kh][s2][1], vh[kh][s2][1], 0, 1, 2, 3, 4, 5, 6, 7), pf, o[1]);
            }
        }
        if (more) { LAS unsigned char* nb = C.lds + RING_OFF + (cur ^ 1) * ATT_BUF;
            *(LAS v4u*)(nb + kr0 * KT_PITCH + kk0 * 16) = sk0; if (k2) *(LAS v4u*)(nb + kr1 * KT_PITCH + kk1 * 16) = sk1; *(LAS v4u*)(nb + KT_BYTES + vr * VT_PITCH + vk * 16) = sv; }
        __syncthreads();
    }
    const float linv = 1.0f / xhalf_sum(l_run);
    bf16* orow = ATT + (rowbase + q0 + r32) * 512 + h * 64;
#pragma unroll
    for (int dt = 0; dt < 2; ++dt)
#pragma unroll
        for (int g = 0; g < 4; ++g) { v2u w; w.x = pk2(o[dt][4 * g] * linv, o[dt][4 * g + 1] * linv); w.y = pk2(o[dt][4 * g + 2] * linv, o[dt][4 * g + 3] * linv);
            *(v2u*)(orow + 32 * dt + 8 * g + 4 * hh) = w; }
}
__device__ __forceinline__ void phase_attn_prompt(const Ctx& C, const Params& P) {
    for (int pi = C.bid; pi < 512; pi += C.G) {
        const int bh = pi >> 2, pr = pi & 3;
        attn_unit(C, P, bh, 7 - pr);
        attn_unit(C, P, bh, pr);
    }
}

constexpr int LK_PITCH = 272, LT_PITCH = 272, LKR_PITCH = 80;
constexpr int SA_LK = 0, SA_LT = 128 * LK_PITCH, SA_LT_BUF = 128 * LT_PITCH, SA_KR = SA_LT + 2 * SA_LT_BUF, SA_P = SA_KR + 128 * LKR_PITCH, SA_P_BUF = 8 * 256, SA_AL = SA_P + 2 * SA_P_BUF, SA_QG = SA_AL + 2 * 32, SA_END = SA_QG + 8 * 256;
static_assert(SA_END <= RING_BYTES, "sample attention LDS");
constexpr int PART_STRIDE = 8 * 132;
__device__ __forceinline__ float xhalf_sum_pl(float v) { auto rr = __builtin_amdgcn_permlane32_swap(__float_as_uint(v), __float_as_uint(v), false, false); return __uint_as_float(rr[0]) + __uint_as_float(rr[1]); }
__device__ __forceinline__ void phase_attn_sample(const Ctx& C, const Params& P) {
    const int lane = C.lane, h = C.wave, tid = C.tid, r32 = lane & 31, hh = lane >> 5;
    const bf16* WUKV = WSP(const bf16, WS_WUKV); const bf16* Q = WSP(const bf16, WS_Q); float* PART = WSP(float, WS_PART);
    const float* cache_lat = P.in[2]; const float* cache_kr = P.in[3]; const int* ptab = (const int*)P.in[7]; const float* gkn = P.in[28];
    LAS unsigned char* S = C.lds + RING_OFF;
    bf16x8 wk[2][8];
#pragma unroll
    for (int rt = 0; rt < 2; ++rt)
#pragma unroll
        for (int s = 0; s < 8; ++s) wk[rt][s] = *(const bf16x8*)(WUKV + (size_t)(h * 128 + 32 * rt + r32) * 256 + 16 * s + 8 * hh);
    const int kg = tid >> 5, dq = tid & 31;
    for (int u = C.bid; u < 256; u += C.G) {
        const int sq = u >> 1, half = u & 1; const size_t qrow = (size_t)(MP + sq);
        { const int l2 = fresh_lane(); *(LAS float*)(S + SA_QG + h * 256 + l2 * 4) = bf2f(Q[qrow * 768 + h * 96 + l2]) * gkn[l2]; }
        bf16x8 qv[2];
        { const bf16x8 qfr = *(const bf16x8*)(Q + qrow * 768 + h * 96 + 64 + 8 * (lane >> 4));
          qv[0] = ((lane & 7) == 0) ? qfr : bf16x8{}; qv[1] = ((lane & 7) == 4) ? qfr : bf16x8{}; }
        float m_run = -INFINITY, l_run = 0.f; f32x4 ctx = (f32x4){0.f, 0.f, 0.f, 0.f};
        f32x4 pl[8]; f32x4 pk[2];
        const int pgs = ptab[sq * NPAGES + half * 64 + lane];
#define SA_PREFETCH(pgidx) do { const int pg_ = __builtin_amdgcn_readlane(pgs, (pgidx)); \
          const char* lb_ = (const char*)(cache_lat + (size_t)pg_ * (PAGE * KVLR)); const char* kb_ = (const char*)(cache_kr + (size_t)pg_ * (PAGE * ROPE_D)); \
          const unsigned lo_ = (unsigned)((tid >> 5) * 4096 + (tid & 31) * 16), ko_ = (unsigned)(tid * 16); \
          _Pragma("unroll") for (int i = 0; i < 8; ++i) pl[i] = __builtin_nontemporal_load((const f32x4*)(lb_ + lo_ + i * 512)); \
          pk[0] = __builtin_nontemporal_load((const f32x4*)(kb_ + ko_)); pk[1] = __builtin_nontemporal_load((const f32x4*)(kb_ + 8192 + ko_)); } while (0)
        SA_PREFETCH(0);
#pragma unroll 1
        for (int pgi = 0; pgi < 64; ++pgi) {
            const int pb = pgi & 1;
#ifndef SA_REP_STAGE
#define SA_REP_STAGE 1
#endif
#ifndef SA_REP_TILE
#define SA_REP_TILE 1
#endif
            for (int rs_ = 0; rs_ < SA_REP_STAGE; ++rs_) { asm volatile("" ::: "memory");
            { unsigned lo[8], hi2[8];
#pragma unroll
              for (int i = 0; i < 8; ++i) { lo[i] = pk2(pl[i].x, pl[i].y); hi2[i] = pk2(pl[i].z, pl[i].w); *(LAS v2u*)(S + SA_LK + (8 * kg + i) * LK_PITCH + dq * 8) = (v2u){lo[i], hi2[i]}; }
              v4u w0, w1, w2, w3;
#pragma unroll
              for (int i = 0; i < 4; ++i) { w0[i] = __builtin_amdgcn_perm(lo[2 * i + 1], lo[2 * i], 0x05040100u); w1[i] = __builtin_amdgcn_perm(lo[2 * i + 1], lo[2 * i], 0x07060302u);
                                            w2[i] = __builtin_amdgcn_perm(hi2[2 * i + 1], hi2[2 * i], 0x05040100u); w3[i] = __builtin_amdgcn_perm(hi2[2 * i + 1], hi2[2 * i], 0x07060302u); }
              LAS unsigned char* T = S + SA_LT + pb * SA_LT_BUF + kg * 16;
              *(LAS v4u*)(T + (4 * dq + 0) * LT_PITCH) = w0; *(LAS v4u*)(T + (4 * dq + 1) * LT_PITCH) = w1; *(LAS v4u*)(T + (4 * dq + 2) * LT_PITCH) = w2; *(LAS v4u*)(T + (4 * dq + 3) * LT_PITCH) = w3; }
#pragma unroll
            for (int i = 0; i < 2; ++i) { const int c = tid + 512 * i, key = c >> 3, part = c & 7; *(LAS v2u*)(S + SA_KR + key * LKR_PITCH + part * 8) = (v2u){pk2(pk[i].x, pk[i].y), pk2(pk[i].z, pk[i].w)}; }
            }
            if (pgi + 1 < 64) SA_PREFETCH(pgi + 1);
            __syncthreads();
            float sc[4];
            for (int rt_ = 0; rt_ < SA_REP_TILE; ++rt_) { asm volatile("" ::: "memory");
            { f32x16 a0, a1; f32x4 r4; bf16x8 bf[8], kb0, kb1; float ssx, ssy, dtx, dty;
#define SA_LOADB(kt) do { _Pragma("unroll") for (int s = 0; s < 8; ++s) bf[s] = *(const LAS bf16x8*)(S + SA_LK + (32 * (kt) + r32) * LK_PITCH + (16 * s + 8 * hh) * 2); \
                const LAS unsigned char* kr_ = S + SA_KR + (32 * (kt) + (lane & 15)) * LKR_PITCH + (lane >> 4) * 16; kb0 = *(const LAS bf16x8*)kr_; kb1 = *(const LAS bf16x8*)(kr_ + 16 * LKR_PITCH); } while (0)
#define SA_ROPE() do { r4 = (f32x4){0.f, 0.f, 0.f, 0.f}; r4 = mfma16(qv[0], kb0, r4); r4 = mfma16(qv[1], kb1, r4); } while (0)
#define SA_MF(A, rt) do { A = f32x16{}; _Pragma("unroll") for (int s = 0; s < 8; ++s) A = mfma32(wk[rt][s], bf[s], A); } while (0)
#define SA_RED(A, rt) do { f32x4 q_[4]; _Pragma("unroll") for (int g = 0; g < 4; ++g) q_[g] = *(const LAS f32x4*)(S + SA_QG + h * 256 + (32 * (rt) + 8 * g + 4 * hh) * 4); \
                _Pragma("unroll") for (int g = 0; g < 4; ++g) { ssx += A[4 * g] * A[4 * g]; ssy += A[4 * g + 1] * A[4 * g + 1]; ssx += A[4 * g + 2] * A[4 * g + 2]; ssy += A[4 * g + 3] * A[4 * g + 3]; } \
                _Pragma("unroll") for (int g = 0; g < 4; ++g) { dtx += A[4 * g] * q_[g].x; dty += A[4 * g + 1] * q_[g].y; dtx += A[4 * g + 2] * q_[g].z; dty += A[4 * g + 3] * q_[g].w; } } while (0)
#define SA_FIN(kt, RV) do { const float ss_ = xhalf_sum_pl(ssx + ssy), dot_ = xhalf_sum_pl(dtx + dty); sc[kt] = __builtin_amdgcn_rsqf(ss_ * (1.f / 64.f) + EPS) * dot_ + (RV); } while (0)
#define SA_SB() __builtin_amdgcn_sched_barrier(0)
              float rv;
              SA_LOADB(0); SA_ROPE(); SA_MF(a0, 0); SA_SB();
#pragma unroll
              for (int kt = 0; kt < 4; ++kt) {
                  ssx = 0.f; ssy = 0.f; dtx = 0.f; dty = 0.f; rv = r4[0];
                  SA_MF(a1, 1); SA_SB();
                  if (kt < 3) { SA_LOADB(kt + 1); SA_SB(); }
                  SA_RED(a0, 0); SA_SB();
                  if (kt < 3) { SA_ROPE(); SA_MF(a0, 0); SA_SB(); }
                  SA_RED(a1, 1); SA_FIN(kt, rv); SA_SB();
              }
#undef SA_LOADB
#undef SA_ROPE
#undef SA_MF
#undef SA_RED
#undef SA_FIN
#undef SA_SB
            } }
            float mx = half_max32(fmaxf(fmaxf(sc[0], sc[1]), fmaxf(sc[2], sc[3])));
            const float m_new = fmaxf(m_run, mx); const float alpha = __builtin_amdgcn_exp2f(m_run - m_new); m_run = m_new;
            float ps = 0.f;
#pragma unroll
            for (int kt = 0; kt < 4; ++kt) { const float e = __builtin_amdgcn_exp2f(sc[kt] - m_new); ps += e; if (hh == 0) *(LAS bf16*)(S + SA_P + pb * SA_P_BUF + h * 256 + (32 * kt + r32) * 2) = (bf16)f2bf(e); }
            l_run = l_run * alpha + ps;
            if (lane == 0) *(LAS float*)(S + SA_AL + pb * 32 + h * 4) = alpha;
            __syncthreads();
            { const int g4 = lane >> 4, n16 = lane & 15;
              if (g4 < 2) { const f32x4 al = *(const LAS f32x4*)(S + SA_AL + pb * 32 + 16 * g4); ctx = ctx * al; }
#pragma unroll
              for (int ks = 0; ks < 4; ++ks) {
                  bf16x8 af = *(const LAS bf16x8*)(S + SA_P + pb * SA_P_BUF + (n16 & 7) * 256 + (32 * ks + 8 * g4) * 2); if (n16 >= 8) af = bf16x8{};
                  const bf16x8 bfr = *(const LAS bf16x8*)(S + SA_LT + pb * SA_LT_BUF + (16 * h + n16) * LT_PITCH + (32 * ks + 8 * g4) * 2);
                  ctx = mfma16(af, bfr, ctx); } }
        }
#undef SA_PREFETCH
        { const int ln = fresh_lane(); const int g4 = ln >> 4, n16 = ln & 15; float* pu = PART + (size_t)u * PART_STRIDE;
          if (g4 < 2) {
#pragma unroll
              for (int i = 0; i < 4; ++i) pu[(4 * g4 + i) * 132 + 16 * h + n16] = ctx[i]; }
          const float lsum = wave_sum(l_run) * 0.5f;
          if (ln == 0) { pu[h * 132 + 128] = m_run; pu[h * 132 + 129] = lsum; } }
        __syncthreads();
    }
}

typedef int v8i __attribute__((ext_vector_type(8)));
constexpr int L8_PITCH = 144;
constexpr int S8_LK = 0, S8_LK_BUF = 128 * L8_PITCH, S8_LT = 2 * S8_LK_BUF, S8_LT_BUF = 128 * LT_PITCH, S8_KR = S8_LT + 2 * S8_LT_BUF, S8_KR_BUF = 128 * LKR_PITCH,
              S8_DOT = S8_KR + 2 * S8_KR_BUF, S8_ROPE = S8_DOT + 4096, S8_P = S8_ROPE + 4096, S8_AL = S8_P + 2048, S8_QA = S8_AL + 32, S8_QG = S8_QA + 2048, S8_END = S8_QG + 2048;
static_assert(S8_END <= RING_BYTES, "fp8 sample attention LDS");
__device__ __forceinline__ int fp8x4(float a, float b, float c, float d) { int w = 0; w = __builtin_amdgcn_cvt_pk_fp8_f32(a, b, w, false); w = __builtin_amdgcn_cvt_pk_fp8_f32(c, d, w, true); return w; }
__device__ __forceinline__ f32x16 mfma8(v8i a, v8i b, f32x16 c) { return __builtin_amdgcn_mfma_scale_f32_32x32x64_f8f6f4(a, b, c, 0, 0, 0, 127, 0, 127); }
__device__ __forceinline__ void phase_attn_sample8(const Ctx& C, const Params& P) {
    const int lane = C.lane, h = C.wave, tid = C.tid, r32 = lane & 31, hh = lane >> 5;
    const bf16* WUKV = WSP(const bf16, WS_WUKV); const bf16* Q = WSP(const bf16, WS_Q); float* PART = WSP(float, WS_PART);
    const float* cache_lat = P.in[2]; const float* cache_kr = P.in[3]; const int* ptab = (const int*)P.in[7]; const float* gkn = P.in[28];
    LAS unsigned char* S = C.lds + RING_OFF; const unsigned lds0 = (unsigned)(uintptr_t)S;
    v8i wk8[2][2];
#pragma unroll
    for (int rt = 0; rt < 2; ++rt)
#pragma unroll
        for (int ks = 0; ks < 2; ++ks) { const bf16* wp = WUKV + (size_t)(h * 128 + 32 * rt + r32) * 256 + 64 * ks + 32 * hh;
#pragma unroll
            for (int q = 0; q < 4; ++q) { const v4u w = *(const v4u*)(wp + 8 * q); float f[8]; unpack8f(w, f);
                wk8[rt][ks][2 * q] = fp8x4(16.f * f[0], 16.f * f[1], 16.f * f[2], 16.f * f[3]); wk8[rt][ks][2 * q + 1] = fp8x4(16.f * f[4], 16.f * f[5], 16.f * f[6], 16.f * f[7]); } }
    const int kg = tid >> 5, dq = tid & 31;
    for (int u = C.bid; u < 256; u += C.G) {
        const int sq = u >> 1, half = u & 1; const size_t qrow = (size_t)(MP + sq);
        { const int l2 = fresh_lane(); *(LAS float*)(S + S8_QG + h * 256 + l2 * 4) = bf2f(Q[qrow * 768 + h * 96 + l2]) * gkn[l2];
          const int kc = l2 & 15, dg = l2 >> 4; float acc[8] = {0.f, 0.f, 0.f, 0.f, 0.f, 0.f, 0.f, 0.f};
          asm volatile("s_waitcnt lgkmcnt(0)" ::: "memory");
#pragma unroll 4
          for (int i = 0; i < 16; ++i) { const int d = dg + 4 * i; const v4u w = *(const v4u*)(WUKV + (size_t)(h * 128 + d) * 256 + 8 * kc); float f[8]; unpack8f(w, f);
              const float qd = *(const LAS float*)(S + S8_QG + h * 256 + d * 4);
#pragma unroll
              for (int j = 0; j < 8; ++j) acc[j] += f[j] * qd; }
#pragma unroll
          for (int j = 0; j < 8; ++j) { acc[j] += lane_xor16(acc[j], l2); acc[j] += lane_xor32(acc[j], l2); }
          if (dg == 0) *(LAS bf16x8*)(S + S8_QA + h * 256 + kc * 16) = pack8(acc); }
        float m_run = -INFINITY, l_run = 0.f; f32x4 ctx = (f32x4){0.f, 0.f, 0.f, 0.f};
        f32x4 pl[8]; f32x4 pk[2];
        const int pgs = ptab[sq * NPAGES + half * 64 + lane];
#define S8_PREFETCH(pgidx) do { const int pg_ = __builtin_amdgcn_readlane(pgs, (pgidx)); \
          const char* lb_ = (const char*)(cache_lat + (size_t)pg_ * (PAGE * KVLR)); const char* kb_ = (const char*)(cache_kr + (size_t)pg_ * (PAGE * ROPE_D)); \
          const unsigned lo_ = (unsigned)((tid >> 5) * 4096 + (tid & 31) * 16), ko_ = (unsigned)(tid * 16); \
          _Pragma("unroll") for (int i = 0; i < 8; ++i) pl[i] = __builtin_nontemporal_load((const f32x4*)(lb_ + lo_ + i * 512)); \
          pk[0] = __builtin_nontemporal_load((const f32x4*)(kb_ + ko_)); pk[1] = __builtin_nontemporal_load((const f32x4*)(kb_ + 8192 + ko_)); } while (0)
#define S8_STAGE(nb) do { \
          unsigned lo[8], hi2[8]; \
          _Pragma("unroll") for (int i = 0; i < 8; ++i) { lo[i] = pk2(pl[i].x, pl[i].y); hi2[i] = pk2(pl[i].z, pl[i].w); \
              *(LAS int*)(S + S8_LK + (nb) * S8_LK_BUF + (8 * kg + i) * L8_PITCH + dq * 4) = fp8x4(pl[i].x, pl[i].y, pl[i].z, pl[i].w); } \
          v4u w0, w1, w2, w3; \
          _Pragma("unroll") for (int i = 0; i < 4; ++i) { w0[i] = __builtin_amdgcn_perm(lo[2 * i + 1], lo[2 * i], 0x05040100u); w1[i] = __builtin_amdgcn_perm(lo[2 * i + 1], lo[2 * i], 0x07060302u); \
                                            w2[i] = __builtin_amdgcn_perm(hi2[2 * i + 1], hi2[2 * i], 0x05040100u); w3[i] = __builtin_amdgcn_perm(hi2[2 * i + 1], hi2[2 * i], 0x07060302u); } \
          LAS unsigned char* T = S + S8_LT + (nb) * S8_LT_BUF + kg * 16; \
          *(LAS v4u*)(T + (4 * dq + 0) * LT_PITCH) = w0; *(LAS v4u*)(T + (4 * dq + 1) * LT_PITCH) = w1; *(LAS v4u*)(T + (4 * dq + 2) * LT_PITCH) = w2; *(LAS v4u*)(T + (4 * dq + 3) * LT_PITCH) = w3; \
          _Pragma("unroll") for (int i = 0; i < 2; ++i) { const int c = tid + 512 * i, key = c >> 3, part = c & 7; \
              *(LAS v2u*)(S + S8_KR + (nb) * S8_KR_BUF + key * LKR_PITCH + part * 8) = (v2u){pk2(pk[i].x, pk[i].y), pk2(pk[i].z, pk[i].w)}; } } while (0)
#define S8_DOTROPE(nb) do { \
          const int n16_ = lane & 15, g4_ = lane >> 4, q4_ = n16_ >> 2, p4_ = n16_ & 3; \
          f32x4 dacc = (f32x4){0.f, 0.f, 0.f, 0.f}, racc = (f32x4){0.f, 0.f, 0.f, 0.f}; \
          const unsigned tb_ = lds0 + S8_LT + (nb) * S8_LT_BUF + (8 * g4_ + q4_) * LT_PITCH + (16 * h + 4 * p4_) * 2; \
          s16x4 tl_[4], th_[4]; \
          asm volatile("ds_read_b64_tr_b16 %0, %8\n\tds_read_b64_tr_b16 %1, %8 offset:%9\n\tds_read_b64_tr_b16 %2, %8 offset:%10\n\tds_read_b64_tr_b16 %3, %8 offset:%11\n\t" \
                       "ds_read_b64_tr_b16 %4, %8 offset:%12\n\tds_read_b64_tr_b16 %5, %8 offset:%13\n\tds_read_b64_tr_b16 %6, %8 offset:%14\n\tds_read_b64_tr_b16 %7, %8 offset:%15\n\ts_waitcnt lgkmcnt(0)" \
                       : "=&v"(tl_[0]), "=&v"(th_[0]), "=&v"(tl_[1]), "=&v"(th_[1]), "=&v"(tl_[2]), "=&v"(th_[2]), "=&v"(tl_[3]), "=&v"(th_[3]) \
                       : "v"(tb_), "i"(4 * LT_PITCH), "i"(32 * LT_PITCH), "i"(36 * LT_PITCH), "i"(64 * LT_PITCH), "i"(68 * LT_PITCH), "i"(96 * LT_PITCH), "i"(100 * LT_PITCH) : "memory"); \
          _Pragma("unroll") for (int ks = 0; ks < 4; ++ks) dacc = mfma16(qa[ks], __builtin_shufflevector(tl_[ks], th_[ks], 0, 1, 2, 3, 4, 5, 6, 7), dacc); \
          { const bf16x8 kb_ = *(const LAS bf16x8*)(S + S8_KR + (nb) * S8_KR_BUF + (16 * h + n16_) * LKR_PITCH + g4_ * 16); racc = mfma16(qr, kb_, racc); } \
          if (g4_ < 2) { _Pragma("unroll") for (int i = 0; i < 4; ++i) { *(LAS float*)(S + S8_DOT + ((4 * g4_ + i) * 128 + 16 * h + n16_) * 4) = dacc[i]; *(LAS float*)(S + S8_ROPE + ((4 * g4_ + i) * 128 + 16 * h + n16_) * 4) = racc[i]; } } } while (0)
        S8_PREFETCH(0);
        __syncthreads();
        bf16x8 qa[4], qr;
        { const int n16 = lane & 15, g4 = lane >> 4;
#pragma unroll
          for (int ks = 0; ks < 4; ++ks) { bf16x8 f = *(const LAS bf16x8*)(S + S8_QA + (n16 & 7) * 256 + (32 * ks + 8 * g4) * 2); if (n16 >= 8) f = bf16x8{}; qa[ks] = f; }
          qr = bf16x8{}; if (n16 < 8) qr = *(const bf16x8*)(Q + qrow * 768 + n16 * 96 + 64 + 8 * g4); }
        S8_STAGE(0); S8_PREFETCH(1);
        __syncthreads();
        S8_DOTROPE(0);
#pragma unroll 1
        for (int pgi = 0; pgi < 64; ++pgi) {
            const int pb = pgi & 1;
            __syncthreads();
            float sc[4];
            { v8i bA0, bA1, bB0, bB1; f32x16 xa0, xa1, ya0, ya1; float dvA, rvA, dvB, rvB;
#define S8_LOADB(kt, B0, B1, DV, RV) do { const LAS unsigned char* bp_ = S + S8_LK + pb * S8_LK_BUF + (32 * (kt) + r32) * L8_PITCH + 32 * hh; \
                const v4u b00_ = *(const LAS v4u*)bp_, b01_ = *(const LAS v4u*)(bp_ + 16), b10_ = *(const LAS v4u*)(bp_ + 64), b11_ = *(const LAS v4u*)(bp_ + 80); \
                DV = *(const LAS float*)(S + S8_DOT + (h * 128 + 32 * (kt) + r32) * 4); RV = *(const LAS float*)(S + S8_ROPE + (h * 128 + 32 * (kt) + r32) * 4); \
                B0 = (v8i){(int)b00_.x, (int)b00_.y, (int)b00_.z, (int)b00_.w, (int)b01_.x, (int)b01_.y, (int)b01_.z, (int)b01_.w}; \
                B1 = (v8i){(int)b10_.x, (int)b10_.y, (int)b10_.z, (int)b10_.w, (int)b11_.x, (int)b11_.y, (int)b11_.z, (int)b11_.w}; } while (0)
#define S8_MF(B0, B1, A0, A1) do { A0 = f32x16{}; A1 = f32x16{}; A0 = mfma8(wk8[0][0], B0, A0); A1 = mfma8(wk8[1][0], B0, A1); A0 = mfma8(wk8[0][1], B1, A0); A1 = mfma8(wk8[1][1], B1, A1); } while (0)
#define S8_RED(kt, A0, A1, DV, RV) do { float sx_ = 0.f, sy_ = 0.f; \
                _Pragma("unroll") for (int r = 0; r < 16; r += 2) { sx_ += A0[r] * A0[r]; sy_ += A0[r + 1] * A0[r + 1]; sx_ += A1[r] * A1[r]; sy_ += A1[r + 1] * A1[r + 1]; } \
                const float ss_ = xhalf_sum_pl(sx_ + sy_); sc[kt] = __builtin_amdgcn_rsqf(ss_ * (1.f / (64.f * 256.f)) + EPS) * (DV) + (RV); } while (0)
#define S8_SB() __builtin_amdgcn_sched_barrier(0)
              S8_LOADB(0, bA0, bA1, dvA, rvA); S8_LOADB(1, bB0, bB1, dvB, rvB); S8_MF(bA0, bA1, xa0, xa1); S8_SB();
              { const float d0 = dvA, r0 = rvA; S8_MF(bB0, bB1, ya0, ya1); S8_LOADB(2, bA0, bA1, dvA, rvA); S8_RED(0, xa0, xa1, d0, r0); S8_SB(); }
              { const float d1 = dvB, r1 = rvB; S8_MF(bA0, bA1, xa0, xa1); S8_LOADB(3, bB0, bB1, dvB, rvB); S8_RED(1, ya0, ya1, d1, r1); S8_SB(); }
              S8_MF(bB0, bB1, ya0, ya1); S8_RED(2, xa0, xa1, dvA, rvA); S8_SB();
              S8_RED(3, ya0, ya1, dvB, rvB);
#undef S8_LOADB
#undef S8_MF
#undef S8_RED
#undef S8_SB
            }
            float mx = half_max32(fmaxf(fmaxf(sc[0], sc[1]), fmaxf(sc[2], sc[3])));
            const float m_new = fmaxf(m_run, mx); const float alpha = __builtin_amdgcn_exp2f(m_run - m_new); m_run = m_new;
            float ps = 0.f;
#pragma unroll
            for (int kt = 0; kt < 4; ++kt) { const float e = __builtin_amdgcn_exp2f(sc[kt] - m_new); ps += e; if (hh == 0) *(LAS bf16*)(S + S8_P + h * 256 + (32 * kt + r32) * 2) = (bf16)f2bf(e); }
            l_run = l_run * alpha + ps;
            if (lane == 0) *(LAS float*)(S + S8_AL + h * 4) = alpha;
            if (pgi + 1 < 64) { S8_STAGE(pb ^ 1); if (pgi + 2 < 64) S8_PREFETCH(pgi + 2); }
            __syncthreads();
            { const int g4 = lane >> 4, n16 = lane & 15;
              const f32x4 al = *(const LAS f32x4*)(S + S8_AL + 16 * (g4 & 1));
              bf16x8 af[4], bfr[4];
#pragma unroll
              for (int ks = 0; ks < 4; ++ks) { af[ks] = *(const LAS bf16x8*)(S + S8_P + (n16 & 7) * 256 + (32 * ks + 8 * g4) * 2);
                  bfr[ks] = *(const LAS bf16x8*)(S + S8_LT + pb * S8_LT_BUF + (16 * h + n16) * LT_PITCH + (32 * ks + 8 * g4) * 2); }
              if (g4 < 2) ctx = ctx * al;
#pragma unroll
              for (int ks = 0; ks < 4; ++ks) { if (n16 >= 8) af[ks] = bf16x8{}; ctx = mfma16(af[ks], bfr[ks], ctx); } }
            if (pgi + 1 < 64) S8_DOTROPE(pb ^ 1);
        }
#undef S8_PREFETCH
#undef S8_STAGE
#undef S8_DOTROPE
        { const int ln = fresh_lane(); const int g4 = ln >> 4, n16 = ln & 15; float* pu = PART + (size_t)u * PART_STRIDE;
          if (g4 < 2) {
#pragma unroll
              for (int i = 0; i < 4; ++i) pu[(4 * g4 + i) * 132 + 16 * h + n16] = ctx[i]; }
          const float lsum = wave_sum(l_run) * 0.5f;
          if (ln == 0) { pu[h * 132 + 128] = m_run; pu[h * 132 + 129] = lsum; } }
        __syncthreads();
    }
}

__device__ __forceinline__ void phase_sample_combine(const Ctx& C, const Params& P) {
    const int gw = C.bid * NWAVES + C.wave, NGW = C.G * NWAVES, lane = C.lane;
    const float* PART = WSP(const float, WS_PART); const bf16* Q = WSP(const bf16, WS_Q); const bf16* KF = WSP(const bf16, WS_KF); const bf16* KVRAW = WSP(const bf16, WS_KVRAW);
    bf16* ATT = WSP(bf16, WS_ATT); const float* wukv = P.in[27];
    for (int it = gw; it < MS * NHEAD; it += NGW) {
        const int sq = it >> 3, h = it & 7; const size_t row = (size_t)(MP + sq);
        const float* p0 = PART + (size_t)(2 * sq) * PART_STRIDE + h * 132; const float* p1 = p0 + PART_STRIDE;
        float sn = 0.f; if (lane < 48) { const unsigned qa = *(const unsigned*)(Q + row * 768 + h * 96 + 2 * lane), ka = *(const unsigned*)(KF + row * 768 + h * 96 + 2 * lane); sn = bflo(qa) * bflo(ka) + bfhi(qa) * bfhi(ka); }
        sn = wave_sum(sn);
        const float m0 = p0[128], l0 = p0[129], m1 = p1[128], l1 = p1[129];
        const float M = fmaxf(fmaxf(m0, m1), sn); const float w0 = exp2f(m0 - M), w1 = exp2f(m1 - M), wn = exp2f(sn - M);
        const float Lt = l0 * w0 + l1 * w1 + wn;
        const float c_lo = p0[lane] * w0 + p1[lane] * w1, c_hi = p0[64 + lane] * w0 + p1[64 + lane] * w1;
        float acc = 0.f; const float* wv = wukv + h * 128 + 64 + lane;
#pragma unroll
        for (int k = 0; k < 64; ++k) { acc += __builtin_bit_cast(float, __builtin_amdgcn_readlane(__builtin_bit_cast(int, c_lo), k)) * wv[(size_t)k * 1024];
                                       acc += __builtin_bit_cast(float, __builtin_amdgcn_readlane(__builtin_bit_cast(int, c_hi), k)) * wv[(size_t)(64 + k) * 1024]; }
        const float outv = (acc + wn * bf2f(KVRAW[row * 1024 + h * 128 + 64 + lane])) / Lt;
        ATT[row * 512 + h * 64 + lane] = (bf16)f2bf(outv);
    }
}

__device__ __forceinline__ void phase_mix(const Ctx& C, const Params& P) {
    const int gw = C.bid * NWAVES + C.wave, NGW = C.G * NWAVES, lane = C.lane;
    const bf16* Z = WSP(const bf16, WS_Z); const bf16* HL = WSP(const bf16, WS_HL); const bf16* AC = WSP(const bf16, WS_AC); const bf16* ATT = WSP(const bf16, WS_ATT);
    const float* CAR = WSP(const float, WS_CARRY); bf16* MIX = WSP(bf16, WS_MIX);
    const int c = 8 * lane;
    float glo[8], gmo[8];
#pragma unroll
    for (int j = 0; j < 8; ++j) { glo[j] = P.in[29][c + j]; gmo[j] = P.in[30][c + j]; }
    for (int r0 = gw; r0 < MREAL; r0 += 2 * NGW) {
        v4u wh[2], wa[2], wg[2], wt[2]; f32x4 c0[2], c1[2]; int rr[2];
#pragma unroll
        for (int u = 0; u < 2; ++u) { const int r = (r0 + u * NGW < MREAL) ? r0 + u * NGW : r0; rr[u] = r;
            wh[u] = *(const v4u*)(HL + (size_t)r * 512 + c); wa[u] = *(const v4u*)(AC + (size_t)r * 512 + c); wg[u] = *(const v4u*)(Z + (size_t)r * ZC + 512 + c); wt[u] = *(const v4u*)(ATT + (size_t)r * 512 + c);
            c0[u] = (f32x4){0.f, 0.f, 0.f, 0.f}; c1[u] = c0[u];
            if (r < MP) { const float* cp = CAR + ((size_t)(r >> 11) * 32 + ((r & 2047) >> 6)) * 512 + c; c0[u] = *(const f32x4*)cp; c1[u] = *(const f32x4*)(cp + 4); } }
#pragma unroll
        for (int u = 0; u < 2; ++u) { const int r = rr[u];
            float hv[8], av[8], gv[8], tv[8]; unpack8f(wh[u], hv); unpack8f(wa[u], av); unpack8f(wg[u], gv); unpack8f(wt[u], tv);
            const float cin[8] = {c0[u].x, c0[u].y, c0[u].z, c0[u].w, c1[u].x, c1[u].y, c1[u].z, c1[u].w};
            float ss = 0.f, s2 = 0.f;
#pragma unroll
            for (int j = 0; j < 8; ++j) { hv[j] = (hv[j] + av[j] * cin[j]) * gelu_tanh(gv[j]); ss += hv[j] * hv[j]; s2 += tv[j] * tv[j]; }
            const float rstd = rsqrtf(wave_sum(ss) * (1.f / 512.f) + EPS), rs2 = rsqrtf(wave_sum(s2) * (1.f / 512.f) + EPS);
#pragma unroll
            for (int j = 0; j < 8; ++j) { hv[j] = hv[j] * rstd * glo[j]; tv[j] = tv[j] * rs2 * gmo[j]; }
            *(bf16x8*)(MIX + (size_t)r * 1024 + c) = pack8(hv); *(bf16x8*)(MIX + (size_t)r * 1024 + 512 + c) = pack8(tv);
        }
    }
}

__device__ __forceinline__ void unpack8(const v4u& w, float* v) { v[0] = bflo(w.x); v[1] = bfhi(w.x); v[2] = bflo(w.y); v[3] = bfhi(w.y); v[4] = bflo(w.z); v[5] = bfhi(w.z); v[6] = bflo(w.w); v[7] = bfhi(w.w); }
__device__ __forceinline__ void phase_ffn_fixup(const Ctx& C, const Params& P) {
    const float* RAW = WSP(const float, WS_RAW); const bf16* UP = WSP(const bf16, WS_UP); bf16* ACT = WSP(bf16, WS_ACT); const float* fw = P.in[34]; const float* fb = P.in[35];
    const int gt = C.bid * 512 + C.tid, NGT = C.G * 512;
    for (int idx = gt; idx < 256 * 704; idx += NGT) {
        const int blk = idx / 704, c = 4 * (idx - blk * 704);
        if ((blk & 15) == 0) continue;
        const float* r0 = RAW + (size_t)(blk - 1) * 4 * UPC; const float* r1 = RAW + (size_t)blk * 4 * UPC;
        const f32x4 wv0 = *(const f32x4*)(fw + c), wv1 = *(const f32x4*)(fw + UPC + c), wv2 = *(const f32x4*)(fw + 2 * UPC + c), bv = *(const f32x4*)(fb + c);
        const f32x4 wg0 = *(const f32x4*)(fw + DFF + c), wg1 = *(const f32x4*)(fw + UPC + DFF + c), wg2 = *(const f32x4*)(fw + 2 * UPC + DFF + c), bg = *(const f32x4*)(fb + DFF + c);
        const f32x4 vm2 = *(const f32x4*)(r0 + c), vm1 = *(const f32x4*)(r0 + UPC + c), v0 = *(const f32x4*)(r1 + 2 * UPC + c), v1 = *(const f32x4*)(r1 + 3 * UPC + c);
        const f32x4 gm2 = *(const f32x4*)(r0 + DFF + c), gm1 = *(const f32x4*)(r0 + UPC + DFF + c), g0 = *(const f32x4*)(r1 + 2 * UPC + DFF + c), g1 = *(const f32x4*)(r1 + 3 * UPC + DFF + c);
        const f32x4 va = bv + wv0 * vm2 + wv1 * vm1 + wv2 * v0, ga = bg + wg0 * gm2 + wg1 * gm1 + wg2 * g0;
        const f32x4 vb = bv + wv0 * vm1 + wv1 * v0 + wv2 * v1, gb = bg + wg0 * gm1 + wg1 * g0 + wg2 * g1;
        v2u oa, ob; oa.x = pk2(gelu_tanh(ga.x) * va.x, gelu_tanh(ga.y) * va.y); oa.y = pk2(gelu_tanh(ga.z) * va.z, gelu_tanh(ga.w) * va.w);
        ob.x = pk2(gelu_tanh(gb.x) * vb.x, gelu_tanh(gb.y) * vb.y); ob.y = pk2(gelu_tanh(gb.z) * vb.z, gelu_tanh(gb.w) * vb.w);
        *(v2u*)(ACT + (size_t)(blk * 128) * DFF + c) = oa; *(v2u*)(ACT + (size_t)(blk * 128 + 1) * DFF + c) = ob;
    }
    for (int idx = gt; idx < NBATCH * 2 * (UPC / 4); idx += NGT) { const int b = idx / (2 * (UPC / 4)), rem = idx - b * (2 * (UPC / 4)), s = rem / (UPC / 4), c = 4 * (rem - s * (UPC / 4));
        *(f32x4*)(P.out + O_FCP + ((size_t)b * 2 + s) * UPC + c) = *(const f32x4*)(RAW + ((size_t)(16 * b + 15) * 4 + s) * UPC + c); }
    for (int idx = gt; idx < MS * 352; idx += NGT) {
        const int s_ = idx / 352, c = 8 * (idx - s_ * 352); const int r = MP + s_;
        float v0[8], g0[8]; unpack8(*(const v4u*)(UP + (size_t)r * UPC + c), v0); unpack8(*(const v4u*)(UP + (size_t)r * UPC + DFF + c), g0);
        const float* st = P.in[6] + (size_t)s_ * 2 * UPC; float* d = P.out + O_FCS + (size_t)s_ * 2 * UPC;
        float o[8];
#pragma unroll
        for (int q = 0; q < 2; ++q) { const int cc = c + 4 * q;
            const f32x4 v2 = *(const f32x4*)(st + cc), g2 = *(const f32x4*)(st + DFF + cc), v1 = *(const f32x4*)(st + UPC + cc), g1 = *(const f32x4*)(st + UPC + DFF + cc);
            const f32x4 vv = (f32x4){v0[4 * q], v0[4 * q + 1], v0[4 * q + 2], v0[4 * q + 3]}, gg = (f32x4){g0[4 * q], g0[4 * q + 1], g0[4 * q + 2], g0[4 * q + 3]};
            *(f32x4*)(d + cc) = v1; *(f32x4*)(d + DFF + cc) = g1; *(f32x4*)(d + UPC + cc) = vv; *(f32x4*)(d + UPC + DFF + cc) = gg;
            const f32x4 val = *(const f32x4*)(fb + cc) + *(const f32x4*)(fw + cc) * v2 + *(const f32x4*)(fw + UPC + cc) * v1 + *(const f32x4*)(fw + 2 * UPC + cc) * vv;
            const f32x4 gt_ = *(const f32x4*)(fb + DFF + cc) + *(const f32x4*)(fw + DFF + cc) * g2 + *(const f32x4*)(fw + UPC + DFF + cc) * g1 + *(const f32x4*)(fw + 2 * UPC + DFF + cc) * gg;
#pragma unroll
            for (int e = 0; e < 4; ++e) o[4 * q + e] = gelu_tanh(gt_[e]) * val[e]; }
        *(bf16x8*)(ACT + (size_t)r * DFF + c) = pack8(o);
    }
}

__device__ __forceinline__ void phase_stream_probe(const Ctx& C, const Params& P) {
    const float* cache_lat = P.in[2]; const float* cache_kr = P.in[3]; const int* ptab = (const int*)P.in[7]; const int tid = C.tid, lane = C.lane;
    float accum = 0.f;
    for (int u = C.bid; u < 256; u += C.G) {
        const int sq = u >> 1, half = u & 1;
        const int pgs = ptab[sq * NPAGES + half * 64 + lane];
        f32x4 pl[8], pk[2];
#define PR_PREFETCH(pgidx) do { const int pg_ = __builtin_amdgcn_readlane(pgs, (pgidx)); \
          const char* lb_ = (const char*)(cache_lat + (size_t)pg_ * (PAGE * KVLR)); const char* kb_ = (const char*)(cache_kr + (size_t)pg_ * (PAGE * ROPE_D)); \
          const unsigned lo_ = (unsigned)((tid >> 5) * 4096 + (tid & 31) * 16), ko_ = (unsigned)(tid * 16); \
          _Pragma("unroll") for (int i = 0; i < 8; ++i) pl[i] = __builtin_nontemporal_load((const f32x4*)(lb_ + lo_ + i * 512)); \
          pk[0] = __builtin_nontemporal_load((const f32x4*)(kb_ + ko_)); pk[1] = __builtin_nontemporal_load((const f32x4*)(kb_ + 8192 + ko_)); } while (0)
        PR_PREFETCH(0);
#pragma unroll 1
        for (int pgi = 0; pgi < 64; ++pgi) {
            float s = 0.f;
#pragma unroll
            for (int i = 0; i < 8; ++i) s += (pl[i].x + pl[i].y) + (pl[i].z + pl[i].w);
            s += pk[0].x + pk[1].y;
            if (pgi + 1 < 64) PR_PREFETCH(pgi + 1);
            accum += s;
        }
#undef PR_PREFETCH
    }
    WSP(float, WS_END)[C.bid * 512 + tid] = accum;
}
#ifndef SA_FP8
#define SA_FP8 1
#endif

constexpr int N_LAUNCHES = MK_N_LAUNCHES;
constexpr int N_PHASES = 16;
template <int PHASE_MASK> __global__ void __launch_bounds__(NWAVES * 64, 2) mk_fwd(Params P) {
    extern __shared__ __attribute__((aligned(16))) unsigned char lds[];
    Ctx C0; C0.lds = (LAS unsigned char*)lds; C0.tid = threadIdx.x; C0.lane = C0.tid & 63; C0.wave = __builtin_amdgcn_readfirstlane(C0.tid >> 6); C0.G = gridDim.x; C0.bid = blockIdx.x; C0.p = nullptr;
    const Ctx& C = C0;
    volatile LAS unsigned* MISC = (volatile LAS unsigned*)(C.lds + MISC_OFF);
    for (int u = C.tid; u < (LDS_BYTES - LDSCTL_OFF) / 4; u += NWAVES * 64) ((LAS unsigned*)(C.lds + LDSCTL_OFF))[u] = 0u;
    __syncthreads();
    gu32* ctl = (gu32*)(P.ws + WS_CTL);
    XcdBarrier bar; bar.bar = (unsigned*)(ctl + CW_BAR); bar.x = 0; bar.st = nullptr;
    if (N_LAUNCHES == 1) bar = xcd_barrier_post((unsigned*)(ctl + CW_BAR), MISC + 8, C0.tid);
    const int lo = P.ph_lo, hi = P.ph_hi;
#define IN(k) (((PHASE_MASK >> (k)) & 1) && lo <= (k) && (k) < hi)
#ifndef EXTRA_BARRIERS
#define EXTRA_BARRIERS 0
#endif
#define SEAM(k) do { if (IN(k) && IN((k) + 1)) { PHASE_CTX(); xcd_barrier(bar, C.tid); for (int xb_ = 0; xb_ < EXTRA_BARRIERS; ++xb_) xcd_barrier(bar, C.tid); } } while (0)
#ifndef REPEAT_MASK
#define REPEAT_MASK 0
#endif
#define NREP(k) (((REPEAT_MASK >> (k)) & 1) ? 2 : 1)
#define PHASE_CTX() Ctx C = C0; asm volatile("v_mbcnt_lo_u32_b32 %0, -1, 0\n\tv_mbcnt_hi_u32_b32 %0, -1, %0" : "=v"(C.lane)); C.tid = C0.wave * 64 + C.lane

    if (IN(0)) for (int rep_ = 0; rep_ < NREP(0); ++rep_) { PHASE_CTX(); phase_p0a(C, P); } SEAM(0);
    if (IN(1)) for (int rep_ = 0; rep_ < NREP(1); ++rep_) { PHASE_CTX(); phase_p0b(C, P); } SEAM(1);
    if (IN(2)) for (int rep_ = 0; rep_ < NREP(2); ++rep_) { PHASE_CTX();
        { EpiSB Es{WSP(float, WS_SB)}; skinny_gemm_splitk<8>(C, WSP(const bf16, WS_SH2), 1024, WSP(const bf16, WS_WUP), 1024, 9, UPC / 128, 1024, Es); }
        phase_norm_mod<false>(C, P); } SEAM(2);
    if (IN(3)) for (int rep_ = 0; rep_ < NREP(3); ++rep_) { PHASE_CTX();
        { EpiSkBf16 Es{WSP(bf16, WS_Z), ZC}; skinny_gemm_splitk<2>(C, WSP(const bf16, WS_H1) + (size_t)MP * 1024, 1024, WSP(const bf16, WS_WIN), 1024, 8, ZC / 32, 1024, Es); }
        pg8::Gemm g{WSP(const pg8::bf16_t, WS_H1), WSP(const pg8::bf16_t, WS_WIN), MP, ZC, 1024}; pg8::StaticOrder S; S.init(MP, ZC, C.G, C.bid);
        pg8::EpiBf16<0> E{WSP(pg8::bf16_t, WS_Z), ZC, nullptr, 0, 0, 1.f};
        pg8::gemm_phase<pg8::EpiBf16<0>, pg8::StaticOrder, true, true>(C.lds + RING_OFF, g, S, E, C.tid);
    } SEAM(3);
    if (IN(4)) for (int rep_ = 0; rep_ < NREP(4); ++rep_) { PHASE_CTX(); phase_p3a(C, P); phase_p3b<false>(C, P); } SEAM(4);
    if (IN(5)) for (int rep_ = 0; rep_ < NREP(5); ++rep_) { PHASE_CTX();
        { EpiSkBf16 Es{WSP(bf16, WS_QRAW), 768}; skinny_gemm<2>(C, WSP(const bf16, WS_QN) + (size_t)MP * 256, 256, WSP(const bf16, WS_WUQ), 256, 8, 768 / 32, 256, Es); }
        { EpiSkBf16 Es{WSP(bf16, WS_KVRAW), 1024}; skinny_gemm<2>(C, WSP(const bf16, WS_KVN) + (size_t)MP * 256, 256, WSP(const bf16, WS_WUKV), 256, 8, 1024 / 32, 128, Es); }
        pg8::Gemm g{WSP(const pg8::bf16_t, WS_QN), WSP(const pg8::bf16_t, WS_WUQ), MP, 768, 256}; pg8::StaticOrder S; S.init(MP, 768, C.G, C.bid);
        pg8::EpiBf16<0> E{WSP(pg8::bf16_t, WS_QRAW), 768, nullptr, 0, 0, 1.f};
        pg8::gemm_phase<pg8::EpiBf16<0>, pg8::StaticOrder, true, true>(C.lds + RING_OFF, g, S, E, C.tid);
        { Ctx C2 = C; C2.bid = (C.bid + 4) % C.G; if (C2.bid < 4) phase_p3b<true>(C2, P); }
    }
    if (IN(6)) for (int rep_ = 0; rep_ < NREP(6); ++rep_) { PHASE_CTX();
        pg8::Gemm g{WSP(const pg8::bf16_t, WS_KVN), WSP(const pg8::bf16_t, WS_WUKV), MP, 1024, 256}; pg8::StaticOrder S; S.init(MP, 1024, C.G, C.bid);
        pg8::EpiBf16<0> E{WSP(pg8::bf16_t, WS_KVRAW), 1024, nullptr, 0, 0, 1.f};
        pg8::gemm_phase<pg8::EpiBf16<0>, pg8::StaticOrder, true, true>(C.lds + RING_OFF, g, S, E, C.tid);
    } SEAM(6);
    if (IN(7)) for (int rep_ = 0; rep_ < NREP(7); ++rep_) { PHASE_CTX(); phase_p5(C, P); } SEAM(7);
    if (IN(8)) { { PHASE_CTX(); phase_carry(C, P); } for (int rep_ = 0; rep_ < NREP(16); ++rep_) { PHASE_CTX();
#if SA_FP8
            phase_attn_sample8(C, P);
#else
            phase_attn_sample(C, P);
#endif
        } if ((REPEAT_MASK >> 18) & 1) { PHASE_CTX(); phase_stream_probe(C, P); } for (int rep_ = 0; rep_ < NREP(17); ++rep_) { PHASE_CTX(); phase_attn_prompt(C, P); } } SEAM(8);
    if (IN(9)) for (int rep_ = 0; rep_ < NREP(9); ++rep_) { PHASE_CTX(); phase_sample_combine(C, P); } SEAM(9);
    if (IN(10)) for (int rep_ = 0; rep_ < NREP(10); ++rep_) { PHASE_CTX(); phase_mix(C, P); } SEAM(10);
    if (IN(11)) for (int rep_ = 0; rep_ < NREP(11); ++rep_) { PHASE_CTX();
        { EpiSkResGate<false, true, true> Es{P.in[1], WSP(bf16, WS_X1) + (size_t)MP * 1024, WSP(const float, WS_MOD), 2048, WSP(bf16, WS_H1) + (size_t)MP * 1024, P.in[32], WSP(float, WS_ROWSS) + MP}; skinny_gemm_splitk<2>(C, WSP(const bf16, WS_MIX) + (size_t)MP * 1024, 1024, WSP(const bf16, WS_WO), 1024, 8, 1024 / 32, 1024, Es); }
        pg8::Gemm g{WSP(const pg8::bf16_t, WS_MIX), WSP(const pg8::bf16_t, WS_WO), MP, 1024, 1024}; pg8::StaticOrder S; S.init(MP, 1024, C.G, C.bid);
        pg8::EpiResGate<false, true, true> E{P.in[0], WSP(bf16, WS_X1), WSP(const float, WS_MOD), 2048, WSP(pg8::bf16_t, WS_H1), P.in[32], WSP(float, WS_ROWSS)};
        pg8::gemm_phase<pg8::EpiResGate<false, true, true>, pg8::StaticOrder, true, true>(C.lds + RING_OFF, g, S, E, C.tid);
        if ((REPEAT_MASK >> 21) & 1) { pg8::EpiNull<false> En; pg8::gemm_phase<pg8::EpiNull<false>, pg8::StaticOrder, true, true>(C.lds + RING_OFF, g, S, En, C.tid); }
    } SEAM(11);
    if (IN(13)) for (int rep_ = 0; rep_ < NREP(13); ++rep_) { PHASE_CTX();
        { EpiSkUp Es{WSP(bf16, WS_UP), WSP(const float, WS_ROWSS), WSP(const float, WS_SB)}; skinny_gemm_splitk<8>(C, WSP(const bf16, WS_H1) + (size_t)MP * 1024, 1024, WSP(const bf16, WS_WUP), 1024, 8, UPC / 128, 1024, Es); }
        pg8::Gemm g{WSP(const pg8::bf16_t, WS_H1), WSP(const pg8::bf16_t, WS_WUP), MP, UPC, 1024}; pg8::StaticOrder S; S.init(MP, UPC, C.G, C.bid);
        pg8::EpiConvGelu E{WSP(pg8::bf16_t, WS_ACT), WSP(float, WS_RAW), P.in[34], P.in[35], WSP(const float, WS_ROWSS), WSP(const float, WS_SB)};
        pg8::gemm_phase<pg8::EpiConvGelu, pg8::StaticOrder, true, true>(C.lds + RING_OFF, g, S, E, C.tid);
    } SEAM(13);
    if (IN(14)) for (int rep_ = 0; rep_ < NREP(14); ++rep_) { PHASE_CTX(); phase_ffn_fixup(C, P); }
    if (((REPEAT_MASK >> 20) & 1) && IN(14)) { PHASE_CTX(); pg8::Gemm g{WSP(const pg8::bf16_t, WS_H1), WSP(const pg8::bf16_t, WS_WUP), MP, UPC, 1024}; pg8::StaticOrder S; S.init(MP, UPC, C.G, C.bid);
        pg8::EpiNull<true> En; pg8::gemm_phase<pg8::EpiNull<true>, pg8::StaticOrder, true, true>(C.lds + RING_OFF, g, S, En, C.tid); }
    SEAM(14);
    if (IN(15)) for (int rep_ = 0; rep_ < NREP(15); ++rep_) { PHASE_CTX();
        { EpiSkResGate<true, false, false> Es{WSP(const bf16, WS_X1) + (size_t)MP * 1024, P.out + (size_t)MP * 1024, WSP(const float, WS_MOD), 5120, nullptr, nullptr, nullptr}; skinny_gemm_splitk<2>(C, WSP(const bf16, WS_ACT) + (size_t)MP * DFF, DFF, WSP(const bf16, WS_WDN), DFF, 8, 1024 / 32, DFF, Es);
          if ((REPEAT_MASK >> 26) & 1) skinny_gemm_splitk<2>(C, WSP(const bf16, WS_ACT) + (size_t)MP * DFF, DFF, WSP(const bf16, WS_WDN), DFF, 8, 1024 / 32, DFF, Es); }
        pg8::Gemm g{WSP(const pg8::bf16_t, WS_ACT), WSP(const pg8::bf16_t, WS_WDN), MP, 1024, DFF}; pg8::StaticOrder S; S.init(MP, 1024, C.G, C.bid);
        pg8::EpiResGate<true, false, false> E{WSP(const bf16, WS_X1), P.out, WSP(const float, WS_MOD), 5120, nullptr, nullptr, nullptr};
        pg8::gemm_phase<pg8::EpiResGate<true, false, false>, pg8::StaticOrder, true, true>(C.lds + RING_OFF, g, S, E, C.tid);
        if ((REPEAT_MASK >> 22) & 1) { pg8::EpiProbe<0> En{(float*)(P.ws + WS_UP + 64 * MiB), nullptr}; pg8::gemm_phase<pg8::EpiProbe<0>, pg8::StaticOrder, true, true>(C.lds + RING_OFF, g, S, En, C.tid); }
        if ((REPEAT_MASK >> 23) & 1) { pg8::EpiProbe<1> En{nullptr, WSP(const pg8::bf16_t, WS_X1)}; pg8::gemm_phase<pg8::EpiProbe<1>, pg8::StaticOrder, true, true>(C.lds + RING_OFF, g, S, En, C.tid); }
        if ((REPEAT_MASK >> 24) & 1) { pg8::EpiProbe<2> En{(float*)(P.ws + WS_UP + 64 * MiB), nullptr}; pg8::gemm_phase<pg8::EpiProbe<2>, pg8::StaticOrder, true, true>(C.lds + RING_OFF, g, S, En, C.tid); }
        if ((REPEAT_MASK >> 25) & 1) { pg8::EpiResGate<true, false, false> En{WSP(const bf16, WS_X1), (float*)(P.ws + WS_UP + 64 * MiB), WSP(const float, WS_MOD), 5120, nullptr, nullptr, nullptr}; pg8::gemm_phase<pg8::EpiResGate<true, false, false>, pg8::StaticOrder, true, true>(C.lds + RING_OFF, g, S, En, C.tid); }
        if ((REPEAT_MASK >> 19) & 1) { pg8::EpiNull<false> En; pg8::gemm_phase<pg8::EpiNull<false>, pg8::StaticOrder, true, true>(C.lds + RING_OFF, g, S, En, C.tid); }
    }
#undef IN
#undef SEAM
}

typedef void (*KernFn)(Params);
template <int... I> struct Seq {};
static KernFn phase_kernel(int k) {
    if constexpr (N_LAUNCHES == 1) { return mk_fwd<0xffff>; }
    else {
        switch (k) {
#define PK(i) case i: return mk_fwd<(1 << i)>;
            PK(0) PK(1) PK(2) PK(3) PK(4) PK(5) PK(6) PK(7) PK(8) PK(9) PK(10) PK(11) PK(12) PK(13) PK(14) PK(15)
#undef PK
            default: return nullptr;
        }
    }
}
extern "C" void kernel_launch(void* const* d_in, const int* in_sizes, int n_in, void* d_out, int out_size, void* d_ws, size_t ws_size, hipStream_t stream) {
    static int grid = 0;
    static KernFn fns[N_PHASES];
    if (grid == 0) {
        if (n_in != 37 || out_size != (int)O_END || ws_size < WS_END + 4 * MiB) { fprintf(stderr, "kernel_launch: unexpected shapes: n_in %d out %d ws %zu\n", n_in, out_size, ws_size); grid = -1; return; }
        int dev = 0, cus = 0, per_cu = 0;
        if (hipGetDevice(&dev) != hipSuccess || hipDeviceGetAttribute(&cus, hipDeviceAttributeMultiprocessorCount, dev) != hipSuccess) { grid = -1; return; }
        for (int li = 0; li < N_LAUNCHES; ++li) {
            fns[li] = (N_LAUNCHES == 1) ? phase_kernel(99) : phase_kernel(li);
            if (hipFuncSetAttribute((const void*)fns[li], hipFuncAttributeMaxDynamicSharedMemorySize, LDS_BYTES) != hipSuccess) { fprintf(stderr, "kernel_launch: hipFuncSetAttribute failed\n"); grid = -1; return; }
            if (hipOccupancyMaxActiveBlocksPerMultiprocessor(&per_cu, (const void*)fns[li], NWAVES * 64, LDS_BYTES) != hipSuccess || per_cu < 1) { fprintf(stderr, "kernel_launch: occupancy query says %d for launch %d\n", per_cu, li); }
        }
        (void)hipGetLastError();
        grid = cus;
    }
    if (grid < 0) return;
    if (hipMemsetAsync((char*)d_ws + WS_CTL, 0, CTL_ZERO_BYTES, stream) != hipSuccess) return;
    Params p{};
    for (int i = 0; i < 37; ++i) p.in[i] = (const float*)d_in[i];
    p.out = (float*)d_out; p.ws = (unsigned char*)d_ws;
    for (int li = 0; li < N_LAUNCHES; ++li) {
        if (N_LAUNCHES == 1) { p.ph_lo = 0; p.ph_hi = N_PHASES; } else { p.ph_lo = li; p.ph_hi = li + 1; }
        hipLaunchKernelGGL(fns[li], dim3(grid), dim3(NWAVES * 64), LDS_BYTES, stream, p);
        const hipError_t le = hipPeekAtLastError();
        if (le != hipSuccess) { fprintf(stderr, "kernel_launch: launch %d failed: %s\n", li, hipGetErrorName(le)); break; }
    }
}
```

```cpp
#include <hip/hip_runtime.h>
#include <cstdio>
#include <cstdint>
#include <cmath>

#ifndef MK_N_LAUNCHES
#define MK_N_LAUNCHES 1
#endif

constexpr int MP = 32768;
constexpr int MS = 128;
constexpr int MREAL = MP + MS;
constexpr int MR = 33024;
constexpr int DM = 1024, SEQ = 2048, NBATCH = 16;
constexpr int ZC = 1536;
constexpr int LRU_W = 512, NHEAD = 8;
constexpr int QLR = 256, KVLR = 128, ROPE_D = 32, NOPE_D = 64, QKD = 96, VD = 64;
constexpr int DFF = 2816, UPC = 5632;
constexpr int NPAGES = 128, PAGE = 128;
constexpr int MODC = 6144;
constexpr float EPS = 1e-6f;
constexpr float C2 = 0.10206207261596575f * 1.4426950408889634f;

constexpr size_t O_YP = 0, O_YS = 33554432, O_KVP = 33685504, O_KRP = 37879808, O_LHP = 38928384, O_LCP = 38936576, O_FCP = 38961152,
                 O_KVS = 39141376, O_KRS = 39157760, O_LHS = 39161856, O_LCS = 39227392, O_FCS = 39424000, O_END = 40865792;

constexpr size_t MiB = 1u << 20;
constexpr size_t WS_CTL = 0, CTL_ZERO_BYTES = 1 * MiB;
constexpr size_t WS_WIN = 1 * MiB;
constexpr size_t WS_WUQ = 4 * MiB;
constexpr size_t WS_WUKV = 5 * MiB;
constexpr size_t WS_WO = 6 * MiB;
constexpr size_t WS_WUP = 8 * MiB;
constexpr size_t WS_WDN = 20 * MiB;
constexpr size_t WS_WADA = 26 * MiB;
constexpr size_t WS_WG = 38 * MiB;
constexpr size_t WS_SC = 39 * MiB;
constexpr size_t WS_MOD = 40 * MiB;
constexpr size_t WS_ROPE = 44 * MiB;
constexpr size_t WS_SUM = 45 * MiB;
constexpr size_t WS_CARRY = 47 * MiB;
constexpr size_t WS_PART = 48 * MiB;
constexpr size_t WS_H1 = 64 * MiB;
constexpr size_t WS_Z = 130 * MiB;
constexpr size_t WS_QN = 228 * MiB;
constexpr size_t WS_KVN = 246 * MiB;
constexpr size_t WS_KR = 264 * MiB;
constexpr size_t WS_HL = 268 * MiB;
constexpr size_t WS_AC = 302 * MiB;
constexpr size_t WS_QRAW = 336 * MiB;
constexpr size_t WS_KVRAW = 386 * MiB;
constexpr size_t WS_Q = 452 * MiB;
constexpr size_t WS_KF = 502 * MiB;
constexpr size_t WS_V = 552 * MiB;
constexpr size_t WS_ATT = 586 * MiB;
constexpr size_t WS_MIX = 620 * MiB;
constexpr size_t WS_UP = 686 * MiB;
constexpr size_t WS_ACT = 1042 * MiB;
constexpr size_t WS_RAW = 1221 * MiB;
constexpr size_t WS_X1 = 1246 * MiB;
constexpr size_t WS_SH2 = 1312 * MiB;
constexpr size_t WS_SB = 1313 * MiB;
constexpr size_t WS_ROWSS = WS_CTL + 256 * 1024;
constexpr size_t WS_END = 1318 * MiB;
constexpr int CW_TMO = 0, CW_BAR = 4096;

constexpr int RING_OFF = 0, RING_BYTES = 143360;
constexpr int LDSCTL_OFF = RING_BYTES, MISC_OFF = LDSCTL_OFF + 320;
constexpr int LDS_BYTES = 147456;
constexpr int NWAVES = 8;

namespace pg8 {
#define PG8_LAS __attribute__((address_space(3)))
typedef unsigned short bf16_t;
typedef short bf16x8 __attribute__((ext_vector_type(8)));
typedef float f32x4 __attribute__((ext_vector_type(4)));
typedef unsigned u32x4 __attribute__((ext_vector_type(4)));
constexpr int BM = 256, BK = 64, HALF = 128, HTB = HALF * BK * 2  , STAGE_BYTES = 8 * HTB, NXCD = 8, WGM = 8;

__host__ __device__ __forceinline__ int lds_byte(int r, int c) { const int st = (r >> 4) * 2 + (c >> 5), rr = r & 15, cc = c & 31, ob = rr * 64 + cc * 2; return st * 1024 + (ob ^ (((ob >> 9) & 1) << 5)); }
__host__ __device__ __forceinline__ void stage_rc(int b, int& R, int& C) { const int st = b / 1024, sb = b % 1024, swz = sb ^ (((sb >> 9) & 1) << 5); R = (st >> 1) * 16 + swz / 64; C = (st & 1) * 32 + (swz % 64) / 2; }
__host__ __device__ __forceinline__ int perm32(int rho) { const int n = rho >> 4, i = rho & 15; return 8 * (i >> 2) + 4 * n + (i & 3); }

struct Unit { int pm, pn; };
struct Gemm { const bf16_t* A; const bf16_t* Bt; int M, N, K; };

struct StaticOrder {
    int nM, nN, nwg, G, c;
    __host__ __device__ void init(int M, int N, int G_, int c_) { nM = M / BM; nN = N / BM; nwg = nM * nN; G = G_; c = c_; }
    __host__ __device__ bool next(int i, Unit& u) const {
        const long L = (long)i * G + c; if (L >= nwg) return false;
        int wgid = (int)L; { const int q = nwg / NXCD, r = nwg % NXCD, xcd = wgid % NXCD, off = wgid / NXCD; wgid = (xcd < r ? xcd * (q + 1) : r * (q + 1) + (xcd - r) * q) + off; }
        const int nig = WGM * nN, gid = wgid / nig, fm = gid * WGM, gsz = (nM - fm) < WGM ? (nM - fm) : WGM;
        u.pm = fm + ((wgid % nig) % gsz); u.pn = (wgid % nig) / gsz; return true;
    }
    __device__ __forceinline__ void a_ready(const Unit&) const {}
    __device__ __forceinline__ void done(const Unit&) const {}
};

__device__ __forceinline__ unsigned cvt_pk_bf16(float lo, float hi) { unsigned r; asm volatile("v_cvt_pk_bf16_f32 %0, %1, %2" : "=v"(r) : "v"(lo), "v"(hi)); return r; }
typedef float f32x2 __attribute__((ext_vector_type(2)));
__device__ __forceinline__ f32x2 gelu_pk(f32x2 v) {
    const f32x2 av = __builtin_elementwise_abs(v), d = av * 0.2316418882f + 1.0f;
    f32x2 t; t.x = __builtin_amdgcn_rcpf(d.x); t.y = __builtin_amdgcn_rcpf(d.y);
    f32x2 q = t * 0.5307027145f + (-0.7265760135f); q = q * t + 0.7107068705f; q = q * t + (-0.142248368f); q = q * t + 0.127414796f; q = q * t;
    const f32x2 s = (v * v) * (-0.72134752044f);
    f32x2 e; e.x = __builtin_amdgcn_exp2f(s.x); e.y = __builtin_amdgcn_exp2f(s.y);
    const f32x2 m = v * (q * e), r = v - m;
    f32x2 o; o.x = v.x < 0.f ? m.x : r.x; o.y = v.y < 0.f ? m.y : r.y; return o;
}

template <int ACT  > struct EpiBf16 {
    static constexpr bool PERM = true, AFTER_DRAIN = false, PERMA = false; static_assert(ACT == 0 || ACT == 1, "EpiBf16: ACT is 0 (none) or 1 (gelu_pk)");
    bf16_t* O; int ldc; const float* bias; int split_cols; size_t split_stride; float scale0;
    __device__ __forceinline__ void operator()(const f32x4 (&acc)[2][2][4][2], const Unit& u, int wr, int wc, int fr, int fq) const {
        const int row0 = u.pm * BM + wr * 64 + fr; int colt = u.pn * BM; bf16_t* base = O;
        float sc = 1.f; if (split_cols) { const int t = colt / split_cols; base += (size_t)t * split_stride; colt -= t * split_cols; if (t == 0) sc = scale0; }
        const int col0 = colt + wc * 32 + 8 * fq, bcol0 = u.pn * BM + wc * 32 + 8 * fq;
        f32x4 bv[2][2];
#pragma unroll
        for (int bj = 0; bj < 2; ++bj)
#pragma unroll
            for (int n = 0; n < 2; ++n) bv[bj][n] = bias ? *(const f32x4*)(bias + bcol0 + bj * HALF + 4 * n) : (f32x4){0.f, 0.f, 0.f, 0.f};
#pragma unroll
        for (int ai = 0; ai < 2; ++ai)
#pragma unroll
            for (int m = 0; m < 4; ++m) { bf16_t* rowp = base + (size_t)(row0 + ai * HALF + m * 16) * ldc + col0;
#pragma unroll
                for (int bj = 0; bj < 2; ++bj) { f32x4 v0 = acc[ai][bj][m][0] + bv[bj][0], v1 = acc[ai][bj][m][1] + bv[bj][1];
                    if (ACT == 1) { f32x2 a = gelu_pk((f32x2){v0[0], v0[1]}), b = gelu_pk((f32x2){v0[2], v0[3]}), c = gelu_pk((f32x2){v1[0], v1[1]}), d = gelu_pk((f32x2){v1[2], v1[3]});
                        v0 = (f32x4){a.x, a.y, b.x, b.y}; v1 = (f32x4){c.x, c.y, d.x, d.y}; }
                    v0 = v0 * sc; v1 = v1 * sc; u32x4 w; w.x = cvt_pk_bf16(v0[0], v0[1]); w.y = cvt_pk_bf16(v0[2], v0[3]); w.z = cvt_pk_bf16(v1[0], v1[1]); w.w = cvt_pk_bf16(v1[2], v1[3]);
                    *(u32x4*)(rowp + bj * HALF) = w; } }
    }
};

template <bool BASE_BF16, bool OUT_BF16, bool XG> struct EpiResGate {
    static constexpr bool PERM = OUT_BF16, AFTER_DRAIN = false, PERMA = false;
    static constexpr int CN = PERM ? 4 : 16, CQ = PERM ? 8 : 4;
    const void* base; void* out; const float* mod; int goff; bf16_t* xg; const float* g2; float* rowss;
    typedef unsigned u32x2e __attribute__((ext_vector_type(2)));
    static constexpr int GM = BASE_BF16 ? 4 : 2, NG = 8 / GM;
    template <class BT> __device__ __forceinline__ void load_group(BT (&b)[GM * 4], int g, const Unit& u, int wr, int fr, int col0) const {
#pragma unroll
        for (int q = 0; q < GM; ++q) { const int am = g * GM + q; const size_t row = (size_t)(u.pm * BM + (am >> 2) * HALF + wr * 64 + (am & 3) * 16 + fr);
#pragma unroll
            for (int bj = 0; bj < 2; ++bj)
#pragma unroll
                for (int n = 0; n < 2; ++n) b[q * 4 + bj * 2 + n] = *(const BT*)((const typename std::conditional<BASE_BF16, bf16_t, float>::type*)base + row * 1024 + col0 + bj * HALF + n * CN); }
    }
    __device__ __forceinline__ void operator()(const f32x4 (&acc)[2][2][4][2], const Unit& u, int wr, int wc, int fr, int fq) const {
        typedef typename std::conditional<BASE_BF16, u32x2e, f32x4>::type BT;
        const int col0 = u.pn * BM + wc * 32 + CQ * fq;
        const float* mrow = mod + (size_t)((u.pm * BM) >> 11) * 6144;
        BT ring[2][GM * 4];
        load_group(ring[0], 0, u, wr, fr, col0);
        f32x4 gt[2][2], G2[2][2];
#pragma unroll
        for (int bj = 0; bj < 2; ++bj)
#pragma unroll
            for (int n = 0; n < 2; ++n) { const int c = col0 + bj * HALF + n * CN; gt[bj][n] = *(const f32x4*)(mrow + goff + c);
                if (XG) G2[bj][n] = *(const f32x4*)(g2 + c) * (*(const f32x4*)(mrow + 4096 + c) + 1.0f); }
#pragma unroll
        for (int g = 0; g < NG; ++g) {
            if (g + 1 < NG) load_group(ring[(g + 1) & 1], g + 1, u, wr, fr, col0);
            asm volatile("" ::: "memory");
#pragma unroll
            for (int q = 0; q < GM; ++q) { const int am = g * GM + q, ai = am >> 2, m = am & 3;
                const size_t row = (size_t)(u.pm * BM + ai * HALF + wr * 64 + m * 16 + fr);
                float ss = 0.f;
#pragma unroll
                for (int bj = 0; bj < 2; ++bj) { u32x2e wo[2], wx[2];
#pragma unroll
                    for (int n = 0; n < 2; ++n) { const int c = col0 + bj * HALF + n * CN;
                        f32x4 bs;
                        if constexpr (BASE_BF16) { const u32x2e w = ring[g & 1][q * 4 + bj * 2 + n]; bs = (f32x4){__uint_as_float(w.x << 16), __uint_as_float(w.x & 0xffff0000u), __uint_as_float(w.y << 16), __uint_as_float(w.y & 0xffff0000u)}; }
                        else bs = ring[g & 1][q * 4 + bj * 2 + n];
                        const f32x4 o = bs + gt[bj][n] * acc[ai][bj][m][n];
                        if (OUT_BF16) { wo[n].x = cvt_pk_bf16(o[0], o[1]); wo[n].y = cvt_pk_bf16(o[2], o[3]); if (!PERM) *(u32x2e*)((bf16_t*)out + row * 1024 + c) = wo[n]; }
                        else *(f32x4*)((float*)out + row * 1024 + c) = o;
                        if (XG) { const f32x4 x = o * G2[bj][n]; wx[n].x = cvt_pk_bf16(x[0], x[1]); wx[n].y = cvt_pk_bf16(x[2], x[3]); if (!PERM) *(u32x2e*)(xg + row * 1024 + c) = wx[n];
                            ss += (o[0] * o[0] + o[1] * o[1]) + (o[2] * o[2] + o[3] * o[3]); } }
                    if (PERM) { const int c8 = col0 + bj * HALF;
                        if (OUT_BF16) *(u32x4*)((bf16_t*)out + row * 1024 + c8) = (u32x4){wo[0].x, wo[0].y, wo[1].x, wo[1].y};
                        if (XG) *(u32x4*)(xg + row * 1024 + c8) = (u32x4){wx[0].x, wx[0].y, wx[1].x, wx[1].y}; } }
                if (XG) {
                    { auto rr = __builtin_amdgcn_permlane16_swap(__float_as_uint(ss), __float_as_uint(ss), false, false); ss = __uint_as_float(rr[0]) + __uint_as_float(rr[1]); }
                    { auto rr = __builtin_amdgcn_permlane32_swap(__float_as_uint(ss), __float_as_uint(ss), false, false); ss = __uint_as_float(rr[0]) + __uint_as_float(rr[1]); }
                    if (fq == 0) __hip_atomic_fetch_add(rowss + row, ss, __ATOMIC_RELAXED, __HIP_MEMORY_SCOPE_AGENT); }
            }
        }
    }
};


__device__ __forceinline__ float dpp_shr1(float v) { return __builtin_bit_cast(float, __builtin_amdgcn_update_dpp(0, __builtin_bit_cast(int, v), 0x111, 0xf, 0xf, false)); }
__device__ __forceinline__ float gelu_tanh_e(float x) { const float u = 0.7978845608028654f * (x + 0.044715f * x * x * x); return x * __builtin_amdgcn_rcpf(1.0f + __builtin_amdgcn_exp2f(-2.8853900817779268f * u)); }
#ifndef CW1_AT
#define CW1_AT 7
#endif
struct EpiConvGelu {
    static constexpr bool PERM = true, AFTER_DRAIN = false, PERMA = true;
    bf16_t* ACT; float* RAW; const float* fw; const float* fb; const float* rowss; const float* SB;
    __device__ __forceinline__ void operator()(const f32x4 (&acc_)[2][2][4][2], const Unit& u, int wr, int wc, int fr_, int fq_) const {
        f32x4 (&acc)[2][2][4][2] = const_cast<f32x4 (&)[2][2][4][2]>(acc_);
        int ln_; asm volatile("v_mbcnt_lo_u32_b32 %0, -1, 0\n\tv_mbcnt_hi_u32_b32 %0, -1, %0" : "=v"(ln_)); const int fr = ln_ & 15, fq = ln_ >> 4; (void)fr_; (void)fq_;
        const int tb = u.pm * BM + wr * 128 + fr * 8;
        { const f32x4 s0 = *(const f32x4*)(rowss + tb), s1 = *(const f32x4*)(rowss + tb + 4);
          float rs[8]; rs[0] = s0[0]; rs[1] = s0[1]; rs[2] = s0[2]; rs[3] = s0[3]; rs[4] = s1[0]; rs[5] = s1[1]; rs[6] = s1[2]; rs[7] = s1[3];
#pragma unroll
          for (int j = 0; j < 8; ++j) rs[j] = __builtin_amdgcn_rsqf(rs[j] * (1.f / 1024.f) + 1e-6f);
          const float* sbp = SB + (size_t)((u.pm * BM) >> 11) * 5632 + u.pn * BM + wc * 32 + fq * 8;
#pragma unroll
          for (int bj = 0; bj < 2; ++bj)
#pragma unroll
              for (int n = 0; n < 2; ++n) { const f32x4 sb = *(const f32x4*)(sbp + bj * HALF + 4 * n);
#pragma unroll
                  for (int j = 0; j < 8; ++j) acc[j >> 2][bj][j & 3][n] = acc[j >> 2][bj][j & 3][n] * rs[j] + sb; } }
        const int cb = u.pn * 128 + wc * 32 + fq * 8;
        const int blk = u.pm * 2 + wr;
        f32x4 cw[2][8];
#define CW_LOAD(n) do { const int c0_ = cb + 4 * (n); \
            cw[n][0] = *(const f32x4*)(fw + c0_); cw[n][1] = *(const f32x4*)(fw + 5632 + c0_); cw[n][2] = *(const f32x4*)(fw + 11264 + c0_); cw[n][3] = *(const f32x4*)(fb + c0_); \
            cw[n][4] = *(const f32x4*)(fw + 2816 + c0_); cw[n][5] = *(const f32x4*)(fw + 5632 + 2816 + c0_); cw[n][6] = *(const f32x4*)(fw + 11264 + 2816 + c0_); cw[n][7] = *(const f32x4*)(fb + 2816 + c0_); } while (0)
#pragma unroll
        for (int n = 0; n < 2; ++n) {
            const int c0 = cb + 4 * n;
            if (n == 0) CW_LOAD(0);
            const f32x4 wv0 = cw[n][0], wv1 = cw[n][1], wv2 = cw[n][2], bv = cw[n][3], wg0 = cw[n][4], wg1 = cw[n][5], wg2 = cw[n][6], bg = cw[n][7];
            f32x4 pv1, pv2, pg1, pg2;
#pragma unroll
            for (int e = 0; e < 4; ++e) { pv1[e] = dpp_shr1(acc[1][0][3][n][e]); pv2[e] = dpp_shr1(acc[1][0][2][n][e]); pg1[e] = dpp_shr1(acc[1][1][3][n][e]); pg2[e] = dpp_shr1(acc[1][1][2][n][e]); }
#pragma unroll
            for (int j = 0; j < 8; ++j) { const int ai = j >> 2, m = j & 3;
                if (n == 0 && j == 1) {
                    if (fr == 15) { float* r = RAW + (size_t)blk * 4 * 5632;
#pragma unroll
                        for (int n2 = 0; n2 < 2; ++n2) { const int c2 = cb + 4 * n2;
                            *(f32x4*)(r + c2) = acc[1][0][2][n2]; *(f32x4*)(r + 2816 + c2) = acc[1][1][2][n2]; *(f32x4*)(r + 5632 + c2) = acc[1][0][3][n2]; *(f32x4*)(r + 5632 + 2816 + c2) = acc[1][1][3][n2]; } }
                    if (fr == 0) { float* r = RAW + ((size_t)blk * 4 + 2) * 5632;
#pragma unroll
                        for (int n2 = 0; n2 < 2; ++n2) { const int c2 = cb + 4 * n2;
                            *(f32x4*)(r + c2) = acc[0][0][0][n2]; *(f32x4*)(r + 2816 + c2) = acc[0][1][0][n2]; *(f32x4*)(r + 5632 + c2) = acc[0][0][1][n2]; *(f32x4*)(r + 5632 + 2816 + c2) = acc[0][1][1][n2]; } } }
                if (n == 0 && j == CW1_AT) CW_LOAD(1);
                const f32x4 v = acc[ai][0][m][n], g = acc[ai][1][m][n];
                const f32x4 val = bv + wv0 * pv2 + wv1 * pv1 + wv2 * v, gt = bg + wg0 * pg2 + wg1 * pg1 + wg2 * g;
                u32x4 dummy; (void)dummy;
                const unsigned p0 = cvt_pk_bf16(gelu_tanh_e(gt[0]) * val[0], gelu_tanh_e(gt[1]) * val[1]), p1 = cvt_pk_bf16(gelu_tanh_e(gt[2]) * val[2], gelu_tanh_e(gt[3]) * val[3]);
                typedef unsigned u32x2e __attribute__((ext_vector_type(2)));
                *(u32x2e*)(ACT + (size_t)(tb + j) * 2816 + c0) = (u32x2e){p0, p1};
                pv2 = pv1; pv1 = v; pg2 = pg1; pg1 = g; }
        }
#undef CW_LOAD
    }
};

template <bool PA> struct EpiNull {
    static constexpr bool PERM = false, AFTER_DRAIN = false, PERMA = PA;
    __device__ __forceinline__ void operator()(const f32x4 (&acc)[2][2][4][2], const Unit& u, int wr, int wc, int fr, int fq) const {
#pragma unroll
        for (int i = 0; i < 32; ++i) asm volatile("" :: "v"(acc[i >> 4][(i >> 3) & 1][(i >> 1) & 3][i & 1]));
    }
};

template <int MODE> struct EpiProbe {
    static constexpr bool PERM = false, AFTER_DRAIN = false, PERMA = false;
    float* out; const bf16_t* base;
    __device__ __forceinline__ void operator()(const f32x4 (&acc)[2][2][4][2], const Unit& u, int wr, int wc, int fr, int fq) const {
        typedef unsigned u32x2e __attribute__((ext_vector_type(2)));
        const int col0 = u.pn * BM + wc * 32 + 4 * fq;
#pragma unroll
        for (int am = 0; am < 8; ++am) { const int ai = am >> 2, m = am & 3; const size_t row = (size_t)(u.pm * BM + ai * HALF + wr * 64 + m * 16 + fr);
#pragma unroll
            for (int bj = 0; bj < 2; ++bj)
#pragma unroll
                for (int n = 0; n < 2; ++n) { const int c = col0 + bj * HALF + n * 16;
                    if (MODE == 0) *(f32x4*)(out + row * 1024 + c) = acc[ai][bj][m][n];
                    else if (MODE == 1) { const u32x2e w = *(const u32x2e*)(base + row * 1024 + c); asm volatile("" :: "v"(w), "v"(acc[ai][bj][m][n])); }
                    else { u32x2e w; w.x = cvt_pk_bf16(acc[ai][bj][m][n][0], acc[ai][bj][m][n][1]); w.y = cvt_pk_bf16(acc[ai][bj][m][n][2], acc[ai][bj][m][n][3]); *(u32x2e*)((bf16_t*)out + row * 1024 + c) = w; } } }
    }
};
template <class Epi, class Sched, bool ALIGN_EPI = false, bool SP2 = false>
__device__ __forceinline__ void gemm_phase(PG8_LAS unsigned char* lds, const Gemm g, const Sched& S, const Epi& E, const int tid) {
    const int wid = __builtin_amdgcn_readfirstlane(tid >> 6), lane = tid & 63, wr = wid >> 2, wc = wid & 3, fr = lane & 15, fq = lane >> 4;
    const int K = g.K, nt = K / BK;
    unsigned voffA[2], voffB[2];
#pragma unroll
    for (int i = 0; i < 2; ++i) { int R, C; stage_rc(tid * 16 + i * 8192, R, C); const int Rb = Epi::PERM ? ((R & ~31) + perm32(R & 31)) : R;
        const int Ra = Epi::PERMA ? (128 * (R >> 6) + 8 * (R & 15) + ((R >> 4) & 3)) : R;
        voffA[i] = (unsigned)(Ra * K + C) * 2u; voffB[i] = (unsigned)(Rb * K + C) * 2u; }
    const size_t kstep = (size_t)(BK * 2);
    const size_t hstep = (size_t)HALF * K * 2;
    const size_t hstepA = Epi::PERMA ? (size_t)4 * K * 2 : hstep;
    const size_t tstep = 2 * hstep;
    const unsigned ldsw = (unsigned)wid * 1024u;
    const int aoff = lds_byte(wr * 64 + fr, fq * 8), boff = lds_byte(wc * 32 + fr, fq * 8);
#define PG8_SA(b, h) (((b) * 2 + (h)) * HTB)
#define PG8_SB(b, h) ((4 + (b) * 2 + (h)) * HTB)
#define PG8_STAGE(bufoff, gbase, voff) do { _Pragma("unroll") for (int _i = 0; _i < 2; ++_i) \
        __builtin_amdgcn_global_load_lds((const unsigned*)((const char*)(gbase) + (voff)[_i]), (PG8_LAS unsigned*)(lds + (bufoff) + ldsw + _i * 8192), 16, 0, 0); } while (0)
#define PG8_LDA(dst, b, h) do { _Pragma("unroll") for (int m = 0; m < 4; ++m) _Pragma("unroll") for (int k = 0; k < 2; ++k) dst[m][k] = *(const PG8_LAS bf16x8*)(lds + PG8_SA(b, h) + aoff + m * 2048 + k * 1024); } while (0)
#define PG8_LDB(dst, b, h) do { _Pragma("unroll") for (int n = 0; n < 2; ++n) _Pragma("unroll") for (int k = 0; k < 2; ++k) dst[n][k] = *(const PG8_LAS bf16x8*)(lds + PG8_SB(b, h) + boff + n * 2048 + k * 1024); } while (0)
#define PG8_MMA(ai, bj, At, Bt) do { __builtin_amdgcn_s_setprio(1); _Pragma("unroll") for (int m = 0; m < 4; ++m) _Pragma("unroll") for (int n = 0; n < 2; ++n) _Pragma("unroll") for (int k = 0; k < 2; ++k) \
        acc[ai][bj][m][n] = __builtin_amdgcn_mfma_f32_16x16x32_bf16(Bt[n][k], At[m][k], acc[ai][bj][m][n], 0, 0, 0); __builtin_amdgcn_s_setprio(0); } while (0)
#define PG8_WAIT_V(n) asm volatile("s_waitcnt vmcnt(" #n ")" ::: "memory")
#define PG8_WAIT_L(n) asm volatile("s_waitcnt lgkmcnt(" #n ")" ::: "memory")
#define PG8_BAR __builtin_amdgcn_s_barrier()
#define PG8_SCHED __builtin_amdgcn_sched_barrier(0)
    Unit cur, nxt; int ui = 0;
    if (!S.next(0, cur)) return;
    f32x4 acc[2][2][4][2];
#pragma unroll
    for (int a = 0; a < 2; ++a)
#pragma unroll
        for (int b = 0; b < 2; ++b)
#pragma unroll
            for (int m = 0; m < 4; ++m)
#pragma unroll
                for (int n = 0; n < 2; ++n) acc[a][b][m][n] = (f32x4){0.f, 0.f, 0.f, 0.f};
    bf16x8 At[4][2], B0[2][2], B1[2][2];
    const char* cA = (const char*)g.A + (size_t)cur.pm * tstep; const char* cB = (const char*)g.Bt + (size_t)cur.pn * tstep;
    S.a_ready(cur);
    if constexpr (SP2) {
        PG8_STAGE(PG8_SB(0, 0), cB, voffB); PG8_STAGE(PG8_SB(0, 1), cB + hstep, voffB); PG8_STAGE(PG8_SA(0, 0), cA, voffA); PG8_STAGE(PG8_SA(0, 1), cA + hstepA, voffA);
        if (wr == 1) PG8_BAR;
        PG8_WAIT_V(2); PG8_BAR;
        PG8_STAGE(PG8_SB(1, 0), cB + kstep, voffB); PG8_STAGE(PG8_SA(1, 0), cA + kstep, voffA); PG8_STAGE(PG8_SB(1, 1), cB + hstep + kstep, voffB);
        PG8_WAIT_V(6); PG8_BAR;
    } else {
        PG8_STAGE(PG8_SB(0, 0), cB, voffB); PG8_STAGE(PG8_SA(0, 0), cA, voffA); PG8_STAGE(PG8_SB(0, 1), cB + hstep, voffB); PG8_STAGE(PG8_SA(0, 1), cA + hstepA, voffA);
        if (wr == 1) PG8_BAR;
        PG8_WAIT_V(4); PG8_BAR;
        PG8_STAGE(PG8_SB(1, 0), cB + kstep, voffB); PG8_STAGE(PG8_SA(1, 0), cA + kstep, voffA); PG8_STAGE(PG8_SB(1, 1), cB + hstep + kstep, voffB);
        PG8_WAIT_V(6); PG8_BAR;
    }
    for (;;) {
        const bool has_next = S.next(ui + 1, nxt);
        const char* nA = has_next ? (const char*)g.A + (size_t)nxt.pm * tstep : cA; const char* nB = has_next ? (const char*)g.Bt + (size_t)nxt.pn * tstep : cB;
        for (int t = 0; t < nt; t += 2) {
            const bool last = (t == nt - 2);
            const char* a1 = cA + (size_t)(t + 1) * kstep;
            const char* a2 = last ? nA : cA + (size_t)(t + 2) * kstep; const char* b2 = last ? nB : cB + (size_t)(t + 2) * kstep;
            const char* a3 = a2 + kstep; const char* b3 = b2 + kstep;
            if (last && has_next) S.a_ready(nxt);
            if constexpr (SP2) {
            PG8_LDB(B0, 0, 0); PG8_LDB(B1, 0, 1); PG8_SCHED; PG8_LDA(At, 0, 0); PG8_STAGE(PG8_SA(1, 1), a1 + hstepA, voffA);
            PG8_WAIT_V(8); PG8_WAIT_L(0); PG8_BAR; PG8_MMA(0, 0, At, B0); PG8_MMA(0, 1, At, B1); PG8_BAR; PG8_SCHED;
            PG8_LDA(At, 0, 1); PG8_STAGE(PG8_SB(0, 0), b2, voffB); PG8_STAGE(PG8_SB(0, 1), b2 + hstep, voffB); PG8_STAGE(PG8_SA(0, 0), a2, voffA);
            PG8_WAIT_V(8); PG8_WAIT_L(0); PG8_BAR; PG8_MMA(1, 0, At, B0); PG8_MMA(1, 1, At, B1); PG8_BAR; PG8_SCHED;
            PG8_LDB(B0, 1, 0); PG8_LDB(B1, 1, 1); PG8_SCHED; PG8_LDA(At, 1, 0); PG8_STAGE(PG8_SA(0, 1), a2 + hstepA, voffA);
            PG8_WAIT_V(8); PG8_WAIT_L(0); PG8_BAR; PG8_MMA(0, 0, At, B0); PG8_MMA(0, 1, At, B1); PG8_BAR; PG8_SCHED;
            PG8_LDA(At, 1, 1); PG8_STAGE(PG8_SB(1, 0), b3, voffB); PG8_STAGE(PG8_SB(1, 1), b3 + hstep, voffB); PG8_STAGE(PG8_SA(1, 0), a3, voffA);
            PG8_WAIT_V(8); PG8_WAIT_L(0); PG8_BAR; PG8_MMA(1, 0, At, B0); PG8_MMA(1, 1, At, B1); PG8_BAR; PG8_SCHED;
            } else {
            PG8_LDB(B0, 0, 0); PG8_SCHED; PG8_LDA(At, 0, 0); PG8_STAGE(PG8_SA(1, 1), a1 + hstepA, voffA);
            PG8_WAIT_L(8); PG8_BAR; PG8_WAIT_L(0); PG8_MMA(0, 0, At, B0); PG8_BAR; PG8_SCHED;
            PG8_LDB(B1, 0, 1); PG8_STAGE(PG8_SB(0, 0), b2, voffB);
            PG8_BAR; PG8_WAIT_L(0); PG8_MMA(0, 1, At, B1); PG8_BAR;
            PG8_LDA(At, 0, 1); PG8_STAGE(PG8_SA(0, 0), a2, voffA);
            PG8_BAR; PG8_WAIT_L(0); PG8_MMA(1, 0, At, B0); PG8_BAR; PG8_SCHED;
            PG8_STAGE(PG8_SB(0, 1), b2 + hstep, voffB);
            PG8_WAIT_V(6); PG8_BAR; PG8_MMA(1, 1, At, B1); PG8_BAR;
            PG8_LDB(B0, 1, 0); PG8_SCHED; PG8_LDA(At, 1, 0); PG8_STAGE(PG8_SA(0, 1), a2 + hstepA, voffA);
            PG8_WAIT_L(8); PG8_BAR; PG8_WAIT_L(0); PG8_MMA(0, 0, At, B0); PG8_BAR; PG8_SCHED;
            PG8_LDB(B1, 1, 1); PG8_STAGE(PG8_SB(1, 0), b3, voffB);
            PG8_BAR; PG8_WAIT_L(0); PG8_MMA(0, 1, At, B1); PG8_BAR;
            PG8_LDA(At, 1, 1); PG8_STAGE(PG8_SA(1, 0), a3, voffA);
            PG8_BAR; PG8_WAIT_L(0); PG8_MMA(1, 0, At, B0); PG8_BAR; PG8_SCHED;
            PG8_STAGE(PG8_SB(1, 1), b3 + hstep, voffB);
            PG8_WAIT_V(6); PG8_BAR; PG8_MMA(1, 1, At, B1); PG8_BAR;
            }
        }
        if constexpr (ALIGN_EPI) { if (wr == 0) PG8_BAR; }
        if constexpr (!Epi::AFTER_DRAIN) { E(acc, cur, wr, wc, fr, fq); S.done(cur); }
        if (!has_next) break;
#pragma unroll
        for (int a = 0; a < 2; ++a)
#pragma unroll
            for (int b = 0; b < 2; ++b)
#pragma unroll
                for (int m = 0; m < 4; ++m)
#pragma unroll
                    for (int n = 0; n < 2; ++n) acc[a][b][m][n] = (f32x4){0.f, 0.f, 0.f, 0.f};
        cur = nxt; cA = nA; cB = nB; ++ui;
        if constexpr (ALIGN_EPI) { if (wr == 1) PG8_BAR; }
    }
    PG8_WAIT_V(0);
    if constexpr (!ALIGN_EPI) { if (wr == 0) PG8_BAR; }
    PG8_BAR;
    if constexpr (Epi::AFTER_DRAIN) { E.fused(acc, cur, wr, wc, fr, fq, lds, wid, lane); S.done(cur); }
#undef PG8_SA
#undef PG8_SB
#undef PG8_STAGE
#undef PG8_LDA
#undef PG8_LDB
#undef PG8_MMA
#undef PG8_WAIT_V
#undef PG8_WAIT_L
#undef PG8_BAR
#undef PG8_SCHED
}
}
#define GAS __attribute__((address_space(1)))
#define LAS __attribute__((address_space(3)))
typedef unsigned short bf16;
typedef unsigned v4u __attribute__((ext_vector_type(4)));
typedef float f32x4 __attribute__((ext_vector_type(4)));
typedef short bf16x8 __attribute__((ext_vector_type(8)));
typedef GAS unsigned gu32;
typedef GAS unsigned long long gu64;
#define RLX_AGENT __ATOMIC_RELAXED, __HIP_MEMORY_SCOPE_AGENT
#define LDS_WAIT() asm volatile("s_waitcnt lgkmcnt(0)" ::: "memory")
#define VM_WAIT() asm volatile("s_waitcnt vmcnt(0)" ::: "memory")
__device__ __forceinline__ unsigned long long rt() { return __builtin_amdgcn_s_memrealtime(); }
typedef float f32x2_cv __attribute__((ext_vector_type(2))); typedef __bf16 bf16x2_cv __attribute__((ext_vector_type(2)));
__device__ __forceinline__ unsigned pk2(float lo, float hi) { f32x2_cv v = {lo, hi}; bf16x2_cv b = __builtin_convertvector(v, bf16x2_cv); return __builtin_bit_cast(unsigned, b); }
__device__ __forceinline__ unsigned f2bf(float f) { return pk2(f, f) & 0xffffu; }
#define XB_TMO      128
#define XB_XCNT(j)  (256  + 64 * (j))
#define XB_XSUB(j)  (1280 + 64 * (j))
#define XB_XGEN(j)  (2304 + 64 * (j))
#define XB_TOP      3328
#define XB_TOPGEN   3392
#define XCD_BAR_WORDS 3456
#define XB_SPIN_CAP (1u << 18)

__device__ __forceinline__ unsigned xb_ld(unsigned* p)              { return __hip_atomic_load(p, __ATOMIC_RELAXED, __HIP_MEMORY_SCOPE_AGENT); }
__device__ __forceinline__ unsigned xb_add(unsigned* p, unsigned v) { return __hip_atomic_fetch_add(p, v, __ATOMIC_RELAXED, __HIP_MEMORY_SCOPE_AGENT); }
__device__ __forceinline__ unsigned xb_xcc_id() { return (unsigned)__builtin_amdgcn_s_getreg((3 << 11) | 20) & 0xFu; }
#define XB_SPIN(cond, bar) do { unsigned _sp = 0; while (cond) { __builtin_amdgcn_s_sleep(1); \
    if ((++_sp & 255u) == 0u) { if (xb_ld(&(bar)[XB_TMO])) break; if (_sp > XB_SPIN_CAP) { atomicAdd(&(bar)[XB_TMO], 1u); break; } } } } while (0)

struct XcdBarrier {
    unsigned* bar; unsigned x;
    volatile LAS unsigned* st;
};

__device__ __forceinline__ XcdBarrier xcd_barrier_post(unsigned* bar, volatile LAS unsigned* st, int tid) {
    XcdBarrier b; b.bar = bar; b.x = xb_xcc_id(); b.st = st;
    if (tid == 0) (void)xb_add(&bar[XB_XCNT(b.x)], 1u);
    return b;
}
__device__ __forceinline__ void xcd_barrier_complete(unsigned* bar, unsigned x, unsigned& nloc, unsigned& nx) {
    const unsigned G = gridDim.x * gridDim.y * gridDim.z;
    unsigned sum, cnt, mine, sp = 0u;
    for (;;) {
        sum = 0u; cnt = 0u; mine = 0u;
#pragma unroll
        for (unsigned j = 0; j < 16; ++j) { const unsigned c = xb_ld(&bar[XB_XCNT(j)]); sum += c; cnt += (c > 0u) ? 1u : 0u; mine = (j == x) ? c : mine; }
        if (sum == G) break;
        __builtin_amdgcn_s_sleep(1);
        if ((++sp & 255u) == 0u) { if (xb_ld(&bar[XB_TMO])) break; if (sp > XB_SPIN_CAP) { atomicAdd(&bar[XB_TMO], 1u); break; } }
    }
    nloc = mine > 0u ? mine : 1u; nx = cnt > 0u ? cnt : 1u;
}

__device__ __forceinline__ void xcd_barrier(const XcdBarrier& b, int tid) {
    asm volatile("s_waitcnt vmcnt(0)" ::: "memory");
    __syncthreads();
    if (tid == 0) {
        unsigned* bar = b.bar;
        __builtin_amdgcn_s_waitcnt(0);
        unsigned nloc = b.st[0], nx = b.st[1];
        if (nloc == 0u) { xcd_barrier_complete(bar, b.x, nloc, nx); b.st[0] = nloc; b.st[1] = nx; }
        const unsigned old = xb_add(&bar[XB_XSUB(b.x)], 1u);
        const unsigned gen = old / nloc;
        if (old + 1u == (gen + 1u) * nloc) {
            __builtin_amdgcn_fence(__ATOMIC_RELEASE, "agent");
            asm volatile("s_waitcnt vmcnt(0)" ::: "memory");
            const unsigned og = xb_add(&bar[XB_TOP], 1u);
            const unsigned tg = og / nx;
            if (og + 1u == (tg + 1u) * nx) xb_add(&bar[XB_TOPGEN], 1u);
            else XB_SPIN(xb_ld(&bar[XB_TOPGEN]) == tg, bar);
            __builtin_amdgcn_fence(__ATOMIC_ACQUIRE, "agent");
            xb_add(&bar[XB_XGEN(b.x)], 1u);
            asm volatile("s_waitcnt vmcnt(0)" ::: "memory");
        } else {
            XB_SPIN(xb_ld(&bar[XB_XGEN(b.x)]) == gen, bar);
            __builtin_amdgcn_fence(__ATOMIC_ACQUIRE, "agent");
            asm volatile("s_waitcnt vmcnt(0)" ::: "memory");
        }
    }
    __syncthreads();
}

typedef float f32x16 __attribute__((ext_vector_type(16)));
typedef float f32x2 __attribute__((ext_vector_type(2)));
typedef unsigned v2u __attribute__((ext_vector_type(2)));
typedef short s16x4 __attribute__((ext_vector_type(4)));

struct Params { const float* in[37]; float* out; unsigned char* ws; int ph_lo, ph_hi; };

__device__ __forceinline__ float bf2f(unsigned short b) { return __uint_as_float(((unsigned)b) << 16); }
__device__ __forceinline__ float bflo(unsigned w) { return __uint_as_float(w << 16); }
__device__ __forceinline__ float bfhi(unsigned w) { return __uint_as_float(w & 0xffff0000u); }
#define DPPF0(v, ctrl) __builtin_bit_cast(float, __builtin_amdgcn_update_dpp(__builtin_bit_cast(int, v), __builtin_bit_cast(int, v), ctrl, 0xf, 0xf, false))
__device__ __forceinline__ float row16_sum(float v) { v += DPPF0(v, 0xB1); v += DPPF0(v, 0x4E); v += DPPF0(v, 0x141); v += DPPF0(v, 0x140); return v; }
__device__ __forceinline__ float lane_xor16(float v, int lane) { auto rr = __builtin_amdgcn_permlane16_swap(__float_as_uint(v), __float_as_uint(v), false, false); return __uint_as_float((lane & 16) ? rr[0] : rr[1]); }
__device__ __forceinline__ float lane_xor32(float v, int lane) { auto rr = __builtin_amdgcn_permlane32_swap(__float_as_uint(v), __float_as_uint(v), false, false); return __uint_as_float((lane & 32) ? rr[0] : rr[1]); }
__device__ __forceinline__ float wave_sum(float v) {
    v = row16_sum(v);
    { auto rr = __builtin_amdgcn_permlane16_swap(__float_as_uint(v), __float_as_uint(v), false, false); v = __uint_as_float(rr[0]) + __uint_as_float(rr[1]); }
    { auto rr = __builtin_amdgcn_permlane32_swap(__float_as_uint(v), __float_as_uint(v), false, false); v = __uint_as_float(rr[0]) + __uint_as_float(rr[1]); }
    return v;
}
__device__ __forceinline__ void unpack8f(const v4u& w, float* v) { v[0] = bflo(w.x); v[1] = bfhi(w.x); v[2] = bflo(w.y); v[3] = bfhi(w.y); v[4] = bflo(w.z); v[5] = bfhi(w.z); v[6] = bflo(w.w); v[7] = bfhi(w.w); }
__device__ __forceinline__ float wave_max(float v) {
#pragma unroll
    for (int o = 1; o < 64; o <<= 1) v = fmaxf(v, __shfl_xor(v, o));
    return v;
}
__device__ __forceinline__ float dpp_f(float v, int ctrl_dummy);
#define DPPF(v, ctrl) __builtin_bit_cast(float, __builtin_amdgcn_update_dpp(__builtin_bit_cast(int, v), __builtin_bit_cast(int, v), ctrl, 0xf, 0xf, false))
__device__ __forceinline__ float half_max32(float v) {
    v = fmaxf(v, DPPF(v, 0xB1)); v = fmaxf(v, DPPF(v, 0x4E)); v = fmaxf(v, DPPF(v, 0x141)); v = fmaxf(v, DPPF(v, 0x140));
    auto rr = __builtin_amdgcn_permlane16_swap(__float_as_uint(v), __float_as_uint(v), false, false);
    return fmaxf(__uint_as_float(rr[0]), __uint_as_float(rr[1]));
}
__device__ __forceinline__ float gelu_tanh(float x) {
    const float u = 0.7978845608028654f * (x + 0.044715f * x * x * x);
    return x * __builtin_amdgcn_rcpf(1.0f + __builtin_amdgcn_exp2f(-2.8853900817779268f * u));
}
__device__ __forceinline__ float sigmoidf_(float x) { return __builtin_amdgcn_rcpf(1.0f + __builtin_amdgcn_exp2f(-1.4426950408889634f * x)); }
__device__ __forceinline__ f32x16 mfma32(bf16x8 a, bf16x8 b, f32x16 c) { return __builtin_amdgcn_mfma_f32_32x32x16_bf16(a, b, c, 0, 0, 0); }
__device__ __forceinline__ f32x4 mfma16(bf16x8 a, bf16x8 b, f32x4 c) { return __builtin_amdgcn_mfma_f32_16x16x32_bf16(a, b, c, 0, 0, 0); }
__device__ __forceinline__ int crow(int r, int hi) { return (r & 3) + 8 * (r >> 2) + 4 * hi; }
__device__ __forceinline__ bf16x8 pack8(const float* v) { v4u w; w.x = pk2(v[0], v[1]); w.y = pk2(v[2], v[3]); w.z = pk2(v[4], v[5]); w.w = pk2(v[6], v[7]); return __builtin_bit_cast(bf16x8, w); }
__device__ __forceinline__ float xhalf_sum(float v) { auto rr = __builtin_amdgcn_permlane32_swap(__float_as_uint(v), __float_as_uint(v), false, false); return __uint_as_float(rr[0]) + __uint_as_float(rr[1]); }

__device__ __forceinline__ int fresh_lane() { int l; asm volatile("v_mbcnt_lo_u32_b32 %0, -1, 0\n\tv_mbcnt_hi_u32_b32 %0, -1, %0" : "=v"(l)); return l; }
struct Ctx {
    LAS unsigned char* lds; int tid, lane, wave, G, bid;
    const Params* p;
};
#define WSP(T, off) ((T*)(P.ws + (off)))

template <bool UPPERM = false> __device__ __forceinline__ void p0_transpose_item(const float* W, int N, bf16* WT, int ldk, LAS float* scr, int nblk, int item, int lane) {
    const int kb = item / nblk, nb = item % nblk, k0 = 64 * kb, n0 = 32 * nb;
    const int d0 = UPPERM ? ((n0 < DFF) ? (256 * (n0 >> 7) + (n0 & 127)) : (256 * ((n0 - DFF) >> 7) + 128 + ((n0 - DFF) & 127))) : n0;
#pragma unroll 8
    for (int i = 0; i < 32; ++i) { const int kk = 2 * i + (lane >> 5); scr[kk * 33 + (lane & 31)] = W[(size_t)(k0 + kk) * N + n0 + (lane & 31)]; }
    LDS_WAIT(); asm volatile("" ::: "memory");
    const int c = lane & 7;
#pragma unroll
    for (int j = 0; j < 4; ++j) { const int n = (lane >> 3) + 8 * j; const LAS float* s = scr + (8 * c) * 33 + n;
        v4u o; o.x = pk2(s[0 * 33], s[1 * 33]); o.y = pk2(s[2 * 33], s[3 * 33]); o.z = pk2(s[4 * 33], s[5 * 33]); o.w = pk2(s[6 * 33], s[7 * 33]);
        *(GAS v4u*)(WT + (size_t)(d0 + n) * ldk + k0 + 8 * c) = o; }
    LDS_WAIT(); asm volatile("" ::: "memory");
}
constexpr int CW_SC = 16384;
__device__ __forceinline__ void phase_p0a(const Ctx& C, const Params& P) {
    LAS float* scr = (LAS float*)(C.lds + RING_OFF + C.wave * 16384);
    const int gw = C.bid * NWAVES + C.wave, NGW = C.G * NWAVES, lane = C.lane;
    const int gt = C.bid * 512 + C.tid, NGT = C.G * 512;
    { bf16* sc = WSP(bf16, WS_SC);
      for (int i = gt; i < 144 * 1024 / 4; i += NGT) { const int r = i >> 8, c4 = (i & 255) * 4;
          const float* src = (r < 16) ? P.in[8] + (size_t)r * 1024 : P.in[9] + (size_t)(r - 16) * 1024; const f32x4 v = *(const f32x4*)(src + c4);
          v2u o; o.x = pk2(v.x * sigmoidf_(v.x), v.y * sigmoidf_(v.y)); o.y = pk2(v.z * sigmoidf_(v.z), v.w * sigmoidf_(v.w));
          *(v2u*)(sc + (size_t)r * 1024 + c4) = o; }
      asm volatile("s_waitcnt vmcnt(0)" ::: "memory");
      __syncthreads();
      if (C.tid == 0) { __builtin_amdgcn_fence(__ATOMIC_RELEASE, "agent"); asm volatile("s_waitcnt vmcnt(0)" ::: "memory"); (void)xb_add((unsigned*)(P.ws + WS_CTL) + CW_SC, 1u); } }
    constexpr int I_IN = 16 * 45, I_UQ = 4 * 24, I_UKV = 2 * 32, I_O = 16 * 32, I_UP = 16 * 176, I_DN = 44 * 32, I_G = 32;
    constexpr int NITEMS = I_IN + I_UQ + I_UKV + I_O + I_UP + I_DN + I_G;
    for (int it = NGW - 1 - gw; it < NITEMS; it += NGW) {
        int r = it;
        if (r < I_UP) { p0_transpose_item<true>(P.in[33], UPC, WSP(bf16, WS_WUP), 1024, scr, 176, r, lane); continue; } r -= I_UP;
        if (r < I_DN) { p0_transpose_item(P.in[36], DM, WSP(bf16, WS_WDN), DFF, scr, 32, r, lane); continue; } r -= I_DN;
        if (r < I_IN) { p0_transpose_item(P.in[13], 1440, WSP(bf16, WS_WIN), 1024, scr, 45, r, lane); continue; } r -= I_IN;
        if (r < I_O) { p0_transpose_item(P.in[31], DM, WSP(bf16, WS_WO), 1024, scr, 32, r, lane); continue; } r -= I_O;
        if (r < I_UQ) { p0_transpose_item(P.in[22], 768, WSP(bf16, WS_WUQ), 256, scr, 24, r, lane); continue; } r -= I_UQ;
        if (r < I_UKV) { p0_transpose_item(P.in[27], 1024, WSP(bf16, WS_WUKV), 256, scr, 32, r, lane); continue; } r -= I_UKV;
        { const int hg = r >> 1, sub = r & 1, h = hg >> 1, gate = hg & 1;
          p0_transpose_item(P.in[gate ? 18 : 16] + (size_t)h * 4096, 64, WSP(bf16, WS_WG) + (size_t)(h * 2 + gate) * 4096, 64, scr, 2, sub, lane); }
    }
    { bf16* w = WSP(bf16, WS_WIN) + (size_t)1440 * 1024; for (int i = gt; i < 96 * 1024 / 8; i += NGT) ((v4u*)w)[i] = (v4u){0u, 0u, 0u, 0u}; }
    { bf16* w = WSP(bf16, WS_WUKV); for (int i = gt; i < 1024 * 16; i += NGT) { const int n = i >> 4, c = i & 15; *(v4u*)(w + (size_t)n * 256 + 128 + c * 8) = (v4u){0u, 0u, 0u, 0u}; } }
    { float* rt = WSP(float, WS_ROPE);
      for (int i = gt; i < 2049 * 16; i += NGT) { const int pi = i >> 4, k = i & 15; const float pos = (pi == 2048) ? 16384.0f : (float)pi;
          const float inv = powf(10000.0f, -(float)(2 * k) / 32.0f); const float ang = pos * inv; rt[2 * i] = cosf(ang); rt[2 * i + 1] = sinf(ang); } }
}

template <int NW, class Epi> __device__ __forceinline__ void skinny_gemm(const Ctx& C, const bf16* A, int lda, const bf16* Bt, int ldb, int MT, int NT, int K, const Epi& E) {
    const int gw = C.bid * NWAVES + C.wave, NGW = C.G * NWAVES, lane = C.lane;
    for (int wu = gw; wu < MT * NT; wu += NGW) {
        const int mt = wu % MT, nt = wu / MT;
        const bf16* ap = A + (size_t)(mt * 16 + (lane & 15)) * lda + 8 * (lane >> 4);
        const bf16* bp = Bt + (size_t)(nt * 16 * NW + (lane & 15)) * ldb + 8 * (lane >> 4);
        f32x4 acc[NW];
#pragma unroll
        for (int w = 0; w < NW; ++w) acc[w] = (f32x4){0.f, 0.f, 0.f, 0.f};
#pragma unroll 8
        for (int k = 0; k < K; k += 32) { const bf16x8 a = *(const bf16x8*)(ap + k);
#pragma unroll
            for (int w = 0; w < NW; ++w) { const bf16x8 b = *(const bf16x8*)(bp + (size_t)w * 16 * ldb + k); acc[w] = mfma16(a, b, acc[w]); } }
#pragma unroll
        for (int w = 0; w < NW; ++w) E(acc[w], mt, nt * NW + w, lane);
    }
}
template <class E, class = void> struct epi_rowstat { static constexpr bool value = false; };
template <class E> struct epi_rowstat<E, decltype((void)E::ROWSTAT)> { static constexpr bool value = E::ROWSTAT; };
template <int NW, class Epi> __device__ __forceinline__ void skinny_gemm_splitk(const Ctx& C, const bf16* A, int lda, const bf16* Bt, int ldb, int MT, int NTG, int K, const Epi& E) {
    const int lane = C.lane, w = C.wave, tid = C.tid, KW = K / 8;
    LAS float* part = (LAS float*)(C.lds + RING_OFF);
    for (int bu = C.bid; bu < MT * ((NTG + 7) & ~7); bu += C.G) {
        const int g8 = bu / (8 * MT), r8 = bu % (8 * MT), mt = r8 >> 3, ntg = g8 * 8 + (r8 & 7);
        if (ntg >= NTG) continue;
        const bf16* ap = A + (size_t)(mt * 16 + (lane & 15)) * lda + w * KW + 8 * (lane >> 4);
        const bf16* bp = Bt + (size_t)(ntg * 16 * NW + (lane & 15)) * ldb + w * KW + 8 * (lane >> 4);
        f32x4 acc[NW];
#pragma unroll
        for (int q = 0; q < NW; ++q) acc[q] = (f32x4){0.f, 0.f, 0.f, 0.f};
#pragma unroll 4
        for (int k = 0; k < KW; k += 32) { const bf16x8 a = *(const bf16x8*)(ap + k);
#pragma unroll
            for (int q = 0; q < NW; ++q) { const bf16x8 b = *(const bf16x8*)(bp + (size_t)q * 16 * ldb + k); acc[q] = mfma16(a, b, acc[q]); } }
#pragma unroll
        for (int q = 0; q < NW; ++q) *(LAS f32x4*)(part + ((w * NW + q) * 64 + lane) * 4) = acc[q];
        __syncthreads();
        if constexpr (epi_rowstat<Epi>::value) {
            LAS float* sq = part + 8 * NW * 256;
            for (int e = tid; e < 256 * NW; e += 512) { const int q = e >> 8, ln = (e >> 2) & 63, i = e & 3; float s = 0.f;
#pragma unroll
                for (int ww = 0; ww < 8; ++ww) s += part[((ww * NW + q) * 64 + ln) * 4 + i];
                const float v = E.elem(s, mt * 16 + 4 * (ln >> 4) + i, (ntg * NW + q) * 16 + (ln & 15)); sq[(4 * (ln >> 4) + i) * (16 * NW) + q * 16 + (ln & 15)] = v * v; }
            __syncthreads();
            if (tid < 16) { float s = 0.f; for (int k = 0; k < 16 * NW; ++k) s += sq[tid * (16 * NW) + k]; E.rowstat(mt * 16 + tid, s); }
        } else {
            for (int e = tid; e < 256 * NW; e += 512) { const int q = e >> 8, ln = (e >> 2) & 63, i = e & 3; float s = 0.f;
#pragma unroll
                for (int ww = 0; ww < 8; ++ww) s += part[((ww * NW + q) * 64 + ln) * 4 + i];
                E.elem(s, mt * 16 + 4 * (ln >> 4) + i, (ntg * NW + q) * 16 + (ln & 15)); }
        }
        __syncthreads();
    }
}
struct EpiSkBf16 { bf16* O; int ldc;
    __device__ __forceinline__ void elem(float v, int row, int col) const { O[(size_t)(MP + row) * ldc + col] = (bf16)f2bf(v); }
    __device__ __forceinline__ void operator()(const f32x4& acc, int mt, int nt, int lane) const {
#pragma unroll
        for (int i = 0; i < 4; ++i) O[(size_t)(MP + mt * 16 + 4 * (lane >> 4) + i) * ldc + nt * 16 + (lane & 15)] = (bf16)f2bf(acc[i]); } };
struct EpiSB { float* SB;
    __device__ __forceinline__ void elem(float v, int row, int col) const { if (row < 144) SB[(size_t)row * UPC + col] = v; } };
struct EpiSkUp { bf16* O; const float* rowss; const float* SB;
    __device__ __forceinline__ void elem(float v0, int row, int np) const { const float v = v0 * rsqrtf(rowss[MP + row] * (1.f / 1024.f) + EPS) + SB[(size_t)(16 + row) * UPC + np]; const int col = (np & 128) ? (DFF + 128 * (np >> 8) + (np & 127)) : (128 * (np >> 8) + (np & 127)); O[(size_t)(MP + row) * UPC + col] = (bf16)f2bf(v); }
    __device__ __forceinline__ void operator()(const f32x4& acc, int mt, int nt, int lane) const {
        const int np = nt * 16 + (lane & 15); const int col = (np & 128) ? (DFF + 128 * (np >> 8) + (np & 127)) : (128 * (np >> 8) + (np & 127));
#pragma unroll
        for (int i = 0; i < 4; ++i) O[(size_t)(MP + mt * 16 + 4 * (lane >> 4) + i) * UPC + col] = (bf16)f2bf(acc[i]); } };
template <bool BASE_BF16, bool OUT_BF16, bool XG> struct EpiSkResGate { const void* base; void* out; const float* mod; int goff; bf16* xg; const float* g2; float* rowss;
    __device__ __forceinline__ float elem(float a, int s, int c) const { const size_t o = (size_t)s * 1024 + c;
        const float bs = BASE_BF16 ? bf2f(((const bf16*)base)[o]) : ((const float*)base)[o];
        const float v = bs + mod[(size_t)(16 + s) * MODC + goff + c] * a;
        if (OUT_BF16) ((bf16*)out)[o] = (bf16)f2bf(v); else ((float*)out)[o] = v;
        if (XG) xg[o] = (bf16)f2bf(v * g2[c] * (1.0f + mod[(size_t)(16 + s) * MODC + 4096 + c]));
        return v; }
    static constexpr bool ROWSTAT = XG;
    __device__ __forceinline__ void rowstat(int s, float sumsq) const { __hip_atomic_fetch_add(rowss + s, sumsq, __ATOMIC_RELAXED, __HIP_MEMORY_SCOPE_AGENT); }
};

struct EpiMod { float* mod; const float* bias; bf16* sh2;
    __device__ __forceinline__ void elem(float v, int row, int col) const { if (row < 144) { const float o = v + bias[col]; mod[(size_t)row * MODC + col] = o; if (col >= 3072 && col < 4096) sh2[(size_t)row * 1024 + col - 3072] = (bf16)f2bf(o); } }
    __device__ __forceinline__ void operator()(const f32x4& acc, int mt, int nt, int lane) const {
        const int col = nt * 16 + (lane & 15); const float b = bias[col];
#pragma unroll
        for (int i = 0; i < 4; ++i) { const int row = mt * 16 + 4 * (lane >> 4) + i; if (row < 144) mod[(size_t)row * MODC + col] = acc[i] + b; }
    } };
__device__ __forceinline__ void phase_adaln_direct(const Ctx& C, const Params& P) {
    const int lane = C.lane, w = C.wave, tid = C.tid;
    if (C.bid >= MODC / 32) return;
    if (tid == 0) { unsigned* cnt = (unsigned*)(P.ws + WS_CTL) + CW_SC; unsigned sp = 0u;
        while (xb_ld(cnt) < (unsigned)C.G) { __builtin_amdgcn_s_sleep(1); if (++sp > (1u << 22)) break; }
        __builtin_amdgcn_fence(__ATOMIC_ACQUIRE, "agent"); asm volatile("s_waitcnt vmcnt(0)" ::: "memory"); }
    __syncthreads();
    const float* W = P.in[10]; const bf16* SC = WSP(const bf16, WS_SC);
    LAS float* part = (LAS float*)(C.lds + RING_OFF);
    EpiMod E{WSP(float, WS_MOD), P.in[11], WSP(bf16, WS_SH2)};
    for (int ng = C.bid; ng < MODC / 32; ng += C.G) {
        const int n0 = 32 * ng;
        f32x4 acc[9][2];
#pragma unroll
        for (int mt = 0; mt < 9; ++mt) { acc[mt][0] = (f32x4){0.f, 0.f, 0.f, 0.f}; acc[mt][1] = acc[mt][0]; }
        const float* wp = W + (size_t)(w * 128 + 8 * (lane >> 4)) * MODC + n0 + (lane & 15);
        const bf16* ap = SC + (size_t)(lane & 15) * 1024 + w * 128 + 8 * (lane >> 4);
        float braw[4][2][8];
#pragma unroll
        for (int ks = 0; ks < 4; ++ks)
#pragma unroll
            for (int q = 0; q < 2; ++q)
#pragma unroll
                for (int j = 0; j < 8; ++j) braw[ks][q][j] = __builtin_nontemporal_load(wp + (size_t)(32 * ks + j) * MODC + 16 * q);
#pragma unroll
        for (int ks = 0; ks < 4; ++ks) {
            bf16x8 b[2];
#pragma unroll
            for (int q = 0; q < 2; ++q) b[q] = pack8(braw[ks][q]);
#pragma unroll
            for (int mt = 0; mt < 9; ++mt) { const bf16x8 a = *(const bf16x8*)(ap + (size_t)mt * 16 * 1024 + 32 * ks);
                acc[mt][0] = mfma16(a, b[0], acc[mt][0]); acc[mt][1] = mfma16(a, b[1], acc[mt][1]); }
        }
#pragma unroll
        for (int q = 0; q < 2; ++q) {
#pragma unroll
            for (int mt = 0; mt < 9; ++mt) *(LAS f32x4*)(part + ((w * 9 + mt) * 64 + lane) * 4) = acc[mt][q];
            __syncthreads();
#pragma unroll
            for (int t = 0; t < 5; ++t) { const int e = tid + 512 * t;
                if (e < 9 * 256) { const int mt = e >> 8, ln = (e >> 2) & 63, i = e & 3; float sum = 0.f;
#pragma unroll
                    for (int ww = 0; ww < 8; ++ww) sum += part[((ww * 9 + mt) * 64 + ln) * 4 + i];
                    E.elem(sum, mt * 16 + 4 * (ln >> 4) + i, n0 + 16 * q + (ln & 15)); } }
            __syncthreads();
        }
    }
}

__device__ __forceinline__ const float* mod_row(const Params& P, int r) { return WSP(const float, WS_MOD) + (size_t)((r < MP) ? (r >> 11) : (16 + r - MP)) * MODC; }
template <bool SECOND> __device__ __forceinline__ void phase_norm_mod(const Ctx& C, const Params& P) {
    const int gw = C.bid * NWAVES + C.wave, NGW = C.G * NWAVES, lane = C.lane;
    const float* g = P.in[SECOND ? 32 : 12]; bf16* H = WSP(bf16, WS_H1);
    constexpr int SH = SECOND ? 3072 : 0, SC = SECOND ? 4096 : 1024;
    for (int r0 = gw; r0 < MR; r0 += 2 * NGW) {
        f32x4 v[2][4]; int rr[2];
#pragma unroll
        for (int u = 0; u < 2; ++u) { const int r = (r0 + u * NGW < MR) ? r0 + u * NGW : r0; rr[u] = r;
            if (r < MREAL) {
                if (SECOND) { const bf16* xb = WSP(const bf16, WS_X1) + (size_t)r * 1024;
#pragma unroll
                    for (int j = 0; j < 4; ++j) { const v2u w = *((const v2u*)xb + lane + 64 * j); v[u][j] = (f32x4){bflo(w.x), bfhi(w.x), bflo(w.y), bfhi(w.y)}; } }
                else { const float* xr = (r < MP) ? P.in[0] + (size_t)r * 1024 : P.in[1] + (size_t)(r - MP) * 1024;
#pragma unroll
                    for (int j = 0; j < 4; ++j) v[u][j] = *((const f32x4*)xr + lane + 64 * j); } }
            else {
#pragma unroll
                for (int j = 0; j < 4; ++j) v[u][j] = (f32x4){0.f, 0.f, 0.f, 0.f}; } }
#pragma unroll
        for (int u = 0; u < 2; ++u) { const int r = rr[u];
            GAS unsigned long long* o8 = (GAS unsigned long long*)(H + (size_t)r * 1024) + lane;
            if (r >= MREAL) {
#pragma unroll
                for (int j = 0; j < 4; ++j) o8[64 * j] = 0ull;
                continue; }
            const float* md = mod_row(P, r);
            float s = 0.f;
#pragma unroll
            for (int j = 0; j < 4; ++j) s += (v[u][j].x * v[u][j].x + v[u][j].y * v[u][j].y) + (v[u][j].z * v[u][j].z + v[u][j].w * v[u][j].w);
            const float rstd = rsqrtf(wave_sum(s) * (1.f / 1024.f) + EPS);
#pragma unroll
            for (int j = 0; j < 4; ++j) { const int c = 4 * (lane + 64 * j);
                const f32x4 gg = *(const f32x4*)(g + c), sc = *(const f32x4*)(md + SC + c), sh = *(const f32x4*)(md + SH + c);
                const f32x4 h = v[u][j] * rstd * gg * (sc + 1.0f) + sh;
                o8[64 * j] = (unsigned long long)pk2(h.x, h.y) | ((unsigned long long)pk2(h.z, h.w) << 32); }
        }
    }
}

__device__ __forceinline__ void phase_p3a(const Ctx& C, const Params& P) {
    const int gw = C.bid * NWAVES + C.wave, NGW = C.G * NWAVES, lane = C.lane;
    const bf16* Z = WSP(const bf16, WS_Z); bf16* QN = WSP(bf16, WS_QN); bf16* KVN = WSP(bf16, WS_KVN); bf16* KR = WSP(bf16, WS_KR);
    const float* rope = WSP(const float, WS_ROPE);
    const f32x4 gq = *(const f32x4*)(P.in[21] + 4 * lane); const f32x2 gkv = *(const f32x2*)(P.in[25] + 2 * lane); const float gkr = P.in[26][lane & 31];
    for (int r0 = gw; r0 < MREAL; r0 += 2 * NGW) {
        v2u wq[2]; unsigned wk[2]; unsigned short wr[2]; v4u wx[2]; int rr[2];
#pragma unroll
        for (int u = 0; u < 2; ++u) { const int r = (r0 + u * NGW < MREAL) ? r0 + u * NGW : r0; rr[u] = r; const bf16* z = Z + (size_t)r * ZC;
            wq[u] = *(const v2u*)(z + 1024 + 4 * lane); wk[u] = *(const unsigned*)(z + 1280 + 2 * lane); wr[u] = z[1408 + (lane & 31)];
            wx[u] = (v4u){0u, 0u, 0u, 0u}; if (r >= MP || (r & 2047) >= 2045) wx[u] = *(const v4u*)(z + 8 * lane); }
#pragma unroll
        for (int u = 0; u < 2; ++u) { const int r = rr[u];
            const bool smp = r >= MP; const int s_ = r - MP, b = r >> 11, t = r & 2047;
            { const float a0 = bflo(wq[u].x), a1 = bfhi(wq[u].x), a2 = bflo(wq[u].y), a3 = bfhi(wq[u].y);
              const float rstd = rsqrtf(wave_sum(a0 * a0 + a1 * a1 + a2 * a2 + a3 * a3) * (1.f / 256.f) + EPS);
              v2u o; o.x = pk2(a0 * rstd * gq.x, a1 * rstd * gq.y); o.y = pk2(a2 * rstd * gq.z, a3 * rstd * gq.w); *(v2u*)(QN + (size_t)r * 256 + 4 * lane) = o; }
            { const float a0 = bflo(wk[u]), a1 = bfhi(wk[u]);
              const float rstd = rsqrtf(wave_sum(a0 * a0 + a1 * a1) * (1.f / 128.f) + EPS);
              const float o0 = a0 * rstd * gkv.x, o1 = a1 * rstd * gkv.y;
              float* dst = P.out + (smp ? O_KVS + (size_t)s_ * 128 : O_KVP + (size_t)r * 128); *(f32x2*)(dst + 2 * lane) = (f32x2){o0, o1};
              *(unsigned*)(KVN + (size_t)r * 256 + 2 * lane) = pk2(o0, o1); *(unsigned*)(KVN + (size_t)r * 256 + 128 + 2 * lane) = 0u; }
            { const float a = (lane < 32) ? bf2f(wr[u]) : 0.f; const float rstd = rsqrtf(wave_sum(a * a) * (1.f / 32.f) + EPS);
              const float v = a * rstd * gkr; const float pr = lane_xor16(v, lane);
              const f32x2 cs = *(const f32x2*)(rope + ((size_t)(smp ? 2048 : t) * 16 + (lane & 15)) * 2);
              const float o = (lane & 16) ? (v * cs.x + pr * cs.y) : (v * cs.x - pr * cs.y);
              if (lane < 32) { float* dst = P.out + (smp ? O_KRS + (size_t)s_ * 32 : O_KRP + (size_t)r * 32); dst[lane] = o; KR[(size_t)r * 32 + lane] = (bf16)f2bf(o); } }
            const v4u w = wx[u];
            if (smp) { float* d2 = P.out + O_LCS + (size_t)s_ * 1536; const float* st = P.in[5] + (size_t)s_ * 1536;
                *(f32x4*)(d2 + 8 * lane) = *(const f32x4*)(st + 512 + 8 * lane); *(f32x4*)(d2 + 8 * lane + 4) = *(const f32x4*)(st + 512 + 8 * lane + 4);
                *(f32x4*)(d2 + 512 + 8 * lane) = *(const f32x4*)(st + 1024 + 8 * lane); *(f32x4*)(d2 + 512 + 8 * lane + 4) = *(const f32x4*)(st + 1024 + 8 * lane + 4);
                *(f32x4*)(d2 + 1024 + 8 * lane) = (f32x4){bflo(w.x), bfhi(w.x), bflo(w.y), bfhi(w.y)}; *(f32x4*)(d2 + 1024 + 8 * lane + 4) = (f32x4){bflo(w.z), bfhi(w.z), bflo(w.w), bfhi(w.w)}; }
            else if (t >= 2045) { float* d2 = P.out + O_LCP + ((size_t)b * 3 + (t - 2045)) * 512;
                *(f32x4*)(d2 + 8 * lane) = (f32x4){bflo(w.x), bfhi(w.x), bflo(w.y), bfhi(w.y)}; *(f32x4*)(d2 + 8 * lane + 4) = (f32x4){bflo(w.z), bfhi(w.z), bflo(w.w), bfhi(w.w)}; }
        }
    }
}

template <bool SMP> __device__ __forceinline__ void phase_p3b(const Ctx& C, const Params& P) {
    LAS float* L = (LAS float*)(C.lds + RING_OFF);
    for (int i = C.tid; i < 2048; i += 512) L[i] = P.in[14][i];
    { const int i = C.tid; L[2048 + i] = P.in[15][i]; L[2560 + i] = P.in[17][i]; L[3072 + i] = P.in[19][i];
      const float nl = -P.in[20][i]; L[3584 + i] = fmaxf(nl, 0.f) + log1pf(__expf(-fabsf(nl))); }
    __syncthreads();
    const int lane0 = C.lane, h = C.wave;
    const bf16* Z = WSP(const bf16, WS_Z); bf16* HL = WSP(bf16, WS_HL); bf16* AC = WSP(bf16, WS_AC); float* SUM = WSP(float, WS_SUM);
    const bf16* WG = WSP(const bf16, WS_WG);
    bf16x8 idf[2];
#pragma unroll
    for (int s2 = 0; s2 < 2; ++s2) { bf16x8 f;
#pragma unroll
        for (int j = 0; j < 8; ++j) f[j] = (16 * s2 + 8 * (lane0 >> 5) + j == (lane0 & 31)) ? (short)0x3F80 : (short)0;
        idf[s2] = f; }
    const int NIT = SMP ? 4 : NBATCH * 32;
    for (int it0 = C.bid; it0 < NIT; it0 += C.G) {
        constexpr bool smp = SMP; const int it = SMP ? it0 + NBATCH * 32 : it0;
        int lane = lane0; asm volatile("" : "+v"(lane));
        const int tk = lane & 31, hh = lane >> 5;
        const int b = it >> 5, chunk = it & 31;
        float carP[2] = {1.f, 1.f}, carS[2] = {0.f, 0.f};
#pragma unroll 1
        for (int sub = 0; sub < (smp ? 1 : 2); ++sub) {
            const int t0 = smp ? 0 : chunk * 64 + sub * 32;
            const int sq = (it - NBATCH * 32) * 32;
            const size_t rowA = smp ? (size_t)(MP + sq + tk) : (size_t)b * SEQ + t0 + tk;
            bf16x8 af[4];
            int hhc = hh; asm volatile("" : "+v"(hhc));
            v4u zn[4];
#define P3B_LOADZ(s_) do { const int chn_ = 64 * h + 16 * (s_) + 8 * hhc; _Pragma("unroll") for (int tap = 0; tap < 4; ++tap) { const int tt = t0 + tk - 3 + tap; zn[tap] = (v4u){0u, 0u, 0u, 0u}; \
                if (!(smp && tap < 3) && (smp || tt >= 0)) zn[tap] = *(const v4u*)(Z + (rowA - 3 + tap) * ZC + chn_); } } while (0)
            P3B_LOADZ(0);
#pragma unroll
            for (int s = 0; s < 4; ++s) {
                const int ch0 = 64 * h + 16 * s + 8 * hhc;
                v4u zc[4];
#pragma unroll
                for (int tap = 0; tap < 4; ++tap) zc[tap] = zn[tap];
                if (s < 3) P3B_LOADZ(s + 1);
                float xc[8];
#pragma unroll
                for (int j = 0; j < 8; ++j) xc[j] = L[2048 + ch0 + j];
#pragma unroll
                for (int tap = 0; tap < 4; ++tap) {
                    float xv[8];
                    if (smp && tap < 3) { const float* st = P.in[5] + ((size_t)(sq + tk) * 3 + tap) * 512 + ch0; const f32x4 a = *(const f32x4*)st, bq = *(const f32x4*)(st + 4);
                        xv[0] = a.x; xv[1] = a.y; xv[2] = a.z; xv[3] = a.w; xv[4] = bq.x; xv[5] = bq.y; xv[6] = bq.z; xv[7] = bq.w; }
                    else unpack8f(zc[tap], xv);
#pragma unroll
                    for (int j = 0; j < 8; ++j) xc[j] += L[tap * 512 + ch0 + j] * xv[j];
                }
                af[s] = pack8(xc);
                asm volatile("" ::: "memory"); __builtin_amdgcn_sched_barrier(0);
            }
#undef P3B_LOADZ
#pragma unroll 1
            for (int cb = 0; cb < 2; ++cb) {
                f32x16 ra = {}, ia = {}, xq = {};
                { unsigned woff = (unsigned)(((h * 2) * 64 + 32 * cb + tk) * 64 + 8 * hh); asm volatile("" : "+v"(woff));
                  const bf16* wp = WG + woff;
#pragma unroll
                  for (int s = 0; s < 4; ++s) { const bf16x8 wa = *(const bf16x8*)(wp + 16 * s), wx = *(const bf16x8*)(wp + 4096 + 16 * s); ra = mfma32(af[s], wa, ra); ia = mfma32(af[s], wx, ia); } }
                { const bf16x8 afa = cb ? af[2] : af[0], afb = cb ? af[3] : af[1]; xq = mfma32(afa, idf[0], xq); xq = mfma32(afb, idf[1], xq); }
                const int ch = 64 * h + 32 * cb + tk;
                const float spc = L[3584 + ch], bac = L[2560 + ch], bxc = L[3072 + ch];
                float av[16], hv[16];
#pragma unroll
                for (int rr = 0; rr < 16; ++rr) {
                    const float rg = sigmoidf_(ra[rr] + bac), ig = sigmoidf_(ia[rr] + bxc);
                    const float la = -8.0f * spc * rg; const float a = __builtin_amdgcn_exp2f(1.4426950408889634f * la);
                    const float x2 = 2.0f * la;
                    const float ser = -x2 * (1.0f + x2 * (0.5f + x2 * (0.16666667f + x2 * (0.041666668f + x2 * (0.008333334f + x2 * 0.0013888889f)))));
                    float mult = __builtin_amdgcn_sqrtf(x2 > -0.25f ? ser : 1.0f - a * a);
                    if (!smp && (t0 + crow(rr, hh)) == 0) mult = 1.0f;
                    av[rr] = a; hv[rr] = mult * ig * xq[rr];
                    if ((rr & 3) == 3) __builtin_amdgcn_sched_barrier(0);
                }
                if (smp) {
#pragma unroll
                    for (int rr = 0; rr < 16; ++rr) { const int sI = sq + crow(rr, hh); const float h0 = P.in[4][(size_t)sI * 512 + ch];
                        const float hn = av[rr] * h0 + hv[rr]; P.out[O_LHS + (size_t)sI * 512 + ch] = hn;
                        HL[(size_t)(MP + sI) * 512 + ch] = (bf16)f2bf(hn); AC[(size_t)(MP + sI) * 512 + ch] = (bf16)0; }
                } else {
#pragma unroll
                    for (int gi = 0; gi < 4; ++gi)
#pragma unroll
                        for (int j = 1; j < 4; ++j) { hv[4 * gi + j] = av[4 * gi + j] * hv[4 * gi + j - 1] + hv[4 * gi + j]; av[4 * gi + j] = av[4 * gi + j] * av[4 * gi + j - 1]; }
                    float Pc = cb ? carP[1] : carP[0], Sc = cb ? carS[1] : carS[0];
#pragma unroll
                    for (int gi = 0; gi < 4; ++gi) {
                        const float oA = av[4 * gi + 3], oH = hv[4 * gi + 3];
                        const float pA = lane_xor32(oA, lane), pH = lane_xor32(oH, lane);
                        const float loA = hh ? pA : oA, loH = hh ? pH : oH, hiA = hh ? oA : pA, hiH = hh ? oH : pH;
                        const float S1 = loH + loA * Sc, P1 = loA * Pc;
                        const float Sin = hh ? S1 : Sc, Pin = hh ? P1 : Pc;
#pragma unroll
                        for (int j = 0; j < 4; ++j) { const int rr = 4 * gi + j; hv[rr] = hv[rr] + av[rr] * Sin; av[rr] = av[rr] * Pin; }
                        Sc = hiH + hiA * S1; Pc = hiA * P1;
                    }
                    if (cb) { carP[1] = Pc; carS[1] = Sc; } else { carP[0] = Pc; carS[0] = Sc; }
                    { const unsigned ob = (unsigned)(((b * SEQ + t0 + 4 * hh) * 512 + ch) * 2);
#pragma unroll
                      for (int rr = 0; rr < 16; ++rr) { const unsigned o2 = ob + (unsigned)(((rr & 3) + 8 * (rr >> 2)) * 1024);
                          const unsigned w2 = pk2(hv[rr], av[rr]); *(bf16*)((char*)HL + o2) = (bf16)w2; *(bf16*)((char*)AC + o2) = (bf16)(w2 >> 16); } }
                }
            }
        }
        if (!smp) { int lq = lane; asm volatile("" : "+v"(lq));
            if (lq < 32) {
#pragma unroll
                for (int cb = 0; cb < 2; ++cb) { const int ch = 64 * h + 32 * cb + lq; *(f32x2*)(SUM + (((size_t)b * 32 + chunk) * 512 + ch) * 2) = (f32x2){carP[cb], carS[cb]}; } }
        }
    }
    __syncthreads();
}

__device__ __forceinline__ float g8_sum(float v) { v += DPPF0(v, 0xB1); v += DPPF0(v, 0x4E); v += DPPF0(v, 0x141); return v; }
__device__ __forceinline__ void phase_p5(const Ctx& C, const Params& P) {
    const int gw = C.bid * NWAVES + C.wave, NGW = C.G * NWAVES, lane = C.lane, hd = lane >> 3, sub = lane & 7;
    const bf16* QRAW = WSP(const bf16, WS_QRAW); const bf16* KVRAW = WSP(const bf16, WS_KVRAW); const bf16* KR = WSP(const bf16, WS_KR);
    bf16* Q = WSP(bf16, WS_Q); bf16* KF = WSP(bf16, WS_KF);
    const float* rope = WSP(const float, WS_ROPE);
    float gkn[8];
#pragma unroll
    for (int j = 0; j < 8; ++j) gkn[j] = P.in[28][8 * sub + j];
    for (int r0 = gw; r0 < MREAL; r0 += 4 * NGW) {
        v4u wkn[4]; v2u wkr[4]; int rr[4];
#pragma unroll
        for (int u = 0; u < 4; ++u) { const int r = (r0 + u * NGW < MREAL) ? r0 + u * NGW : r0; rr[u] = r;
            wkn[u] = *(const v4u*)(KVRAW + (size_t)r * 1024 + hd * 128 + 8 * sub); wkr[u] = *(const v2u*)(KR + (size_t)r * 32 + 4 * sub); }
#pragma unroll
        for (int u = 0; u < 4; ++u) { const int r = rr[u];
            float v[8]; unpack8f(wkn[u], v); float ss = 0.f;
#pragma unroll
            for (int j = 0; j < 8; ++j) ss += v[j] * v[j];
            const float rstd = rsqrtf(g8_sum(ss) * (1.f / 64.f) + EPS);
#pragma unroll
            for (int j = 0; j < 8; ++j) v[j] = v[j] * rstd * gkn[j];
            *(bf16x8*)(KF + (size_t)r * 768 + hd * 96 + 8 * sub) = pack8(v);
            *(v2u*)(KF + (size_t)r * 768 + hd * 96 + 64 + 4 * sub) = wkr[u];
        }
    }
    for (int r = MP + gw; r < MREAL; r += NGW) {
        const bf16* q = QRAW + (size_t)r * 768 + hd * 96;
        float v[8]; unpack8f(*(const v4u*)(q + 8 * sub), v); float ss = 0.f;
#pragma unroll
        for (int j = 0; j < 8; ++j) ss += v[j] * v[j];
        const float rstd = rsqrtf(g8_sum(ss) * (1.f / 64.f) + EPS) * C2;
#pragma unroll
        for (int j = 0; j < 8; ++j) v[j] = v[j] * rstd * P.in[23][8 * sub + j];
        *(bf16x8*)(Q + (size_t)r * 768 + hd * 96 + 8 * sub) = pack8(v);
        const v2u wq = *(const v2u*)(q + 64 + 4 * sub); float x[4] = {bflo(wq.x), bfhi(wq.x), bflo(wq.y), bfhi(wq.y)};
        const float rs2 = rsqrtf(g8_sum(x[0] * x[0] + x[1] * x[1] + x[2] * x[2] + x[3] * x[3]) * (1.f / 32.f) + EPS);
        float o[4];
#pragma unroll
        for (int j = 0; j < 4; ++j) { const float me = x[j] * rs2 * P.in[24][4 * sub + j]; const float pr = __shfl_xor(me, 4);
            const f32x2 cs = *(const f32x2*)(rope + ((size_t)2048 * 16 + 4 * (sub & 3) + j) * 2);
            o[j] = ((sub & 4) ? (me * cs.x + pr * cs.y) : (me * cs.x - pr * cs.y)) * C2; }
        v2u ow; ow.x = pk2(o[0], o[1]); ow.y = pk2(o[2], o[3]); *(v2u*)(Q + (size_t)r * 768 + hd * 96 + 64 + 4 * sub) = ow;
    }
}

__device__ __forceinline__ void phase_carry(const Ctx& C, const Params& P) {
    const float* SUM = WSP(const float, WS_SUM); float* CAR = WSP(float, WS_CARRY);
    const int t = C.tid; if (t >= 32) return;
    for (int idx = C.bid * 32 + t; idx < NBATCH * 512; idx += C.G * 32) {
        const int b = idx >> 9, ch = idx & 511; f32x2 ps[32];
#pragma unroll
        for (int k = 0; k < 32; ++k) ps[k] = *(const f32x2*)(SUM + (((size_t)b * 32 + k) * 512 + ch) * 2);
        float H = 0.f;
#pragma unroll
        for (int k = 0; k < 32; ++k) { CAR[((size_t)b * 32 + k) * 512 + ch] = H; H = ps[k].x * H + ps[k].y; }
        P.out[O_LHP + idx] = H;
    }
}

constexpr int KT_PITCH = 208, VT_PITCH = 192;
constexpr int KT_BYTES = 64 * KT_PITCH, VT_BYTES = 64 * VT_PITCH, ATT_BUF = KT_BYTES + VT_BYTES;
__device__ __forceinline__ s16x4 tr_read(unsigned addr) { s16x4 r; asm volatile("ds_read_b64_tr_b16 %0, %1\n\ts_waitcnt lgkmcnt(0)" : "=&v"(r) : "v"(addr) : "memory"); return r; }
__device__ __forceinline__ void attn_unit(const Ctx& C, const Params& P, int bh, int qb) {
    const int lane = C.lane, wid = C.wave, tid = C.tid, r32 = lane & 31, hh = lane >> 5;
    const int b = bh >> 3, h = bh & 7;
    const bf16* QRAW = WSP(const bf16, WS_QRAW); const bf16* KF = WSP(const bf16, WS_KF); const bf16* KVRAW = WSP(const bf16, WS_KVRAW); bf16* ATT = WSP(bf16, WS_ATT);
    const size_t rowbase = (size_t)b * SEQ; const int q0 = qb * 256 + wid * 32;
    const unsigned lds0 = (unsigned)(uintptr_t)(C.lds + RING_OFF);
    bf16x8 qf[6];
    { float qv[6][8];
#pragma unroll
      for (int s = 0; s < 6; ++s) { const v4u w = *(const v4u*)(QRAW + (rowbase + q0 + r32) * 768 + h * 96 + 16 * s + 8 * hh); unpack8f(w, qv[s]); }
      float sn = 0.f, sr = 0.f;
#pragma unroll
      for (int j = 0; j < 8; ++j) { sn += qv[0][j] * qv[0][j] + qv[1][j] * qv[1][j] + qv[2][j] * qv[2][j] + qv[3][j] * qv[3][j]; sr += qv[4][j] * qv[4][j] + qv[5][j] * qv[5][j]; }
      const float rn = rsqrtf(xhalf_sum(sn) * (1.f / 64.f) + EPS) * C2, rr = rsqrtf(xhalf_sum(sr) * (1.f / 32.f) + EPS);
      const float* gqn = P.in[23]; const float* gqr = P.in[24]; const float* rope = WSP(const float, WS_ROPE) + (size_t)(q0 + r32) * 32;
#pragma unroll
      for (int s = 0; s < 4; ++s) {
#pragma unroll
          for (int j = 0; j < 8; ++j) qv[s][j] *= rn * gqn[16 * s + 8 * hh + j];
          qf[s] = pack8(qv[s]); }
#pragma unroll
      for (int j = 0; j < 8; ++j) { const int i = 8 * hh + j; const float x1 = qv[4][j] * rr * gqr[i], x2 = qv[5][j] * rr * gqr[16 + i]; const f32x2 cs = *(const f32x2*)(rope + 2 * i);
          qv[4][j] = (x1 * cs.x - x2 * cs.y) * C2; qv[5][j] = (x2 * cs.x + x1 * cs.y) * C2; }
      qf[4] = pack8(qv[4]); qf[5] = pack8(qv[5]); }
    const int NT = 4 * (qb + 1);
    const int kc0 = tid, kr0 = kc0 / 12, kk0 = kc0 % 12, kc1 = 512 + tid, kr1 = kc1 / 12, kk1 = kc1 % 12; const bool k2 = tid < 256;
    const int vr = tid >> 3, vk = tid & 7;
    const bf16* kg0 = KF + (rowbase + kr0) * 768 + h * 96 + kk0 * 8; const bf16* kg1 = KF + (rowbase + kr1) * 768 + h * 96 + kk1 * 8;
    const bf16* vg = KVRAW + (rowbase + vr) * 1024 + h * 128 + 64 + vk * 8;
    v4u sk0, sk1 = (v4u){0u, 0u, 0u, 0u}, sv;
    sk0 = *(const v4u*)kg0; if (k2) sk1 = *(const v4u*)kg1; sv = *(const v4u*)vg;
    { LAS unsigned char* bufp = C.lds + RING_OFF; *(LAS v4u*)(bufp + kr0 * KT_PITCH + kk0 * 16) = sk0; if (k2) *(LAS v4u*)(bufp + kr1 * KT_PITCH + kk1 * 16) = sk1; *(LAS v4u*)(bufp + KT_BYTES + vr * VT_PITCH + vk * 16) = sv; }
    __syncthreads();
    float m_run = -INFINITY, l_run = 0.f; f32x16 o[2]; o[0] = f32x16{}; o[1] = f32x16{};
    for (int t = 0; t < NT; ++t) {
        const int cur = t & 1; const bool more = (t + 1 < NT);
        if (more) { const size_t adv = (size_t)(t + 1) * 64; sk0 = *(const v4u*)(kg0 + adv * 768); if (k2) sk1 = *(const v4u*)(kg1 + adv * 768); sv = *(const v4u*)(vg + adv * 1024); }
        LAS unsigned char* Kb = C.lds + RING_OFF + cur * ATT_BUF; const unsigned Vb = lds0 + cur * ATT_BUF + KT_BYTES;
        if (64 * t <= q0 + 31) {
        f32x16 p[2];
#pragma unroll
        for (int kh = 0; kh < 2; ++kh) { f32x16 acc = f32x16{};
#pragma unroll
            for (int s = 0; s < 6; ++s) { const bf16x8 kf = *(const LAS bf16x8*)(Kb + (32 * kh + r32) * KT_PITCH + (16 * s + 8 * hh) * 2); acc = mfma32(kf, qf[s], acc); }
            p[kh] = acc; }
        s16x4 vl[2][2][2], vh[2][2][2];
        { const int i16 = lane & 15, q4 = i16 >> 2, p4 = i16 & 3, blk = (lane >> 4) & 1;
          const unsigned a0 = Vb + (4 * hh + q4) * VT_PITCH + (16 * blk + 4 * p4) * 2;
#define TRV(kh, s2) asm volatile("ds_read_b64_tr_b16 %0, %4 offset:%5\n\tds_read_b64_tr_b16 %1, %4 offset:%6\n\tds_read_b64_tr_b16 %2, %4 offset:%7\n\tds_read_b64_tr_b16 %3, %4 offset:%8" \
              : "=&v"(vl[kh][s2][0]), "=&v"(vh[kh][s2][0]), "=&v"(vl[kh][s2][1]), "=&v"(vh[kh][s2][1]) : "v"(a0), "i"((32 * kh + 16 * s2) * VT_PITCH), "i"((32 * kh + 16 * s2 + 8) * VT_PITCH), \
                "i"((32 * kh + 16 * s2) * VT_PITCH + 64), "i"((32 * kh + 16 * s2 + 8) * VT_PITCH + 64) : "memory")
          TRV(0, 0); TRV(0, 1); TRV(1, 0); TRV(1, 1);
#undef TRV
        }
        if (64 * t + 63 > q0) { const int qq = q0 + r32;
#pragma unroll
            for (int kh = 0; kh < 2; ++kh)
#pragma unroll
                for (int r = 0; r < 16; ++r) if (64 * t + 32 * kh + crow(r, hh) > qq) p[kh][r] = -INFINITY; }
        float mx = p[0][0];
#pragma unroll
        for (int r = 1; r < 16; ++r) mx = fmaxf(mx, p[0][r]);
#pragma unroll
        for (int r = 0; r < 16; ++r) mx = fmaxf(mx, p[1][r]);
        { auto rr = __builtin_amdgcn_permlane32_swap(__float_as_uint(mx), __float_as_uint(mx), false, false); mx = fmaxf(__uint_as_float(rr[0]), __uint_as_float(rr[1])); }
        const float m_new = fmaxf(m_run, mx); const float alpha = __builtin_amdgcn_exp2f(m_run - m_new); m_run = m_new;
        float ps = 0.f;
#pragma unroll
        for (int kh = 0; kh < 2; ++kh)
#pragma unroll
            for (int r = 0; r < 16; ++r) { const float e = __builtin_amdgcn_exp2f(p[kh][r] - m_new); p[kh][r] = e; ps += e; }
        l_run = l_run * alpha + ps;
#pragma unroll
        for (int dt = 0; dt < 2; ++dt)
#pragma unroll
            for (int r = 0; r < 16; ++r) o[dt][r] *= alpha;
        asm volatile("s_waitcnt lgkmcnt(0)" : "+v"(vl[0][0][0]), "+v"(vh[0][0][0]), "+v"(vl[0][0][1]), "+v"(vh[0][0][1]), "+v"(vl[0][1][0]), "+v"(vh[0][1][0]), "+v"(vl[0][1][1]), "+v"(vh[0][1][1]),
                     "+v"(vl[1][0][0]), "+v"(vh[1][0][0]), "+v"(vl[1][0][1]), "+v"(vh[1][0][1]), "+v"(vl[1][1][0]), "+v"(vh[1][1][0]), "+v"(vl[1][1][1]), "+v"(vh[1][1][1]) :: "memory");
#pragma unroll
        for (int kh = 0; kh < 2; ++kh)
#pragma unroll
            for (int s2 = 0; s2 < 2; ++s2) {
                float pv[8];
#pragma unroll
                for (int j = 0; j < 8; ++j) pv[j] = p[kh][8 * s2 + j];
                const bf16x8 pf = pack8(pv);
                o[0] = mfma32(__builtin_shufflevector(vl[kh][s2][0], vh[kh][s2][0], 0, 1, 2, 3, 4, 5, 6, 7), pf, o[0]);
                o[1] = mfma32(__builtin_shufflevector(vl[kh][s2][1], vh[kh][s2][1], 0, 1, 2, 3, 4, 5, 6, 7), pf, o[1]);
            }
        }
        if (more) { LAS unsigned char* nb = C.lds + RING_OFF + (cur ^ 1) * ATT_BUF;
            *(LAS v4u*)(nb + kr0 * KT_PITCH + kk0 * 16) = sk0; if (k2) *(LAS v4u*)(nb + kr1 * KT_PITCH + kk1 * 16) = sk1; *(LAS v4u*)(nb + KT_BYTES + vr * VT_PITCH + vk * 16) = sv; }
        __syncthreads();
    }
    const float linv = 1.0f / xhalf_sum(l_run);
    bf16* orow = ATT + (rowbase + q0 + r32) * 512 + h * 64;
#pragma unroll
    for (int dt = 0; dt < 2; ++dt)
#pragma unroll
        for (int g = 0; g < 4; ++g) { v2u w; w.x = pk2(o[dt][4 * g] * linv, o[dt][4 * g + 1] * linv); w.y = pk2(o[dt][4 * g + 2] * linv, o[dt][4 * g + 3] * linv);
            *(v2u*)(orow + 32 * dt + 8 * g + 4 * hh) = w; }
}
__device__ __forceinline__ void phase_attn_prompt(const Ctx& C, const Params& P) {
    for (int pi = C.bid; pi < 512; pi += C.G) {
        const int bh = pi >> 2, pr = pi & 3;
        attn_unit(C, P, bh, 7 - pr);
        attn_unit(C, P, bh, pr);
    }
}

constexpr int LK_PITCH = 272, LT_PITCH = 272, LKR_PITCH = 80;
constexpr int SA_LK = 0, SA_LT = 128 * LK_PITCH, SA_LT_BUF = 128 * LT_PITCH, SA_KR = SA_LT + 2 * SA_LT_BUF, SA_P = SA_KR + 128 * LKR_PITCH, SA_P_BUF = 8 * 256, SA_AL = SA_P + 2 * SA_P_BUF, SA_QG = SA_AL + 2 * 32, SA_END = SA_QG + 8 * 256;
static_assert(SA_END <= RING_BYTES, "sample attention LDS");
constexpr int PART_STRIDE = 8 * 132;
__device__ __forceinline__ float xhalf_sum_pl(float v) { auto rr = __builtin_amdgcn_permlane32_swap(__float_as_uint(v), __float_as_uint(v), false, false); return __uint_as_float(rr[0]) + __uint_as_float(rr[1]); }
__device__ __forceinline__ void phase_attn_sample(const Ctx& C, const Params& P) {
    const int lane = C.lane, h = C.wave, tid = C.tid, r32 = lane & 31, hh = lane >> 5;
    const bf16* WUKV = WSP(const bf16, WS_WUKV); const bf16* Q = WSP(const bf16, WS_Q); float* PART = WSP(float, WS_PART);
    const float* cache_lat = P.in[2]; const float* cache_kr = P.in[3]; const int* ptab = (const int*)P.in[7]; const float* gkn = P.in[28];
    LAS unsigned char* S = C.lds + RING_OFF;
    bf16x8 wk[2][8];
#pragma unroll
    for (int rt = 0; rt < 2; ++rt)
#pragma unroll
        for (int s = 0; s < 8; ++s) wk[rt][s] = *(const bf16x8*)(WUKV + (size_t)(h * 128 + 32 * rt + r32) * 256 + 16 * s + 8 * hh);
    const int kg = tid >> 5, dq = tid & 31;
    for (int u = C.bid; u < 256; u += C.G) {
        const int sq = u >> 1, half = u & 1; const size_t qrow = (size_t)(MP + sq);
        { const int l2 = fresh_lane(); *(LAS float*)(S + SA_QG + h * 256 + l2 * 4) = bf2f(Q[qrow * 768 + h * 96 + l2]) * gkn[l2]; }
        bf16x8 qv[2];
        { const bf16x8 qfr = *(const bf16x8*)(Q + qrow * 768 + h * 96 + 64 + 8 * (lane >> 4));
          qv[0] = ((lane & 7) == 0) ? qfr : bf16x8{}; qv[1] = ((lane & 7) == 4) ? qfr : bf16x8{}; }
        float m_run = -INFINITY, l_run = 0.f; f32x4 ctx = (f32x4){0.f, 0.f, 0.f, 0.f};
        f32x4 pl[8]; f32x4 pk[2];
        const int pgs = ptab[sq * NPAGES + half * 64 + lane];
#define SA_PREFETCH(pgidx) do { const int pg_ = __builtin_amdgcn_readlane(pgs, (pgidx)); \
          const char* lb_ = (const char*)(cache_lat + (size_t)pg_ * (PAGE * KVLR)); const char* kb_ = (const char*)(cache_kr + (size_t)pg_ * (PAGE * ROPE_D)); \
          const unsigned lo_ = (unsigned)((tid >> 5) * 4096 + (tid & 31) * 16), ko_ = (unsigned)(tid * 16); \
          _Pragma("unroll") for (int i = 0; i < 8; ++i) pl[i] = __builtin_nontemporal_load((const f32x4*)(lb_ + lo_ + i * 512)); \
          pk[0] = __builtin_nontemporal_load((const f32x4*)(kb_ + ko_)); pk[1] = __builtin_nontemporal_load((const f32x4*)(kb_ + 8192 + ko_)); } while (0)
        SA_PREFETCH(0);
#pragma unroll 1
        for (int pgi = 0; pgi < 64; ++pgi) {
            const int pb = pgi & 1;
#ifndef SA_REP_STAGE
#define SA_REP_STAGE 1
#endif
#ifndef SA_REP_TILE
#define SA_REP_TILE 1
#endif
            for (int rs_ = 0; rs_ < SA_REP_STAGE; ++rs_) { asm volatile("" ::: "memory");
            { unsigned lo[8], hi2[8];
#pragma unroll
              for (int i = 0; i < 8; ++i) { lo[i] = pk2(pl[i].x, pl[i].y); hi2[i] = pk2(pl[i].z, pl[i].w); *(LAS v2u*)(S + SA_LK + (8 * kg + i) * LK_PITCH + dq * 8) = (v2u){lo[i], hi2[i]}; }
              v4u w0, w1, w2, w3;
#pragma unroll
              for (int i = 0; i < 4; ++i) { w0[i] = __builtin_amdgcn_perm(lo[2 * i + 1], lo[2 * i], 0x05040100u); w1[i] = __builtin_amdgcn_perm(lo[2 * i + 1], lo[2 * i], 0x07060302u);
                                            w2[i] = __builtin_amdgcn_perm(hi2[2 * i + 1], hi2[2 * i], 0x05040100u); w3[i] = __builtin_amdgcn_perm(hi2[2 * i + 1], hi2[2 * i], 0x07060302u); }
              LAS unsigned char* T = S + SA_LT + pb * SA_LT_BUF + kg * 16;
              *(LAS v4u*)(T + (4 * dq + 0) * LT_PITCH) = w0; *(LAS v4u*)(T + (4 * dq + 1) * LT_PITCH) = w1; *(LAS v4u*)(T + (4 * dq + 2) * LT_PITCH) = w2; *(LAS v4u*)(T + (4 * dq + 3) * LT_PITCH) = w3; }
#pragma unroll
            for (int i = 0; i < 2; ++i) { const int c = tid + 512 * i, key = c >> 3, part = c & 7; *(LAS v2u*)(S + SA_KR + key * LKR_PITCH + part * 8) = (v2u){pk2(pk[i].x, pk[i].y), pk2(pk[i].z, pk[i].w)}; }
            }
            if (pgi + 1 < 64) SA_PREFETCH(pgi + 1);
            __syncthreads();
            float sc[4];
            for (int rt_ = 0; rt_ < SA_REP_TILE; ++rt_) { asm volatile("" ::: "memory");
            { f32x16 a0, a1; f32x4 r4; bf16x8 bf[8], kb0, kb1; float ssx, ssy, dtx, dty;
#define SA_LOADB(kt) do { _Pragma("unroll") for (int s = 0; s < 8; ++s) bf[s] = *(const LAS bf16x8*)(S + SA_LK + (32 * (kt) + r32) * LK_PITCH + (16 * s + 8 * hh) * 2); \
                const LAS unsigned char* kr_ = S + SA_KR + (32 * (kt) + (lane & 15)) * LKR_PITCH + (lane >> 4) * 16; kb0 = *(const LAS bf16x8*)kr_; kb1 = *(const LAS bf16x8*)(kr_ + 16 * LKR_PITCH); } while (0)
#define SA_ROPE() do { r4 = (f32x4){0.f, 0.f, 0.f, 0.f}; r4 = mfma16(qv[0], kb0, r4); r4 = mfma16(qv[1], kb1, r4); } while (0)
#define SA_MF(A, rt) do { A = f32x16{}; _Pragma("unroll") for (int s = 0; s < 8; ++s) A = mfma32(wk[rt][s], bf[s], A); } while (0)
#define SA_RED(A, rt) do { f32x4 q_[4]; _Pragma("unroll") for (int g = 0; g < 4; ++g) q_[g] = *(const LAS f32x4*)(S + SA_QG + h * 256 + (32 * (rt) + 8 * g + 4 * hh) * 4); \
                _Pragma("unroll") for (int g = 0; g < 4; ++g) { ssx += A[4 * g] * A[4 * g]; ssy += A[4 * g + 1] * A[4 * g + 1]; ssx += A[4 * g + 2] * A[4 * g + 2]; ssy += A[4 * g + 3] * A[4 * g + 3]; } \
                _Pragma("unroll") for (int g = 0; g < 4; ++g) { dtx += A[4 * g] * q_[g].x; dty += A[4 * g + 1] * q_[g].y; dtx += A[4 * g + 2] * q_[g].z; dty += A[4 * g + 3] * q_[g].w; } } while (0)
#define SA_FIN(kt, RV) do { const float ss_ = xhalf_sum_pl(ssx + ssy), dot_ = xhalf_sum_pl(dtx + dty); sc[kt] = __builtin_amdgcn_rsqf(ss_ * (1.f / 64.f) + EPS) * dot_ + (RV); } while (0)
#define SA_SB() __builtin_amdgcn_sched_barrier(0)
              float rv;
              SA_LOADB(0); SA_ROPE(); SA_MF(a0, 0); SA_SB();
#pragma unroll
              for (int kt = 0; kt < 4; ++kt) {
                  ssx = 0.f; ssy = 0.f; dtx = 0.f; dty = 0.f; rv = r4[0];
                  SA_MF(a1, 1); SA_SB();
                  if (kt < 3) { SA_LOADB(kt + 1); SA_SB(); }
                  SA_RED(a0, 0); SA_SB();
                  if (kt < 3) { SA_ROPE(); SA_MF(a0, 0); SA_SB(); }
                  SA_RED(a1, 1); SA_FIN(kt, rv); SA_SB();
              }
#undef SA_LOADB
#undef SA_ROPE
#undef SA_MF
#undef SA_RED
#undef SA_FIN
#undef SA_SB
            } }
            float mx = half_max32(fmaxf(fmaxf(sc[0], sc[1]), fmaxf(sc[2], sc[3])));
            const float m_new = fmaxf(m_run, mx); const float alpha = __builtin_amdgcn_exp2f(m_run - m_new); m_run = m_new;
            float ps = 0.f;
#pragma unroll
            for (int kt = 0; kt < 4; ++kt) { const float e = __builtin_amdgcn_exp2f(sc[kt] - m_new); ps += e; if (hh == 0) *(LAS bf16*)(S + SA_P + pb * SA_P_BUF + h * 256 + (32 * kt + r32) * 2) = (bf16)f2bf(e); }
            l_run = l_run * alpha + ps;
            if (lane == 0) *(LAS float*)(S + SA_AL + pb * 32 + h * 4) = alpha;
            __syncthreads();
            { const int g4 = lane >> 4, n16 = lane & 15;
              if (g4 < 2) { const f32x4 al = *(const LAS f32x4*)(S + SA_AL + pb * 32 + 16 * g4); ctx = ctx * al; }
#pragma unroll
              for (int ks = 0; ks < 4; ++ks) {
                  bf16x8 af = *(const LAS bf16x8*)(S + SA_P + pb * SA_P_BUF + (n16 & 7) * 256 + (32 * ks + 8 * g4) * 2); if (n16 >= 8) af = bf16x8{};
                  const bf16x8 bfr = *(const LAS bf16x8*)(S + SA_LT + pb * SA_LT_BUF + (16 * h + n16) * LT_PITCH + (32 * ks + 8 * g4) * 2);
                  ctx = mfma16(af, bfr, ctx); } }
        }
#undef SA_PREFETCH
        { const int ln = fresh_lane(); const int g4 = ln >> 4, n16 = ln & 15; float* pu = PART + (size_t)u * PART_STRIDE;
          if (g4 < 2) {
#pragma unroll
              for (int i = 0; i < 4; ++i) pu[(4 * g4 + i) * 132 + 16 * h + n16] = ctx[i]; }
          const float lsum = wave_sum(l_run) * 0.5f;
          if (ln == 0) { pu[h * 132 + 128] = m_run; pu[h * 132 + 129] = lsum; } }
        __syncthreads();
    }
}

typedef int v8i __attribute__((ext_vector_type(8)));
constexpr int L8_PITCH = 144;
constexpr int S8_LK = 0, S8_LK_BUF = 128 * L8_PITCH, S8_LT = 2 * S8_LK_BUF, S8_LT_BUF = 128 * LT_PITCH, S8_KR = S8_LT + 2 * S8_LT_BUF, S8_KR_BUF = 128 * LKR_PITCH,
              S8_DOT = S8_KR + 2 * S8_KR_BUF, S8_ROPE = S8_DOT + 4096, S8_P = S8_ROPE + 4096, S8_AL = S8_P + 2048, S8_QA = S8_AL + 32, S8_QG = S8_QA + 2048, S8_END = S8_QG + 2048;
static_assert(S8_END <= RING_BYTES, "fp8 sample attention LDS");
__device__ __forceinline__ int fp8x4(float a, float b, float c, float d) { int w = 0; w = __builtin_amdgcn_cvt_pk_fp8_f32(a, b, w, false); w = __builtin_amdgcn_cvt_pk_fp8_f32(c, d, w, true); return w; }
__device__ __forceinline__ f32x16 mfma8(v8i a, v8i b, f32x16 c) { return __builtin_amdgcn_mfma_scale_f32_32x32x64_f8f6f4(a, b, c, 0, 0, 0, 127, 0, 127); }
__device__ __forceinline__ void phase_attn_sample8(const Ctx& C, const Params& P) {
    const int lane = C.lane, h = C.wave, tid = C.tid, r32 = lane & 31, hh = lane >> 5;
    const bf16* WUKV = WSP(const bf16, WS_WUKV); const bf16* Q = WSP(const bf16, WS_Q); float* PART = WSP(float, WS_PART);
    const float* cache_lat = P.in[2]; const float* cache_kr = P.in[3]; const int* ptab = (const int*)P.in[7]; const float* gkn = P.in[28];
    LAS unsigned char* S = C.lds + RING_OFF; const unsigned lds0 = (unsigned)(uintptr_t)S;
    v8i wk8[2][2];
#pragma unroll
    for (int rt = 0; rt < 2; ++rt)
#pragma unroll
        for (int ks = 0; ks < 2; ++ks) { const bf16* wp = WUKV + (size_t)(h * 128 + 32 * rt + r32) * 256 + 64 * ks + 32 * hh;
#pragma unroll
            for (int q = 0; q < 4; ++q) { const v4u w = *(const v4u*)(wp + 8 * q); float f[8]; unpack8f(w, f);
                wk8[rt][ks][2 * q] = fp8x4(16.f * f[0], 16.f * f[1], 16.f * f[2], 16.f * f[3]); wk8[rt][ks][2 * q + 1] = fp8x4(16.f * f[4], 16.f * f[5], 16.f * f[6], 16.f * f[7]); } }
    const int kg = tid >> 5, dq = tid & 31;
    for (int u = C.bid; u < 256; u += C.G) {
        const int sq = u >> 1, half = u & 1; const size_t qrow = (size_t)(MP + sq);
        { const int l2 = fresh_lane(); *(LAS float*)(S + S8_QG + h * 256 + l2 * 4) = bf2f(Q[qrow * 768 + h * 96 + l2]) * gkn[l2];
          const int kc = l2 & 15, dg = l2 >> 4; float acc[8] = {0.f, 0.f, 0.f, 0.f, 0.f, 0.f, 0.f, 0.f};
          asm volatile("s_waitcnt lgkmcnt(0)" ::: "memory");
#pragma unroll 4
          for (int i = 0; i < 16; ++i) { const int d = dg + 4 * i; const v4u w = *(const v4u*)(WUKV + (size_t)(h * 128 + d) * 256 + 8 * kc); float f[8]; unpack8f(w, f);
              const float qd = *(const LAS float*)(S + S8_QG + h * 256 + d * 4);
#pragma unroll
              for (int j = 0; j < 8; ++j) acc[j] += f[j] * qd; }
#pragma unroll
          for (int j = 0; j < 8; ++j) { acc[j] += lane_xor16(acc[j], l2); acc[j] += lane_xor32(acc[j], l2); }
          if (dg == 0) *(LAS bf16x8*)(S + S8_QA + h * 256 + kc * 16) = pack8(acc); }
        float m_run = -INFINITY, l_run = 0.f; f32x4 ctx = (f32x4){0.f, 0.f, 0.f, 0.f};
        f32x4 pl[8]; f32x4 pk[2];
        const int pgs = ptab[sq * NPAGES + half * 64 + lane];
#define S8_PREFETCH(pgidx) do { const int pg_ = __builtin_amdgcn_readlane(pgs, (pgidx)); \
          const char* lb_ = (const char*)(cache_lat + (size_t)pg_ * (PAGE * KVLR)); const char* kb_ = (const char*)(cache_kr + (size_t)pg_ * (PAGE * ROPE_D)); \
          const unsigned lo_ = (unsigned)((tid >> 5) * 4096 + (tid & 31) * 16), ko_ = (unsigned)(tid * 16); \
          _Pragma("unroll") for (int i = 0; i < 8; ++i) pl[i] = __builtin_nontemporal_load((const f32x4*)(lb_ + lo_ + i * 512)); \
          pk[0] = __builtin_nontemporal_load((const f32x4*)(kb_ + ko_)); pk[1] = __builtin_nontemporal_load((const f32x4*)(kb_ + 8192 + ko_)); } while (0)
#define S8_STAGE(nb) do { \
          unsigned lo[8], hi2[8]; \
          _Pragma("unroll") for (int i = 0; i < 8; ++i) { lo[i] = pk2(pl[i].x, pl[i].y); hi2[i] = pk2(pl[i].z, pl[i].w); \
              *(LAS int*)(S + S8_LK + (nb) * S8_LK_BUF + (8 * kg + i) * L8_PITCH + dq * 4) = fp8x4(pl[i].x, pl[i].y, pl[i].z, pl[i].w); } \
          v4u w0, w1, w2, w3; \
          _Pragma("unroll") for (int i = 0; i < 4; ++i) { w0[i] = __builtin_amdgcn_perm(lo[2 * i + 1], lo[2 * i], 0x05040100u); w1[i] = __builtin_amdgcn_perm(lo[2 * i + 1], lo[2 * i], 0x07060302u); \
                                            w2[i] = __builtin_amdgcn_perm(hi2[2 * i + 1], hi2[2 * i], 0x05040100u); w3[i] = __builtin_amdgcn_perm(hi2[2 * i + 1], hi2[2 * i], 0x07060302u); } \
          LAS unsigned char* T = S + S8_LT + (nb) * S8_LT_BUF + kg * 16; \
          *(LAS v4u*)(T + (4 * dq + 0) * LT_PITCH) = w0; *(LAS v4u*)(T + (4 * dq + 1) * LT_PITCH) = w1; *(LAS v4u*)(T + (4 * dq + 2) * LT_PITCH) = w2; *(LAS v4u*)(T + (4 * dq + 3) * LT_PITCH) = w3; \
          _Pragma("unroll") for (int i = 0; i < 2; ++i) { const int c = tid + 512 * i, key = c >> 3, part = c & 7; \
              *(LAS v2u*)(S + S8_KR + (nb) * S8_KR_BUF + key * LKR_PITCH + part * 8) = (v2u){pk2(pk[i].x, pk[i].y), pk2(pk[i].z, pk[i].w)}; } } while (0)
#define S8_DOTROPE(nb) do { \
          const int n16_ = lane & 15, g4_ = lane >> 4, q4_ = n16_ >> 2, p4_ = n16_ & 3; \
          f32x4 dacc = (f32x4){0.f, 0.f, 0.f, 0.f}, racc = (f32x4){0.f, 0.f, 0.f, 0.f}; \
          const unsigned tb_ = lds0 + S8_LT + (nb) * S8_LT_BUF + (8 * g4_ + q4_) * LT_PITCH + (16 * h + 4 * p4_) * 2; \
          s16x4 tl_[4], th_[4]; \
          asm volatile("ds_read_b64_tr_b16 %0, %8\n\tds_read_b64_tr_b16 %1, %8 offset:%9\n\tds_read_b64_tr_b16 %2, %8 offset:%10\n\tds_read_b64_tr_b16 %3, %8 offset:%11\n\t" \
                       "ds_read_b64_tr_b16 %4, %8 offset:%12\n\tds_read_b64_tr_b16 %5, %8 offset:%13\n\tds_read_b64_tr_b16 %6, %8 offset:%14\n\tds_read_b64_tr_b16 %7, %8 offset:%15\n\ts_waitcnt lgkmcnt(0)" \
                       : "=&v"(tl_[0]), "=&v"(th_[0]), "=&v"(tl_[1]), "=&v"(th_[1]), "=&v"(tl_[2]), "=&v"(th_[2]), "=&v"(tl_[3]), "=&v"(th_[3]) \
                       : "v"(tb_), "i"(4 * LT_PITCH), "i"(32 * LT_PITCH), "i"(36 * LT_PITCH), "i"(64 * LT_PITCH), "i"(68 * LT_PITCH), "i"(96 * LT_PITCH), "i"(100 * LT_PITCH) : "memory"); \
          _Pragma("unroll") for (int ks = 0; ks < 4; ++ks) dacc = mfma16(qa[ks], __builtin_shufflevector(tl_[ks], th_[ks], 0, 1, 2, 3, 4, 5, 6, 7), dacc); \
          { const bf16x8 kb_ = *(const LAS bf16x8*)(S + S8_KR + (nb) * S8_KR_BUF + (16 * h + n16_) * LKR_PITCH + g4_ * 16); racc = mfma16(qr, kb_, racc); } \
          if (g4_ < 2) { _Pragma("unroll") for (int i = 0; i < 4; ++i) { *(LAS float*)(S + S8_DOT + ((4 * g4_ + i) * 128 + 16 * h + n16_) * 4) = dacc[i]; *(LAS float*)(S + S8_ROPE + ((4 * g4_ + i) * 128 + 16 * h + n16_) * 4) = racc[i]; } } } while (0)
        S8_PREFETCH(0);
        __syncthreads();
        bf16x8 qa[4], qr;
        { const int n16 = lane & 15, g4 = lane >> 4;
#pragma unroll
          for (int ks = 0; ks < 4; ++ks) { bf16x8 f = *(const LAS bf16x8*)(S + S8_QA + (n16 & 7) * 256 + (32 * ks + 8 * g4) * 2); if (n16 >= 8) f = bf16x8{}; qa[ks] = f; }
          qr = bf16x8{}; if (n16 < 8) qr = *(const bf16x8*)(Q + qrow * 768 + n16 * 96 + 64 + 8 * g4); }
        S8_STAGE(0); S8_PREFETCH(1);
        __syncthreads();
        S8_DOTROPE(0);
#pragma unroll 1
        for (int pgi = 0; pgi < 64; ++pgi) {
            const int pb = pgi & 1;
            __syncthreads();
            float sc[4];
            { v8i bA0, bA1, bB0, bB1; f32x16 xa0, xa1, ya0, ya1; float dvA, rvA, dvB, rvB;
#define S8_LOADB(kt, B0, B1, DV, RV) do { const LAS unsigned char* bp_ = S + S8_LK + pb * S8_LK_BUF + (32 * (kt) + r32) * L8_PITCH + 32 * hh; \
                const v4u b00_ = *(const LAS v4u*)bp_, b01_ = *(const LAS v4u*)(bp_ + 16), b10_ = *(const LAS v4u*)(bp_ + 64), b11_ = *(const LAS v4u*)(bp_ + 80); \
                DV = *(const LAS float*)(S + S8_DOT + (h * 128 + 32 * (kt) + r32) * 4); RV = *(const LAS float*)(S + S8_ROPE + (h * 128 + 32 * (kt) + r32) * 4); \
                B0 = (v8i){(int)b00_.x, (int)b00_.y, (int)b00_.z, (int)b00_.w, (int)b01_.x, (int)b01_.y, (int)b01_.z, (int)b01_.w}; \
                B1 = (v8i){(int)b10_.x, (int)b10_.y, (int)b10_.z, (int)b10_.w, (int)b11_.x, (int)b11_.y, (int)b11_.z, (int)b11_.w}; } while (0)
#define S8_MF(B0, B1, A0, A1) do { A0 = f32x16{}; A1 = f32x16{}; A0 = mfma8(wk8[0][0], B0, A0); A1 = mfma8(wk8[1][0], B0, A1); A0 = mfma8(wk8[0][1], B1, A0); A1 = mfma8(wk8[1][1], B1, A1); } while (0)
#define S8_RED(kt, A0, A1, DV, RV) do { float sx_ = 0.f, sy_ = 0.f; \
                _Pragma("unroll") for (int r = 0; r < 16; r += 2) { sx_ += A0[r] * A0[r]; sy_ += A0[r + 1] * A0[r + 1]; sx_ += A1[r] * A1[r]; sy_ += A1[r + 1] * A1[r + 1]; } \
                const float ss_ = xhalf_sum_pl(sx_ + sy_); sc[kt] = __builtin_amdgcn_rsqf(ss_ * (1.f / (64.f * 256.f)) + EPS) * (DV) + (RV); } while (0)
#define S8_SB() __builtin_amdgcn_sched_barrier(0)
              S8_LOADB(0, bA0, bA1, dvA, rvA); S8_LOADB(1, bB0, bB1, dvB, rvB); S8_MF(bA0, bA1, xa0, xa1); S8_SB();
              { const float d0 = dvA, r0 = rvA; S8_MF(bB0, bB1, ya0, ya1); S8_LOADB(2, bA0, bA1, dvA, rvA); S8_RED(0, xa0, xa1, d0, r0); S8_SB(); }
              { const float d1 = dvB, r1 = rvB; S8_MF(bA0, bA1, xa0, xa1); S8_LOADB(3, bB0, bB1, dvB, rvB); S8_RED(1, ya0, ya1, d1, r1); S8_SB(); }
              S8_MF(bB0, bB1, ya0, ya1); S8_RED(2, xa0, xa1, dvA, rvA); S8_SB();
              S8_RED(3, ya0, ya1, dvB, rvB);
#undef S8_LOADB
#undef S8_MF
#undef S8_RED
#undef S8_SB
            }
            float mx = half_max32(fmaxf(fmaxf(sc[0], sc[1]), fmaxf(sc[2], sc[3])));
            const float m_new = fmaxf(m_run, mx); const float alpha = __builtin_amdgcn_exp2f(m_run - m_new); m_run = m_new;
            float ps = 0.f;
#pragma unroll
            for (int kt = 0; kt < 4; ++kt) { const float e = __builtin_amdgcn_exp2f(sc[kt] - m_new); ps += e; if (hh == 0) *(LAS bf16*)(S + S8_P + h * 256 + (32 * kt + r32) * 2) = (bf16)f2bf(e); }
            l_run = l_run * alpha + ps;
            if (lane == 0) *(LAS float*)(S + S8_AL + h * 4) = alpha;
            if (pgi + 1 < 64) { S8_STAGE(pb ^ 1); if (pgi + 2 < 64) S8_PREFETCH(pgi + 2); }
            __syncthreads();
            { const int g4 = lane >> 4, n16 = lane & 15;
              const f32x4 al = *(const LAS f32x4*)(S + S8_AL + 16 * (g4 & 1));
              bf16x8 af[4], bfr[4];
#pragma unroll
              for (int ks = 0; ks < 4; ++ks) { af[ks] = *(const LAS bf16x8*)(S + S8_P + (n16 & 7) * 256 + (32 * ks + 8 * g4) * 2);
                  bfr[ks] = *(const LAS bf16x8*)(S + S8_LT + pb * S8_LT_BUF + (16 * h + n16) * LT_PITCH + (32 * ks + 8 * g4) * 2); }
              if (g4 < 2) ctx = ctx * al;
#pragma unroll
              for (int ks = 0; ks < 4; ++ks) { if (n16 >= 8) af[ks] = bf16x8{}; ctx = mfma16(af[ks], bfr[ks], ctx); } }
            if (pgi + 1 < 64) S8_DOTROPE(pb ^ 1);
        }
#undef S8_PREFETCH
#undef S8_STAGE
#undef S8_DOTROPE
        { const int ln = fresh_lane(); const int g4 = ln >> 4, n16 = ln & 15; float* pu = PART + (size_t)u * PART_STRIDE;
          if (g4 < 2) {
#pragma unroll
              for (int i = 0; i < 4; ++i) pu[(4 * g4 + i) * 132 + 16 * h + n16] = ctx[i]; }
          const float lsum = wave_sum(l_run) * 0.5f;
          if (ln == 0) { pu[h * 132 + 128] = m_run; pu[h * 132 + 129] = lsum; } }
        __syncthreads();
    }
}

__device__ __forceinline__ void phase_sample_combine(const Ctx& C, const Params& P) {
    const int gw = C.bid * NWAVES + C.wave, NGW = C.G * NWAVES, lane = C.lane;
    const float* PART = WSP(const float, WS_PART); const bf16* Q = WSP(const bf16, WS_Q); const bf16* KF = WSP(const bf16, WS_KF); const bf16* KVRAW = WSP(const bf16, WS_KVRAW);
    bf16* ATT = WSP(bf16, WS_ATT); const float* wukv = P.in[27];
    for (int it = gw; it < MS * NHEAD; it += NGW) {
        const int sq = it >> 3, h = it & 7; const size_t row = (size_t)(MP + sq);
        const float* p0 = PART + (size_t)(2 * sq) * PART_STRIDE + h * 132; const float* p1 = p0 + PART_STRIDE;
        float sn = 0.f; if (lane < 48) { const unsigned qa = *(const unsigned*)(Q + row * 768 + h * 96 + 2 * lane), ka = *(const unsigned*)(KF + row * 768 + h * 96 + 2 * lane); sn = bflo(qa) * bflo(ka) + bfhi(qa) * bfhi(ka); }
        sn = wave_sum(sn);
        const float m0 = p0[128], l0 = p0[129], m1 = p1[128], l1 = p1[129];
        const float M = fmaxf(fmaxf(m0, m1), sn); const float w0 = exp2f(m0 - M), w1 = exp2f(m1 - M), wn = exp2f(sn - M);
        const float Lt = l0 * w0 + l1 * w1 + wn;
        const float c_lo = p0[lane] * w0 + p1[lane] * w1, c_hi = p0[64 + lane] * w0 + p1[64 + lane] * w1;
        float acc = 0.f; const float* wv = wukv + h * 128 + 64 + lane;
#pragma unroll
        for (int k = 0; k < 64; ++k) { acc += __builtin_bit_cast(float, __builtin_amdgcn_readlane(__builtin_bit_cast(int, c_lo), k)) * wv[(size_t)k * 1024];
                                       acc += __builtin_bit_cast(float, __builtin_amdgcn_readlane(__builtin_bit_cast(int, c_hi), k)) * wv[(size_t)(64 + k) * 1024]; }
        const float outv = (acc + wn * bf2f(KVRAW[row * 1024 + h * 128 + 64 + lane])) / Lt;
        ATT[row * 512 + h * 64 + lane] = (bf16)f2bf(outv);
    }
}

__device__ __forceinline__ void phase_mix(const Ctx& C, const Params& P) {
    const int gw = C.bid * NWAVES + C.wave, NGW = C.G * NWAVES, lane = C.lane;
    const bf16* Z = WSP(const bf16, WS_Z); const bf16* HL = WSP(const bf16, WS_HL); const bf16* AC = WSP(const bf16, WS_AC); const bf16* ATT = WSP(const bf16, WS_ATT);
    const float* CAR = WSP(const float, WS_CARRY); bf16* MIX = WSP(bf16, WS_MIX);
    const int c = 8 * lane;
    float glo[8], gmo[8];
#pragma unroll
    for (int j = 0; j < 8; ++j) { glo[j] = P.in[29][c + j]; gmo[j] = P.in[30][c + j]; }
    for (int r0 = gw; r0 < MREAL; r0 += 2 * NGW) {
        v4u wh[2], wa[2], wg[2], wt[2]; f32x4 c0[2], c1[2]; int rr[2];
#pragma unroll
        for (int u = 0; u < 2; ++u) { const int r = (r0 + u * NGW < MREAL) ? r0 + u * NGW : r0; rr[u] = r;
            wh[u] = *(const v4u*)(HL + (size_t)r * 512 + c); wa[u] = *(const v4u*)(AC + (size_t)r * 512 + c); wg[u] = *(const v4u*)(Z + (size_t)r * ZC + 512 + c); wt[u] = *(const v4u*)(ATT + (size_t)r * 512 + c);
            c0[u] = (f32x4){0.f, 0.f, 0.f, 0.f}; c1[u] = c0[u];
            if (r < MP) { const float* cp = CAR + ((size_t)(r >> 11) * 32 + ((r & 2047) >> 6)) * 512 + c; c0[u] = *(const f32x4*)cp; c1[u] = *(const f32x4*)(cp + 4); } }
#pragma unroll
        for (int u = 0; u < 2; ++u) { const int r = rr[u];
            float hv[8], av[8], gv[8], tv[8]; unpack8f(wh[u], hv); unpack8f(wa[u], av); unpack8f(wg[u], gv); unpack8f(wt[u], tv);
            const float cin[8] = {c0[u].x, c0[u].y, c0[u].z, c0[u].w, c1[u].x, c1[u].y, c1[u].z, c1[u].w};
            float ss = 0.f, s2 = 0.f;
#pragma unroll
            for (int j = 0; j < 8; ++j) { hv[j] = (hv[j] + av[j] * cin[j]) * gelu_tanh(gv[j]); ss += hv[j] * hv[j]; s2 += tv[j] * tv[j]; }
            const float rstd = rsqrtf(wave_sum(ss) * (1.f / 512.f) + EPS), rs2 = rsqrtf(wave_sum(s2) * (1.f / 512.f) + EPS);
#pragma unroll
            for (int j = 0; j < 8; ++j) { hv[j] = hv[j] * rstd * glo[j]; tv[j] = tv[j] * rs2 * gmo[j]; }
            *(bf16x8*)(MIX + (size_t)r * 1024 + c) = pack8(hv); *(bf16x8*)(MIX + (size_t)r * 1024 + 512 + c) = pack8(tv);
        }
    }
}

__device__ __forceinline__ void unpack8(const v4u& w, float* v) { v[0] = bflo(w.x); v[1] = bfhi(w.x); v[2] = bflo(w.y); v[3] = bfhi(w.y); v[4] = bflo(w.z); v[5] = bfhi(w.z); v[6] = bflo(w.w); v[7] = bfhi(w.w); }
__device__ __forceinline__ void phase_ffn_fixup(const Ctx& C, const Params& P) {
    const float* RAW = WSP(const float, WS_RAW); const bf16* UP = WSP(const bf16, WS_UP); bf16* ACT = WSP(bf16, WS_ACT); const float* fw = P.in[34]; const float* fb = P.in[35];
    const int gt = C.bid * 512 + C.tid, NGT = C.G * 512;
    for (int idx = gt; idx < 256 * 704; idx += NGT) {
        const int blk = idx / 704, c = 4 * (idx - blk * 704);
        if ((blk & 15) == 0) continue;
        const float* r0 = RAW + (size_t)(blk - 1) * 4 * UPC; const float* r1 = RAW + (size_t)blk * 4 * UPC;
        const f32x4 wv0 = *(const f32x4*)(fw + c), wv1 = *(const f32x4*)(fw + UPC + c), wv2 = *(const f32x4*)(fw + 2 * UPC + c), bv = *(const f32x4*)(fb + c);
        const f32x4 wg0 = *(const f32x4*)(fw + DFF + c), wg1 = *(const f32x4*)(fw + UPC + DFF + c), wg2 = *(const f32x4*)(fw + 2 * UPC + DFF + c), bg = *(const f32x4*)(fb + DFF + c);
        const f32x4 vm2 = *(const f32x4*)(r0 + c), vm1 = *(const f32x4*)(r0 + UPC + c), v0 = *(const f32x4*)(r1 + 2 * UPC + c), v1 = *(const f32x4*)(r1 + 3 * UPC + c);
        const f32x4 gm2 = *(const f32x4*)(r0 + DFF + c), gm1 = *(const f32x4*)(r0 + UPC + DFF + c), g0 = *(const f32x4*)(r1 + 2 * UPC + DFF + c), g1 = *(const f32x4*)(r1 + 3 * UPC + DFF + c);
        const f32x4 va = bv + wv0 * vm2 + wv1 * vm1 + wv2 * v0, ga = bg + wg0 * gm2 + wg1 * gm1 + wg2 * g0;
        const f32x4 vb = bv + wv0 * vm1 + wv1 * v0 + wv2 * v1, gb = bg + wg0 * gm1 + wg1 * g0 + wg2 * g1;
        v2u oa, ob; oa.x = pk2(gelu_tanh(ga.x) * va.x, gelu_tanh(ga.y) * va.y); oa.y = pk2(gelu_tanh(ga.z) * va.z, gelu_tanh(ga.w) * va.w);
        ob.x = pk2(gelu_tanh(gb.x) * vb.x, gelu_tanh(gb.y) * vb.y); ob.y = pk2(gelu_tanh(gb.z) * vb.z, gelu_tanh(gb.w) * vb.w);
        *(v2u*)(ACT + (size_t)(blk * 128) * DFF + c) = oa; *(v2u*)(ACT + (size_t)(blk * 128 + 1) * DFF + c) = ob;
    }
    for (int idx = gt; idx < NBATCH * 2 * (UPC / 4); idx += NGT) { const int b = idx / (2 * (UPC / 4)), rem = idx - b * (2 * (UPC / 4)), s = rem / (UPC / 4), c = 4 * (rem - s * (UPC / 4));
        *(f32x4*)(P.out + O_FCP + ((size_t)b * 2 + s) * UPC + c) = *(const f32x4*)(RAW + ((size_t)(16 * b + 15) * 4 + s) * UPC + c); }
    for (int idx = gt; idx < MS * 352; idx += NGT) {
        const int s_ = idx / 352, c = 8 * (idx - s_ * 352); const int r = MP + s_;
        float v0[8], g0[8]; unpack8(*(const v4u*)(UP + (size_t)r * UPC + c), v0); unpack8(*(const v4u*)(UP + (size_t)r * UPC + DFF + c), g0);
        const float* st = P.in[6] + (size_t)s_ * 2 * UPC; float* d = P.out + O_FCS + (size_t)s_ * 2 * UPC;
        float o[8];
#pragma unroll
        for (int q = 0; q < 2; ++q) { const int cc = c + 4 * q;
            const f32x4 v2 = *(const f32x4*)(st + cc), g2 = *(const f32x4*)(st + DFF + cc), v1 = *(const f32x4*)(st + UPC + cc), g1 = *(const f32x4*)(st + UPC + DFF + cc);
            const f32x4 vv = (f32x4){v0[4 * q], v0[4 * q + 1], v0[4 * q + 2], v0[4 * q + 3]}, gg = (f32x4){g0[4 * q], g0[4 * q + 1], g0[4 * q + 2], g0[4 * q + 3]};
            *(f32x4*)(d + cc) = v1; *(f32x4*)(d + DFF + cc) = g1; *(f32x4*)(d + UPC + cc) = vv; *(f32x4*)(d + UPC + DFF + cc) = gg;
            const f32x4 val = *(const f32x4*)(fb + cc) + *(const f32x4*)(fw + cc) * v2 + *(const f32x4*)(fw + UPC + cc) * v1 + *(const f32x4*)(fw + 2 * UPC + cc) * vv;
            const f32x4 gt_ = *(const f32x4*)(fb + DFF + cc) + *(const f32x4*)(fw + DFF + cc) * g2 + *(const f32x4*)(fw + UPC + DFF + cc) * g1 + *(const f32x4*)(fw + 2 * UPC + DFF + cc) * gg;
#pragma unroll
            for (int e = 0; e < 4; ++e) o[4 * q + e] = gelu_tanh(gt_[e]) * val[e]; }
        *(bf16x8*)(ACT + (size_t)r * DFF + c) = pack8(o);
    }
}

__device__ __forceinline__ void phase_stream_probe(const Ctx& C, const Params& P) {
    const float* cache_lat = P.in[2]; const float* cache_kr = P.in[3]; const int* ptab = (const int*)P.in[7]; const int tid = C.tid, lane = C.lane;
    float accum = 0.f;
    for (int u = C.bid; u < 256; u += C.G) {
        const int sq = u >> 1, half = u & 1;
        const int pgs = ptab[sq * NPAGES + half * 64 + lane];
        f32x4 pl[8], pk[2];
#define PR_PREFETCH(pgidx) do { const int pg_ = __builtin_amdgcn_readlane(pgs, (pgidx)); \
          const char* lb_ = (const char*)(cache_lat + (size_t)pg_ * (PAGE * KVLR)); const char* kb_ = (const char*)(cache_kr + (size_t)pg_ * (PAGE * ROPE_D)); \
          const unsigned lo_ = (unsigned)((tid >> 5) * 4096 + (tid & 31) * 16), ko_ = (unsigned)(tid * 16); \
          _Pragma("unroll") for (int i = 0; i < 8; ++i) pl[i] = __builtin_nontemporal_load((const f32x4*)(lb_ + lo_ + i * 512)); \
          pk[0] = __builtin_nontemporal_load((const f32x4*)(kb_ + ko_)); pk[1] = __builtin_nontemporal_load((const f32x4*)(kb_ + 8192 + ko_)); } while (0)
        PR_PREFETCH(0);
#pragma unroll 1
        for (int pgi = 0; pgi < 64; ++pgi) {
            float s = 0.f;
#pragma unroll
            for (int i = 0; i < 8; ++i) s += (pl[i].x + pl[i].y) + (pl[i].z + pl[i].w);
            s += pk[0].x + pk[1].y;
            if (pgi + 1 < 64) PR_PREFETCH(pgi + 1);
            accum += s;
        }
#undef PR_PREFETCH
    }
    WSP(float, WS_END)[C.bid * 512 + tid] = accum;
}
#ifndef SA_FP8
#define SA_FP8 1
#endif

constexpr int N_LAUNCHES = MK_N_LAUNCHES;
constexpr int N_PHASES = 16;
template <int PHASE_MASK> __global__ void __launch_bounds__(NWAVES * 64, 2) mk_fwd(Params P) {
    extern __shared__ __attribute__((aligned(16))) unsigned char lds[];
    Ctx C0; C0.lds = (LAS unsigned char*)lds; C0.tid = threadIdx.x; C0.lane = C0.tid & 63; C0.wave = __builtin_amdgcn_readfirstlane(C0.tid >> 6); C0.G = gridDim.x; C0.bid = blockIdx.x; C0.p = nullptr;
    const Ctx& C = C0;
    volatile LAS unsigned* MISC = (volatile LAS unsigned*)(C.lds + MISC_OFF);
    for (int u = C.tid; u < (LDS_BYTES - LDSCTL_OFF) / 4; u += NWAVES * 64) ((LAS unsigned*)(C.lds + LDSCTL_OFF))[u] = 0u;
    __syncthreads();
    gu32* ctl = (gu32*)(P.ws + WS_CTL);
    XcdBarrier bar; bar.bar = (unsigned*)(ctl + CW_BAR); bar.x = 0; bar.st = nullptr;
    if (N_LAUNCHES == 1) bar = xcd_barrier_post((unsigned*)(ctl + CW_BAR), MISC + 8, C0.tid);
    const int lo = P.ph_lo, hi = P.ph_hi;
#define IN(k) (((PHASE_MASK >> (k)) & 1) && lo <= (k) && (k) < hi)
#ifndef EXTRA_BARRIERS
#define EXTRA_BARRIERS 0
#endif
#define SEAM(k) do { if (IN(k) && IN((k) + 1)) { PHASE_CTX(); xcd_barrier(bar, C.tid); for (int xb_ = 0; xb_ < EXTRA_BARRIERS; ++xb_) xcd_barrier(bar, C.tid); } } while (0)
#ifndef REPEAT_MASK
#define REPEAT_MASK 0
#endif
#define NREP(k) (((REPEAT_MASK >> (k)) & 1) ? 2 : 1)
#define PHASE_CTX() Ctx C = C0; asm volatile("v_mbcnt_lo_u32_b32 %0, -1, 0\n\tv_mbcnt_hi_u32_b32 %0, -1, %0" : "=v"(C.lane)); C.tid = C0.wave * 64 + C.lane

    if (IN(0)) { { PHASE_CTX(); phase_p0a(C, P); } { PHASE_CTX(); phase_adaln_direct(C, P); } } SEAM(0);
    if (IN(2)) for (int rep_ = 0; rep_ < NREP(2); ++rep_) { PHASE_CTX();
        { EpiSB Es{WSP(float, WS_SB)}; skinny_gemm_splitk<8>(C, WSP(const bf16, WS_SH2), 1024, WSP(const bf16, WS_WUP), 1024, 9, UPC / 128, 1024, Es); }
        phase_norm_mod<false>(C, P); } SEAM(2);
    if (IN(3)) for (int rep_ = 0; rep_ < NREP(3); ++rep_) { PHASE_CTX();
        { EpiSkBf16 Es{WSP(bf16, WS_Z), ZC}; skinny_gemm_splitk<2>(C, WSP(const bf16, WS_H1) + (size_t)MP * 1024, 1024, WSP(const bf16, WS_WIN), 1024, 8, ZC / 32, 1024, Es); }
        pg8::Gemm g{WSP(const pg8::bf16_t, WS_H1), WSP(const pg8::bf16_t, WS_WIN), MP, ZC, 1024}; pg8::StaticOrder S; S.init(MP, ZC, C.G, C.bid);
        pg8::EpiBf16<0> E{WSP(pg8::bf16_t, WS_Z), ZC, nullptr, 0, 0, 1.f};
        pg8::gemm_phase<pg8::EpiBf16<0>, pg8::StaticOrder, true, true>(C.lds + RING_OFF, g, S, E, C.tid);
    } SEAM(3);
    if (IN(4)) for (int rep_ = 0; rep_ < NREP(4); ++rep_) { PHASE_CTX(); phase_p3a(C, P); phase_p3b<false>(C, P); } SEAM(4);
    if (IN(5)) for (int rep_ = 0; rep_ < NREP(5); ++rep_) { PHASE_CTX();
        { EpiSkBf16 Es{WSP(bf16, WS_QRAW), 768}; skinny_gemm<2>(C, WSP(const bf16, WS_QN) + (size_t)MP * 256, 256, WSP(const bf16, WS_WUQ), 256, 8, 768 / 32, 256, Es); }
        { EpiSkBf16 Es{WSP(bf16, WS_KVRAW), 1024}; skinny_gemm<2>(C, WSP(const bf16, WS_KVN) + (size_t)MP * 256, 256, WSP(const bf16, WS_WUKV), 256, 8, 1024 / 32, 128, Es); }
        pg8::Gemm g{WSP(const pg8::bf16_t, WS_QN), WSP(const pg8::bf16_t, WS_WUQ), MP, 768, 256}; pg8::StaticOrder S; S.init(MP, 768, C.G, C.bid);
        pg8::EpiBf16<0> E{WSP(pg8::bf16_t, WS_QRAW), 768, nullptr, 0, 0, 1.f};
        pg8::gemm_phase<pg8::EpiBf16<0>, pg8::StaticOrder, true, true>(C.lds + RING_OFF, g, S, E, C.tid);
        { Ctx C2 = C; C2.bid = (C.bid + 4) % C.G; if (C2.bid < 4) phase_p3b<true>(C2, P); }
    }
    if (IN(6)) for (int rep_ = 0; rep_ < NREP(6); ++rep_) { PHASE_CTX();
        pg8::Gemm g{WSP(const pg8::bf16_t, WS_KVN), WSP(const pg8::bf16_t, WS_WUKV), MP, 1024, 256}; pg8::StaticOrder S; S.init(MP, 1024, C.G, C.bid);
        pg8::EpiBf16<0> E{WSP(pg8::bf16_t, WS_KVRAW), 1024, nullptr, 0, 0, 1.f};
        pg8::gemm_phase<pg8::EpiBf16<0>, pg8::StaticOrder, true, true>(C.lds + RING_OFF, g, S, E, C.tid);
    } SEAM(6);
    if (IN(7)) for (int rep_ = 0; rep_ < NREP(7); ++rep_) { PHASE_CTX(); phase_p5(C, P); } SEAM(7);
    if (IN(8)) { { PHASE_CTX(); phase_carry(C, P); } for (int rep_ = 0; rep_ < NREP(16); ++rep_) { PHASE_CTX();
#if SA_FP8
            phase_attn_sample8(C, P);
#else
            phase_attn_sample(C, P);
#endif
        } if ((REPEAT_MASK >> 18) & 1) { PHASE_CTX(); phase_stream_probe(C, P); } for (int rep_ = 0; rep_ < NREP(17); ++rep_) { PHASE_CTX(); phase_attn_prompt(C, P); } } SEAM(8);
    if (IN(9)) for (int rep_ = 0; rep_ < NREP(9); ++rep_) { PHASE_CTX(); phase_sample_combine(C, P); } SEAM(9);
    if (IN(10)) for (int rep_ = 0; rep_ < NREP(10); ++rep_) { PHASE_CTX(); phase_mix(C, P); } SEAM(10);
    if (IN(11)) for (int rep_ = 0; rep_ < NREP(11); ++rep_) { PHASE_CTX();
        { EpiSkResGate<false, true, true> Es{P.in[1], WSP(bf16, WS_X1) + (size_t)MP * 1024, WSP(const float, WS_MOD), 2048, WSP(bf16, WS_H1) + (size_t)MP * 1024, P.in[32], WSP(float, WS_ROWSS) + MP}; skinny_gemm_splitk<2>(C, WSP(const bf16, WS_MIX) + (size_t)MP * 1024, 1024, WSP(const bf16, WS_WO), 1024, 8, 1024 / 32, 1024, Es); }
        pg8::Gemm g{WSP(const pg8::bf16_t, WS_MIX), WSP(const pg8::bf16_t, WS_WO), MP, 1024, 1024}; pg8::StaticOrder S; S.init(MP, 1024, C.G, C.bid);
        pg8::EpiResGate<false, true, true> E{P.in[0], WSP(bf16, WS_X1), WSP(const float, WS_MOD), 2048, WSP(pg8::bf16_t, WS_H1), P.in[32], WSP(float, WS_ROWSS)};
        pg8::gemm_phase<pg8::EpiResGate<false, true, true>, pg8::StaticOrder, true, true>(C.lds + RING_OFF, g, S, E, C.tid);
        if ((REPEAT_MASK >> 21) & 1) { pg8::EpiNull<false> En; pg8::gemm_phase<pg8::EpiNull<false>, pg8::StaticOrder, true, true>(C.lds + RING_OFF, g, S, En, C.tid); }
    } SEAM(11);
    if (IN(13)) for (int rep_ = 0; rep_ < NREP(13); ++rep_) { PHASE_CTX();
        { EpiSkUp Es{WSP(bf16, WS_UP), WSP(const float, WS_ROWSS), WSP(const float, WS_SB)}; skinny_gemm_splitk<8>(C, WSP(const bf16, WS_H1) + (size_t)MP * 1024, 1024, WSP(const bf16, WS_WUP), 1024, 8, UPC / 128, 1024, Es); }
        pg8::Gemm g{WSP(const pg8::bf16_t, WS_H1), WSP(const pg8::bf16_t, WS_WUP), MP, UPC, 1024}; pg8::StaticOrder S; S.init(MP, UPC, C.G, C.bid);
        pg8::EpiConvGelu E{WSP(pg8::bf16_t, WS_ACT), WSP(float, WS_RAW), P.in[34], P.in[35], WSP(const float, WS_ROWSS), WSP(const float, WS_SB)};
        pg8::gemm_phase<pg8::EpiConvGelu, pg8::StaticOrder, true, true>(C.lds + RING_OFF, g, S, E, C.tid);
    } SEAM(13);
    if (IN(14)) for (int rep_ = 0; rep_ < NREP(14); ++rep_) { PHASE_CTX(); phase_ffn_fixup(C, P); }
    if (((REPEAT_MASK >> 20) & 1) && IN(14)) { PHASE_CTX(); pg8::Gemm g{WSP(const pg8::bf16_t, WS_H1), WSP(const pg8::bf16_t, WS_WUP), MP, UPC, 1024}; pg8::StaticOrder S; S.init(MP, UPC, C.G, C.bid);
        pg8::EpiNull<true> En; pg8::gemm_phase<pg8::EpiNull<true>, pg8::StaticOrder, true, true>(C.lds + RING_OFF, g, S, En, C.tid); }
    SEAM(14);
    if (IN(15)) for (int rep_ = 0; rep_ < NREP(15); ++rep_) { PHASE_CTX();
        { EpiSkResGate<true, false, false> Es{WSP(const bf16, WS_X1) + (size_t)MP * 1024, P.out + (size_t)MP * 1024, WSP(const float, WS_MOD), 5120, nullptr, nullptr, nullptr}; skinny_gemm_splitk<2>(C, WSP(const bf16, WS_ACT) + (size_t)MP * DFF, DFF, WSP(const bf16, WS_WDN), DFF, 8, 1024 / 32, DFF, Es);
          if ((REPEAT_MASK >> 26) & 1) skinny_gemm_splitk<2>(C, WSP(const bf16, WS_ACT) + (size_t)MP * DFF, DFF, WSP(const bf16, WS_WDN), DFF, 8, 1024 / 32, DFF, Es); }
        pg8::Gemm g{WSP(const pg8::bf16_t, WS_ACT), WSP(const pg8::bf16_t, WS_WDN), MP, 1024, DFF}; pg8::StaticOrder S; S.init(MP, 1024, C.G, C.bid);
        pg8::EpiResGate<true, false, false> E{WSP(const bf16, WS_X1), P.out, WSP(const float, WS_MOD), 5120, nullptr, nullptr, nullptr};
        pg8::gemm_phase<pg8::EpiResGate<true, false, false>, pg8::StaticOrder, true, true>(C.lds + RING_OFF, g, S, E, C.tid);
        if ((REPEAT_MASK >> 22) & 1) { pg8::EpiProbe<0> En{(float*)(P.ws + WS_UP + 64 * MiB), nullptr}; pg8::gemm_phase<pg8::EpiProbe<0>, pg8::StaticOrder, true, true>(C.lds + RING_OFF, g, S, En, C.tid); }
        if ((REPEAT_MASK >> 23) & 1) { pg8::EpiProbe<1> En{nullptr, WSP(const pg8::bf16_t, WS_X1)}; pg8::gemm_phase<pg8::EpiProbe<1>, pg8::StaticOrder, true, true>(C.lds + RING_OFF, g, S, En, C.tid); }
        if ((REPEAT_MASK >> 24) & 1) { pg8::EpiProbe<2> En{(float*)(P.ws + WS_UP + 64 * MiB), nullptr}; pg8::gemm_phase<pg8::EpiProbe<2>, pg8::StaticOrder, true, true>(C.lds + RING_OFF, g, S, En, C.tid); }
        if ((REPEAT_MASK >> 25) & 1) { pg8::EpiResGate<true, false, false> En{WSP(const bf16, WS_X1), (float*)(P.ws + WS_UP + 64 * MiB), WSP(const float, WS_MOD), 5120, nullptr, nullptr, nullptr}; pg8::gemm_phase<pg8::EpiResGate<true, false, false>, pg8::StaticOrder, true, true>(C.lds + RING_OFF, g, S, En, C.tid); }
        if ((REPEAT_MASK >> 19) & 1) { pg8::EpiNull<false> En; pg8::gemm_phase<pg8::EpiNull<false>, pg8::StaticOrder, true, true>(C.lds + RING_OFF, g, S, En, C.tid); }
    }
#undef IN
#undef SEAM
}

typedef void (*KernFn)(Params);
template <int... I> struct Seq {};
static KernFn phase_kernel(int k) {
    if constexpr (N_LAUNCHES == 1) { return mk_fwd<0xffff>; }
    else {
        switch (k) {
#define PK(i) case i: return mk_fwd<(1 << i)>;
            PK(0) PK(1) PK(2) PK(3) PK(4) PK(5) PK(6) PK(7) PK(8) PK(9) PK(10) PK(11) PK(12) PK(13) PK(14) PK(15)
#undef PK
            default: return nullptr;
        }
    }
}
extern "C" void kernel_launch(void* const* d_in, const int* in_sizes, int n_in, void* d_out, int out_size, void* d_ws, size_t ws_size, hipStream_t stream) {
    static int grid = 0;
    static KernFn fns[N_PHASES];
    if (grid == 0) {
        if (n_in != 37 || out_size != (int)O_END || ws_size < WS_END + 4 * MiB) { fprintf(stderr, "kernel_launch: unexpected shapes: n_in %d out %d ws %zu\n", n_in, out_size, ws_size); grid = -1; return; }
        int dev = 0, cus = 0, per_cu = 0;
        if (hipGetDevice(&dev) != hipSuccess || hipDeviceGetAttribute(&cus, hipDeviceAttributeMultiprocessorCount, dev) != hipSuccess) { grid = -1; return; }
        for (int li = 0; li < N_LAUNCHES; ++li) {
            fns[li] = (N_LAUNCHES == 1) ? phase_kernel(99) : phase_kernel(li);
            if (hipFuncSetAttribute((const void*)fns[li], hipFuncAttributeMaxDynamicSharedMemorySize, LDS_BYTES) != hipSuccess) { fprintf(stderr, "kernel_launch: hipFuncSetAttribute failed\n"); grid = -1; return; }
            if (hipOccupancyMaxActiveBlocksPerMultiprocessor(&per_cu, (const void*)fns[li], NWAVES * 64, LDS_BYTES) != hipSuccess || per_cu < 1) { fprintf(stderr, "kernel_launch: occupancy query says %d for launch %d\n", per_cu, li); }
        }
        (void)hipGetLastError();
        grid = cus;
    }
    if (grid < 0) return;
    if (hipMemsetAsync((char*)d_ws + WS_CTL, 0, CTL_ZERO_BYTES, stream) != hipSuccess) return;
    Params p{};
    for (int i = 0; i < 37; ++i) p.in[i] = (const float*)d_in[i];
    p.out = (float*)d_out; p.ws = (unsigned char*)d_ws;
    for (int li = 0; li < N_LAUNCHES; ++li) {
        if (N_LAUNCHES == 1) { p.ph_lo = 0; p.ph_hi = N_PHASES; } else { p.ph_lo = li; p.ph_hi = li + 1; }
        hipLaunchKernelGGL(fns[li], dim3(grid), dim3(NWAVES * 64), LDS_BYTES, stream, p);
        const hipError_t le = hipPeekAtLastError();
        if (le != hipSuccess) { fprintf(stderr, "kernel_launch: launch %d failed: %s\n", li, hipGetErrorName(le)); break; }
    }
}
```

```cpp
#include <hip/hip_runtime.h>
#include <cstdio>
#include <cstdint>
#include <cmath>

#ifndef MK_N_LAUNCHES
#define MK_N_LAUNCHES 1
#endif

constexpr int MP = 32768;
constexpr int MS = 128;
constexpr int MREAL = MP + MS;
constexpr int MR = 33024;
constexpr int DM = 1024, SEQ = 2048, NBATCH = 16;
constexpr int ZC = 1536;
constexpr int LRU_W = 512, NHEAD = 8;
constexpr int QLR = 256, KVLR = 128, ROPE_D = 32, NOPE_D = 64, QKD = 96, VD = 64;
constexpr int DFF = 2816, UPC = 5632;
constexpr int NPAGES = 128, PAGE = 128;
constexpr int MODC = 6144;
constexpr float EPS = 1e-6f;
constexpr float C2 = 0.10206207261596575f * 1.4426950408889634f;

constexpr size_t O_YP = 0, O_YS = 33554432, O_KVP = 33685504, O_KRP = 37879808, O_LHP = 38928384, O_LCP = 38936576, O_FCP = 38961152,
                 O_KVS = 39141376, O_KRS = 39157760, O_LHS = 39161856, O_LCS = 39227392, O_FCS = 39424000, O_END = 40865792;

constexpr size_t MiB = 1u << 20;
constexpr size_t WS_CTL = 0, CTL_ZERO_BYTES = 1 * MiB;
constexpr size_t WS_WIN = 1 * MiB;
constexpr size_t WS_WUQ = 4 * MiB;
constexpr size_t WS_WUKV = 5 * MiB;
constexpr size_t WS_WO = 6 * MiB;
constexpr size_t WS_WUP = 8 * MiB;
constexpr size_t WS_WDN = 20 * MiB;
constexpr size_t WS_WADA = 26 * MiB;
constexpr size_t WS_WG = 38 * MiB;
constexpr size_t WS_SC = 39 * MiB;
constexpr size_t WS_MOD = 40 * MiB;
constexpr size_t WS_ROPE = 44 * MiB;
constexpr size_t WS_SUM = 45 * MiB;
constexpr size_t WS_CARRY = 47 * MiB;
constexpr size_t WS_PART = 48 * MiB;
constexpr size_t WS_H1 = 64 * MiB;
constexpr size_t WS_Z = 130 * MiB;
constexpr size_t WS_QN = 228 * MiB;
constexpr size_t WS_KVN = 246 * MiB;
constexpr size_t WS_KR = 264 * MiB;
constexpr size_t WS_HL = 268 * MiB;
constexpr size_t WS_AC = 302 * MiB;
constexpr size_t WS_QRAW = 336 * MiB;
constexpr size_t WS_KVRAW = 386 * MiB;
constexpr size_t WS_Q = 452 * MiB;
constexpr size_t WS_KF = 502 * MiB;
constexpr size_t WS_V = 552 * MiB;
constexpr size_t WS_ATT = 586 * MiB;
constexpr size_t WS_MIX = 620 * MiB;
constexpr size_t WS_UP = 686 * MiB;
constexpr size_t WS_ACT = 1042 * MiB;
constexpr size_t WS_RAW = 1221 * MiB;
constexpr size_t WS_X1 = 1246 * MiB;
constexpr size_t WS_SH2 = 1312 * MiB;
constexpr size_t WS_SB = 1313 * MiB;
constexpr size_t WS_ROWSS = WS_CTL + 256 * 1024;
constexpr size_t WS_END = 1318 * MiB;
constexpr int CW_TMO = 0, CW_BAR = 4096;

constexpr int RING_OFF = 0, RING_BYTES = 143360;
constexpr int LDSCTL_OFF = RING_BYTES, MISC_OFF = LDSCTL_OFF + 320;
constexpr int LDS_BYTES = 147456;
constexpr int NWAVES = 8;

namespace pg8 {
#define PG8_LAS __attribute__((address_space(3)))
typedef unsigned short bf16_t;
typedef short bf16x8 __attribute__((ext_vector_type(8)));
typedef float f32x4 __attribute__((ext_vector_type(4)));
typedef unsigned u32x4 __attribute__((ext_vector_type(4)));
constexpr int BM = 256, BK = 64, HALF = 128, HTB = HALF * BK * 2  , STAGE_BYTES = 8 * HTB, NXCD = 8, WGM = 8;

__host__ __device__ __forceinline__ int lds_byte(int r, int c) { const int st = (r >> 4) * 2 + (c >> 5), rr = r & 15, cc = c & 31, ob = rr * 64 + cc * 2; return st * 1024 + (ob ^ (((ob >> 9) & 1) << 5)); }
__host__ __device__ __forceinline__ void stage_rc(int b, int& R, int& C) { const int st = b / 1024, sb = b % 1024, swz = sb ^ (((sb >> 9) & 1) << 5); R = (st >> 1) * 16 + swz / 64; C = (st & 1) * 32 + (swz % 64) / 2; }
__host__ __device__ __forceinline__ int perm32(int rho) { const int n = rho >> 4, i = rho & 15; return 8 * (i >> 2) + 4 * n + (i & 3); }

struct Unit { int pm, pn; };
struct Gemm { const bf16_t* A; const bf16_t* Bt; int M, N, K; };

struct StaticOrder {
    int nM, nN, nwg, G, c;
    __host__ __device__ void init(int M, int N, int G_, int c_) { nM = M / BM; nN = N / BM; nwg = nM * nN; G = G_; c = c_; }
    __host__ __device__ bool next(int i, Unit& u) const {
        const long L = (long)i * G + c; if (L >= nwg) return false;
        int wgid = (int)L; { const int q = nwg / NXCD, r = nwg % NXCD, xcd = wgid % NXCD, off = wgid / NXCD; wgid = (xcd < r ? xcd * (q + 1) : r * (q + 1) + (xcd - r) * q) + off; }
        const int nig = WGM * nN, gid = wgid / nig, fm = gid * WGM, gsz = (nM - fm) < WGM ? (nM - fm) : WGM;
        u.pm = fm + ((wgid % nig) % gsz); u.pn = (wgid % nig) / gsz; return true;
    }
    __device__ __forceinline__ void a_ready(const Unit&) const {}
    __device__ __forceinline__ void done(const Unit&) const {}
};

__device__ __forceinline__ unsigned cvt_pk_bf16(float lo, float hi) { unsigned r; asm volatile("v_cvt_pk_bf16_f32 %0, %1, %2" : "=v"(r) : "v"(lo), "v"(hi)); return r; }
typedef float f32x2 __attribute__((ext_vector_type(2)));
__device__ __forceinline__ f32x2 gelu_pk(f32x2 v) {
    const f32x2 av = __builtin_elementwise_abs(v), d = av * 0.2316418882f + 1.0f;
    f32x2 t; t.x = __builtin_amdgcn_rcpf(d.x); t.y = __builtin_amdgcn_rcpf(d.y);
    f32x2 q = t * 0.5307027145f + (-0.7265760135f); q = q * t + 0.7107068705f; q = q * t + (-0.142248368f); q = q * t + 0.127414796f; q = q * t;
    const f32x2 s = (v * v) * (-0.72134752044f);
    f32x2 e; e.x = __builtin_amdgcn_exp2f(s.x); e.y = __builtin_amdgcn_exp2f(s.y);
    const f32x2 m = v * (q * e), r = v - m;
    f32x2 o; o.x = v.x < 0.f ? m.x : r.x; o.y = v.y < 0.f ? m.y : r.y; return o;
}

template <int ACT  > struct EpiBf16 {
    static constexpr bool PERM = true, AFTER_DRAIN = false, PERMA = false; static_assert(ACT == 0 || ACT == 1, "EpiBf16: ACT is 0 (none) or 1 (gelu_pk)");
    bf16_t* O; int ldc; const float* bias; int split_cols; size_t split_stride; float scale0;
    __device__ __forceinline__ void operator()(const f32x4 (&acc)[2][2][4][2], const Unit& u, int wr, int wc, int fr, int fq) const {
        const int row0 = u.pm * BM + wr * 64 + fr; int colt = u.pn * BM; bf16_t* base = O;
        float sc = 1.f; if (split_cols) { const int t = colt / split_cols; base += (size_t)t * split_stride; colt -= t * split_cols; if (t == 0) sc = scale0; }
        const int col0 = colt + wc * 32 + 8 * fq, bcol0 = u.pn * BM + wc * 32 + 8 * fq;
        f32x4 bv[2][2];
#pragma unroll
        for (int bj = 0; bj < 2; ++bj)
#pragma unroll
            for (int n = 0; n < 2; ++n) bv[bj][n] = bias ? *(const f32x4*)(bias + bcol0 + bj * HALF + 4 * n) : (f32x4){0.f, 0.f, 0.f, 0.f};
#pragma unroll
        for (int ai = 0; ai < 2; ++ai)
#pragma unroll
            for (int m = 0; m < 4; ++m) { bf16_t* rowp = base + (size_t)(row0 + ai * HALF + m * 16) * ldc + col0;
#pragma unroll
                for (int bj = 0; bj < 2; ++bj) { f32x4 v0 = acc[ai][bj][m][0] + bv[bj][0], v1 = acc[ai][bj][m][1] + bv[bj][1];
                    if (ACT == 1) { f32x2 a = gelu_pk((f32x2){v0[0], v0[1]}), b = gelu_pk((f32x2){v0[2], v0[3]}), c = gelu_pk((f32x2){v1[0], v1[1]}), d = gelu_pk((f32x2){v1[2], v1[3]});
                        v0 = (f32x4){a.x, a.y, b.x, b.y}; v1 = (f32x4){c.x, c.y, d.x, d.y}; }
                    v0 = v0 * sc; v1 = v1 * sc; u32x4 w; w.x = cvt_pk_bf16(v0[0], v0[1]); w.y = cvt_pk_bf16(v0[2], v0[3]); w.z = cvt_pk_bf16(v1[0], v1[1]); w.w = cvt_pk_bf16(v1[2], v1[3]);
                    *(u32x4*)(rowp + bj * HALF) = w; } }
    }
};

template <bool BASE_BF16, bool OUT_BF16, bool XG> struct EpiResGate {
    static constexpr bool PERM = OUT_BF16, AFTER_DRAIN = false, PERMA = false;
    static constexpr int CN = PERM ? 4 : 16, CQ = PERM ? 8 : 4;
    const void* base; void* out; const float* mod; int goff; bf16_t* xg; const float* g2; float* rowss;
    typedef unsigned u32x2e __attribute__((ext_vector_type(2)));
    static constexpr int GM = BASE_BF16 ? 4 : 2, NG = 8 / GM;
    template <class BT> __device__ __forceinline__ void load_group(BT (&b)[GM * 4], int g, const Unit& u, int wr, int fr, int col0) const {
#pragma unroll
        for (int q = 0; q < GM; ++q) { const int am = g * GM + q; const size_t row = (size_t)(u.pm * BM + (am >> 2) * HALF + wr * 64 + (am & 3) * 16 + fr);
#pragma unroll
            for (int bj = 0; bj < 2; ++bj)
#pragma unroll
                for (int n = 0; n < 2; ++n) b[q * 4 + bj * 2 + n] = *(const BT*)((const typename std::conditional<BASE_BF16, bf16_t, float>::type*)base + row * 1024 + col0 + bj * HALF + n * CN); }
    }
    __device__ __forceinline__ void operator()(const f32x4 (&acc)[2][2][4][2], const Unit& u, int wr, int wc, int fr, int fq) const {
        typedef typename std::conditional<BASE_BF16, u32x2e, f32x4>::type BT;
        const int col0 = u.pn * BM + wc * 32 + CQ * fq;
        const float* mrow = mod + (size_t)((u.pm * BM) >> 11) * 6144;
        BT ring[2][GM * 4];
        load_group(ring[0], 0, u, wr, fr, col0);
        f32x4 gt[2][2], G2[2][2];
#pragma unroll
        for (int bj = 0; bj < 2; ++bj)
#pragma unroll
            for (int n = 0; n < 2; ++n) { const int c = col0 + bj * HALF + n * CN; gt[bj][n] = *(const f32x4*)(mrow + goff + c);
                if (XG) G2[bj][n] = *(const f32x4*)(g2 + c) * (*(const f32x4*)(mrow + 4096 + c) + 1.0f); }
#pragma unroll
        for (int g = 0; g < NG; ++g) {
            if (g + 1 < NG) load_group(ring[(g + 1) & 1], g + 1, u, wr, fr, col0);
            asm volatile("" ::: "memory");
#pragma unroll
            for (int q = 0; q < GM; ++q) { const int am = g * GM + q, ai = am >> 2, m = am & 3;
                const size_t row = (size_t)(u.pm * BM + ai * HALF + wr * 64 + m * 16 + fr);
                float ss = 0.f;
#pragma unroll
                for (int bj = 0; bj < 2; ++bj) { u32x2e wo[2], wx[2];
#pragma unroll
                    for (int n = 0; n < 2; ++n) { const int c = col0 + bj * HALF + n * CN;
                        f32x4 bs;
                        if constexpr (BASE_BF16) { const u32x2e w = ring[g & 1][q * 4 + bj * 2 + n]; bs = (f32x4){__uint_as_float(w.x << 16), __uint_as_float(w.x & 0xffff0000u), __uint_as_float(w.y << 16), __uint_as_float(w.y & 0xffff0000u)}; }
                        else bs = ring[g & 1][q * 4 + bj * 2 + n];
                        const f32x4 o = bs + gt[bj][n] * acc[ai][bj][m][n];
                        if (OUT_BF16) { wo[n].x = cvt_pk_bf16(o[0], o[1]); wo[n].y = cvt_pk_bf16(o[2], o[3]); if (!PERM) *(u32x2e*)((bf16_t*)out + row * 1024 + c) = wo[n]; }
                        else *(f32x4*)((float*)out + row * 1024 + c) = o;
                        if (XG) { const f32x4 x = o * G2[bj][n]; wx[n].x = cvt_pk_bf16(x[0], x[1]); wx[n].y = cvt_pk_bf16(x[2], x[3]); if (!PERM) *(u32x2e*)(xg + row * 1024 + c) = wx[n];
                            ss += (o[0] * o[0] + o[1] * o[1]) + (o[2] * o[2] + o[3] * o[3]); } }
                    if (PERM) { const int c8 = col0 + bj * HALF;
                        if (OUT_BF16) *(u32x4*)((bf16_t*)out + row * 1024 + c8) = (u32x4){wo[0].x, wo[0].y, wo[1].x, wo[1].y};
                        if (XG) *(u32x4*)(xg + row * 1024 + c8) = (u32x4){wx[0].x, wx[0].y, wx[1].x, wx[1].y}; } }
                if (XG) {
                    { auto rr = __builtin_amdgcn_permlane16_swap(__float_as_uint(ss), __float_as_uint(ss), false, false); ss = __uint_as_float(rr[0]) + __uint_as_float(rr[1]); }
                    { auto rr = __builtin_amdgcn_permlane32_swap(__float_as_uint(ss), __float_as_uint(ss), false, false); ss = __uint_as_float(rr[0]) + __uint_as_float(rr[1]); }
                    if (fq == 0) __hip_atomic_fetch_add(rowss + row, ss, __ATOMIC_RELAXED, __HIP_MEMORY_SCOPE_AGENT); }
            }
        }
    }
};


__device__ __forceinline__ float dpp_shr1(float v) { return __builtin_bit_cast(float, __builtin_amdgcn_update_dpp(0, __builtin_bit_cast(int, v), 0x111, 0xf, 0xf, false)); }
__device__ __forceinline__ float gelu_tanh_e(float x) { const float u = 0.7978845608028654f * (x + 0.044715f * x * x * x); return x * __builtin_amdgcn_rcpf(1.0f + __builtin_amdgcn_exp2f(-2.8853900817779268f * u)); }
#ifndef CW1_AT
#define CW1_AT 7
#endif
struct EpiConvGelu {
    static constexpr bool PERM = true, AFTER_DRAIN = false, PERMA = true;
    bf16_t* ACT; float* RAW; const float* fw; const float* fb; const float* rowss; const float* SB;
    __device__ __forceinline__ void operator()(const f32x4 (&acc_)[2][2][4][2], const Unit& u, int wr, int wc, int fr_, int fq_) const {
        f32x4 (&acc)[2][2][4][2] = const_cast<f32x4 (&)[2][2][4][2]>(acc_);
        int ln_; asm volatile("v_mbcnt_lo_u32_b32 %0, -1, 0\n\tv_mbcnt_hi_u32_b32 %0, -1, %0" : "=v"(ln_)); const int fr = ln_ & 15, fq = ln_ >> 4; (void)fr_; (void)fq_;
        const int tb = u.pm * BM + wr * 128 + fr * 8;
        { const f32x4 s0 = *(const f32x4*)(rowss + tb), s1 = *(const f32x4*)(rowss + tb + 4);
          float rs[8]; rs[0] = s0[0]; rs[1] = s0[1]; rs[2] = s0[2]; rs[3] = s0[3]; rs[4] = s1[0]; rs[5] = s1[1]; rs[6] = s1[2]; rs[7] = s1[3];
#pragma unroll
          for (int j = 0; j < 8; ++j) rs[j] = __builtin_amdgcn_rsqf(rs[j] * (1.f / 1024.f) + 1e-6f);
          const float* sbp = SB + (size_t)((u.pm * BM) >> 11) * 5632 + u.pn * BM + wc * 32 + fq * 8;
#pragma unroll
          for (int bj = 0; bj < 2; ++bj)
#pragma unroll
              for (int n = 0; n < 2; ++n) { const f32x4 sb = *(const f32x4*)(sbp + bj * HALF + 4 * n);
#pragma unroll
                  for (int j = 0; j < 8; ++j) acc[j >> 2][bj][j & 3][n] = acc[j >> 2][bj][j & 3][n] * rs[j] + sb; } }
        const int cb = u.pn * 128 + wc * 32 + fq * 8;
        const int blk = u.pm * 2 + wr;
        f32x4 cw[2][8];
#define CW_LOAD(n) do { const int c0_ = cb + 4 * (n); \
            cw[n][0] = *(const f32x4*)(fw + c0_); cw[n][1] = *(const f32x4*)(fw + 5632 + c0_); cw[n][2] = *(const f32x4*)(fw + 11264 + c0_); cw[n][3] = *(const f32x4*)(fb + c0_); \
            cw[n][4] = *(const f32x4*)(fw + 2816 + c0_); cw[n][5] = *(const f32x4*)(fw + 5632 + 2816 + c0_); cw[n][6] = *(const f32x4*)(fw + 11264 + 2816 + c0_); cw[n][7] = *(const f32x4*)(fb + 2816 + c0_); } while (0)
#pragma unroll
        for (int n = 0; n < 2; ++n) {
            const int c0 = cb + 4 * n;
            if (n == 0) CW_LOAD(0);
            const f32x4 wv0 = cw[n][0], wv1 = cw[n][1], wv2 = cw[n][2], bv = cw[n][3], wg0 = cw[n][4], wg1 = cw[n][5], wg2 = cw[n][6], bg = cw[n][7];
            f32x4 pv1, pv2, pg1, pg2;
#pragma unroll
            for (int e = 0; e < 4; ++e) { pv1[e] = dpp_shr1(acc[1][0][3][n][e]); pv2[e] = dpp_shr1(acc[1][0][2][n][e]); pg1[e] = dpp_shr1(acc[1][1][3][n][e]); pg2[e] = dpp_shr1(acc[1][1][2][n][e]); }
#pragma unroll
            for (int j = 0; j < 8; ++j) { const int ai = j >> 2, m = j & 3;
                if (n == 0 && j == 1) {
                    if (fr == 15) { float* r = RAW + (size_t)blk * 4 * 5632;
#pragma unroll
                        for (int n2 = 0; n2 < 2; ++n2) { const int c2 = cb + 4 * n2;
                            *(f32x4*)(r + c2) = acc[1][0][2][n2]; *(f32x4*)(r + 2816 + c2) = acc[1][1][2][n2]; *(f32x4*)(r + 5632 + c2) = acc[1][0][3][n2]; *(f32x4*)(r + 5632 + 2816 + c2) = acc[1][1][3][n2]; } }
                    if (fr == 0) { float* r = RAW + ((size_t)blk * 4 + 2) * 5632;
#pragma unroll
                        for (int n2 = 0; n2 < 2; ++n2) { const int c2 = cb + 4 * n2;
                            *(f32x4*)(r + c2) = acc[0][0][0][n2]; *(f32x4*)(r + 2816 + c2) = acc[0][1][0][n2]; *(f32x4*)(r + 5632 + c2) = acc[0][0][1][n2]; *(f32x4*)(r + 5632 + 2816 + c2) = acc[0][1][1][n2]; } } }
                if (n == 0 && j == CW1_AT) CW_LOAD(1);
                const f32x4 v = acc[ai][0][m][n], g = acc[ai][1][m][n];
                const f32x4 val = bv + wv0 * pv2 + wv1 * pv1 + wv2 * v, gt = bg + wg0 * pg2 + wg1 * pg1 + wg2 * g;
                u32x4 dummy; (void)dummy;
                const unsigned p0 = cvt_pk_bf16(gelu_tanh_e(gt[0]) * val[0], gelu_tanh_e(gt[1]) * val[1]), p1 = cvt_pk_bf16(gelu_tanh_e(gt[2]) * val[2], gelu_tanh_e(gt[3]) * val[3]);
                typedef unsigned u32x2e __attribute__((ext_vector_type(2)));
                *(u32x2e*)(ACT + (size_t)(tb + j) * 2816 + c0) = (u32x2e){p0, p1};
                pv2 = pv1; pv1 = v; pg2 = pg1; pg1 = g; }
        }
#undef CW_LOAD
    }
};

template <bool PA> struct EpiNull {
    static constexpr bool PERM = false, AFTER_DRAIN = false, PERMA = PA;
    __device__ __forceinline__ void operator()(const f32x4 (&acc)[2][2][4][2], const Unit& u, int wr, int wc, int fr, int fq) const {
#pragma unroll
        for (int i = 0; i < 32; ++i) asm volatile("" :: "v"(acc[i >> 4][(i >> 3) & 1][(i >> 1) & 3][i & 1]));
    }
};

template <int MODE> struct EpiProbe {
    static constexpr bool PERM = false, AFTER_DRAIN = false, PERMA = false;
    float* out; const bf16_t* base;
    __device__ __forceinline__ void operator()(const f32x4 (&acc)[2][2][4][2], const Unit& u, int wr, int wc, int fr, int fq) const {
        typedef unsigned u32x2e __attribute__((ext_vector_type(2)));
        const int col0 = u.pn * BM + wc * 32 + 4 * fq;
#pragma unroll
        for (int am = 0; am < 8; ++am) { const int ai = am >> 2, m = am & 3; const size_t row = (size_t)(u.pm * BM + ai * HALF + wr * 64 + m * 16 + fr);
#pragma unroll
            for (int bj = 0; bj < 2; ++bj)
#pragma unroll
                for (int n = 0; n < 2; ++n) { const int c = col0 + bj * HALF + n * 16;
                    if (MODE == 0) *(f32x4*)(out + row * 1024 + c) = acc[ai][bj][m][n];
                    else if (MODE == 1) { const u32x2e w = *(const u32x2e*)(base + row * 1024 + c); asm volatile("" :: "v"(w), "v"(acc[ai][bj][m][n])); }
                    else { u32x2e w; w.x = cvt_pk_bf16(acc[ai][bj][m][n][0], acc[ai][bj][m][n][1]); w.y = cvt_pk_bf16(acc[ai][bj][m][n][2], acc[ai][bj][m][n][3]); *(u32x2e*)((bf16_t*)out + row * 1024 + c) = w; } } }
    }
};
template <class Epi, class Sched, bool ALIGN_EPI = false, bool SP2 = false>
__device__ __forceinline__ void gemm_phase(PG8_LAS unsigned char* lds, const Gemm g, const Sched& S, const Epi& E, const int tid) {
    const int wid = __builtin_amdgcn_readfirstlane(tid >> 6), lane = tid & 63, wr = wid >> 2, wc = wid & 3, fr = lane & 15, fq = lane >> 4;
    const int K = g.K, nt = K / BK;
    unsigned voffA[2], voffB[2];
#pragma unroll
    for (int i = 0; i < 2; ++i) { int R, C; stage_rc(tid * 16 + i * 8192, R, C); const int Rb = Epi::PERM ? ((R & ~31) + perm32(R & 31)) : R;
        const int Ra = Epi::PERMA ? (128 * (R >> 6) + 8 * (R & 15) + ((R >> 4) & 3)) : R;
        voffA[i] = (unsigned)(Ra * K + C) * 2u; voffB[i] = (unsigned)(Rb * K + C) * 2u; }
    const size_t kstep = (size_t)(BK * 2);
    const size_t hstep = (size_t)HALF * K * 2;
    const size_t hstepA = Epi::PERMA ? (size_t)4 * K * 2 : hstep;
    const size_t tstep = 2 * hstep;
    const unsigned ldsw = (unsigned)wid * 1024u;
    const int aoff = lds_byte(wr * 64 + fr, fq * 8), boff = lds_byte(wc * 32 + fr, fq * 8);
#define PG8_SA(b, h) (((b) * 2 + (h)) * HTB)
#define PG8_SB(b, h) ((4 + (b) * 2 + (h)) * HTB)
#define PG8_STAGE(bufoff, gbase, voff) do { _Pragma("unroll") for (int _i = 0; _i < 2; ++_i) \
        __builtin_amdgcn_global_load_lds((const unsigned*)((const char*)(gbase) + (voff)[_i]), (PG8_LAS unsigned*)(lds + (bufoff) + ldsw + _i * 8192), 16, 0, 0); } while (0)
#define PG8_LDA(dst, b, h) do { _Pragma("unroll") for (int m = 0; m < 4; ++m) _Pragma("unroll") for (int k = 0; k < 2; ++k) dst[m][k] = *(const PG8_LAS bf16x8*)(lds + PG8_SA(b, h) + aoff + m * 2048 + k * 1024); } while (0)
#define PG8_LDB(dst, b, h) do { _Pragma("unroll") for (int n = 0; n < 2; ++n) _Pragma("unroll") for (int k = 0; k < 2; ++k) dst[n][k] = *(const PG8_LAS bf16x8*)(lds + PG8_SB(b, h) + boff + n * 2048 + k * 1024); } while (0)
#define PG8_MMA(ai, bj, At, Bt) do { __builtin_amdgcn_s_setprio(1); _Pragma("unroll") for (int m = 0; m < 4; ++m) _Pragma("unroll") for (int n = 0; n < 2; ++n) _Pragma("unroll") for (int k = 0; k < 2; ++k) \
        acc[ai][bj][m][n] = __builtin_amdgcn_mfma_f32_16x16x32_bf16(Bt[n][k], At[m][k], acc[ai][bj][m][n], 0, 0, 0); __builtin_amdgcn_s_setprio(0); } while (0)
#define PG8_WAIT_V(n) asm volatile("s_waitcnt vmcnt(" #n ")" ::: "memory")
#define PG8_WAIT_L(n) asm volatile("s_waitcnt lgkmcnt(" #n ")" ::: "memory")
#define PG8_BAR __builtin_amdgcn_s_barrier()
#define PG8_SCHED __builtin_amdgcn_sched_barrier(0)
    Unit cur, nxt; int ui = 0;
    if (!S.next(0, cur)) return;
    f32x4 acc[2][2][4][2];
#pragma unroll
    for (int a = 0; a < 2; ++a)
#pragma unroll
        for (int b = 0; b < 2; ++b)
#pragma unroll
            for (int m = 0; m < 4; ++m)
#pragma unroll
                for (int n = 0; n < 2; ++n) acc[a][b][m][n] = (f32x4){0.f, 0.f, 0.f, 0.f};
    bf16x8 At[4][2], B0[2][2], B1[2][2];
    const char* cA = (const char*)g.A + (size_t)cur.pm * tstep; const char* cB = (const char*)g.Bt + (size_t)cur.pn * tstep;
    S.a_ready(cur);
    if constexpr (SP2) {
        PG8_STAGE(PG8_SB(0, 0), cB, voffB); PG8_STAGE(PG8_SB(0, 1), cB + hstep, voffB); PG8_STAGE(PG8_SA(0, 0), cA, voffA); PG8_STAGE(PG8_SA(0, 1), cA + hstepA, voffA);
        if (wr == 1) PG8_BAR;
        PG8_WAIT_V(2); PG8_BAR;
        PG8_STAGE(PG8_SB(1, 0), cB + kstep, voffB); PG8_STAGE(PG8_SA(1, 0), cA + kstep, voffA); PG8_STAGE(PG8_SB(1, 1), cB + hstep + kstep, voffB);
        PG8_WAIT_V(6); PG8_BAR;
    } else {
        PG8_STAGE(PG8_SB(0, 0), cB, voffB); PG8_STAGE(PG8_SA(0, 0), cA, voffA); PG8_STAGE(PG8_SB(0, 1), cB + hstep, voffB); PG8_STAGE(PG8_SA(0, 1), cA + hstepA, voffA);
        if (wr == 1) PG8_BAR;
        PG8_WAIT_V(4); PG8_BAR;
        PG8_STAGE(PG8_SB(1, 0), cB + kstep, voffB); PG8_STAGE(PG8_SA(1, 0), cA + kstep, voffA); PG8_STAGE(PG8_SB(1, 1), cB + hstep + kstep, voffB);
        PG8_WAIT_V(6); PG8_BAR;
    }
    for (;;) {
        const bool has_next = S.next(ui + 1, nxt);
        const char* nA = has_next ? (const char*)g.A + (size_t)nxt.pm * tstep : cA; const char* nB = has_next ? (const char*)g.Bt + (size_t)nxt.pn * tstep : cB;
        for (int t = 0; t < nt; t += 2) {
            const bool last = (t == nt - 2);
            const char* a1 = cA + (size_t)(t + 1) * kstep;
            const char* a2 = last ? nA : cA + (size_t)(t + 2) * kstep; const char* b2 = last ? nB : cB + (size_t)(t + 2) * kstep;
            const char* a3 = a2 + kstep; const char* b3 = b2 + kstep;
            if (last && has_next) S.a_ready(nxt);
            if constexpr (SP2) {
            PG8_LDB(B0, 0, 0); PG8_LDB(B1, 0, 1); PG8_SCHED; PG8_LDA(At, 0, 0); PG8_STAGE(PG8_SA(1, 1), a1 + hstepA, voffA);
            PG8_WAIT_V(8); PG8_WAIT_L(0); PG8_BAR; PG8_MMA(0, 0, At, B0); PG8_MMA(0, 1, At, B1); PG8_BAR; PG8_SCHED;
            PG8_LDA(At, 0, 1); PG8_STAGE(PG8_SB(0, 0), b2, voffB); PG8_STAGE(PG8_SB(0, 1), b2 + hstep, voffB); PG8_STAGE(PG8_SA(0, 0), a2, voffA);
            PG8_WAIT_V(8); PG8_WAIT_L(0); PG8_BAR; PG8_MMA(1, 0, At, B0); PG8_MMA(1, 1, At, B1); PG8_BAR; PG8_SCHED;
            PG8_LDB(B0, 1, 0); PG8_LDB(B1, 1, 1); PG8_SCHED; PG8_LDA(At, 1, 0); PG8_STAGE(PG8_SA(0, 1), a2 + hstepA, voffA);
            PG8_WAIT_V(8); PG8_WAIT_L(0); PG8_BAR; PG8_MMA(0, 0, At, B0); PG8_MMA(0, 1, At, B1); PG8_BAR; PG8_SCHED;
            PG8_LDA(At, 1, 1); PG8_STAGE(PG8_SB(1, 0), b3, voffB); PG8_STAGE(PG8_SB(1, 1), b3 + hstep, voffB); PG8_STAGE(PG8_SA(1, 0), a3, voffA);
            PG8_WAIT_V(8); PG8_WAIT_L(0); PG8_BAR; PG8_MMA(1, 0, At, B0); PG8_MMA(1, 1, At, B1); PG8_BAR; PG8_SCHED;
            } else {
            PG8_LDB(B0, 0, 0); PG8_SCHED; PG8_LDA(At, 0, 0); PG8_STAGE(PG8_SA(1, 1), a1 + hstepA, voffA);
            PG8_WAIT_L(8); PG8_BAR; PG8_WAIT_L(0); PG8_MMA(0, 0, At, B0); PG8_BAR; PG8_SCHED;
            PG8_LDB(B1, 0, 1); PG8_STAGE(PG8_SB(0, 0), b2, voffB);
            PG8_BAR; PG8_WAIT_L(0); PG8_MMA(0, 1, At, B1); PG8_BAR;
            PG8_LDA(At, 0, 1); PG8_STAGE(PG8_SA(0, 0), a2, voffA);
            PG8_BAR; PG8_WAIT_L(0); PG8_MMA(1, 0, At, B0); PG8_BAR; PG8_SCHED;
            PG8_STAGE(PG8_SB(0, 1), b2 + hstep, voffB);
            PG8_WAIT_V(6); PG8_BAR; PG8_MMA(1, 1, At, B1); PG8_BAR;
            PG8_LDB(B0, 1, 0); PG8_SCHED; PG8_LDA(At, 1, 0); PG8_STAGE(PG8_SA(0, 1), a2 + hstepA, voffA);
            PG8_WAIT_L(8); PG8_BAR; PG8_WAIT_L(0); PG8_MMA(0, 0, At, B0); PG8_BAR; PG8_SCHED;
            PG8_LDB(B1, 1, 1); PG8_STAGE(PG8_SB(1, 0), b3, voffB);
            PG8_BAR; PG8_WAIT_L(0); PG8_MMA(0, 1, At, B1); PG8_BAR;
            PG8_LDA(At, 1, 1); PG8_STAGE(PG8_SA(1, 0), a3, voffA);
            PG8_BAR; PG8_WAIT_L(0); PG8_MMA(1, 0, At, B0); PG8_BAR; PG8_SCHED;
            PG8_STAGE(PG8_SB(1, 1), b3 + hstep, voffB);
            PG8_WAIT_V(6); PG8_BAR; PG8_MMA(1, 1, At, B1); PG8_BAR;
            }
        }
        if constexpr (ALIGN_EPI) { if (wr == 0) PG8_BAR; }
        if constexpr (!Epi::AFTER_DRAIN) { E(acc, cur, wr, wc, fr, fq); S.done(cur); }
        if (!has_next) break;
#pragma unroll
        for (int a = 0; a < 2; ++a)
#pragma unroll
            for (int b = 0; b < 2; ++b)
#pragma unroll
                for (int m = 0; m < 4; ++m)
#pragma unroll
                    for (int n = 0; n < 2; ++n) acc[a][b][m][n] = (f32x4){0.f, 0.f, 0.f, 0.f};
        cur = nxt; cA = nA; cB = nB; ++ui;
        if constexpr (ALIGN_EPI) { if (wr == 1) PG8_BAR; }
    }
    PG8_WAIT_V(0);
    if constexpr (!ALIGN_EPI) { if (wr == 0) PG8_BAR; }
    PG8_BAR;
    if constexpr (Epi::AFTER_DRAIN) { E.fused(acc, cur, wr, wc, fr, fq, lds, wid, lane); S.done(cur); }
#undef PG8_SA
#undef PG8_SB
#undef PG8_STAGE
#undef PG8_LDA
#undef PG8_LDB
#undef PG8_MMA
#undef PG8_WAIT_V
#undef PG8_WAIT_L
#undef PG8_BAR
#undef PG8_SCHED
}
}
#define GAS __attribute__((address_space(1)))
#define LAS __attribute__((address_space(3)))
typedef unsigned short bf16;
typedef unsigned v4u __attribute__((ext_vector_type(4)));
typedef float f32x4 __attribute__((ext_vector_type(4)));
typedef short bf16x8 __attribute__((ext_vector_type(8)));
typedef GAS unsigned gu32;
typedef GAS unsigned long long gu64;
#define RLX_AGENT __ATOMIC_RELAXED, __HIP_MEMORY_SCOPE_AGENT
#define LDS_WAIT() asm volatile("s_waitcnt lgkmcnt(0)" ::: "memory")
#define VM_WAIT() asm volatile("s_waitcnt vmcnt(0)" ::: "memory")
__device__ __forceinline__ unsigned long long rt() { return __builtin_amdgcn_s_memrealtime(); }
typedef float f32x2_cv __attribute__((ext_vector_type(2))); typedef __bf16 bf16x2_cv __attribute__((ext_vector_type(2)));
__device__ __forceinline__ unsigned pk2(float lo, float hi) { f32x2_cv v = {lo, hi}; bf16x2_cv b = __builtin_convertvector(v, bf16x2_cv); return __builtin_bit_cast(unsigned, b); }
__device__ __forceinline__ unsigned f2bf(float f) { return pk2(f, f) & 0xffffu; }
#define XB_TMO      128
#define XB_XCNT(j)  (256  + 64 * (j))
#define XB_XSUB(j)  (1280 + 64 * (j))
#define XB_XGEN(j)  (2304 + 64 * (j))
#define XB_TOP      3328
#define XB_TOPGEN   3392
#define XCD_BAR_WORDS 3456
#define XB_SPIN_CAP (1u << 18)

__device__ __forceinline__ unsigned xb_ld(unsigned* p)              { return __hip_atomic_load(p, __ATOMIC_RELAXED, __HIP_MEMORY_SCOPE_AGENT); }
__device__ __forceinline__ unsigned xb_add(unsigned* p, unsigned v) { return __hip_atomic_fetch_add(p, v, __ATOMIC_RELAXED, __HIP_MEMORY_SCOPE_AGENT); }
__device__ __forceinline__ unsigned xb_xcc_id() { return (unsigned)__builtin_amdgcn_s_getreg((3 << 11) | 20) & 0xFu; }
#define XB_SPIN(cond, bar) do { unsigned _sp = 0; while (cond) { __builtin_amdgcn_s_sleep(1); \
    if ((++_sp & 255u) == 0u) { if (xb_ld(&(bar)[XB_TMO])) break; if (_sp > XB_SPIN_CAP) { atomicAdd(&(bar)[XB_TMO], 1u); break; } } } } while (0)

struct XcdBarrier {
    unsigned* bar; unsigned x;
    volatile LAS unsigned* st;
};

__device__ __forceinline__ XcdBarrier xcd_barrier_post(unsigned* bar, volatile LAS unsigned* st, int tid) {
    XcdBarrier b; b.bar = bar; b.x = xb_xcc_id(); b.st = st;
    if (tid == 0) (void)xb_add(&bar[XB_XCNT(b.x)], 1u);
    return b;
}
__device__ __forceinline__ void xcd_barrier_complete(unsigned* bar, unsigned x, unsigned& nloc, unsigned& nx) {
    const unsigned G = gridDim.x * gridDim.y * gridDim.z;
    unsigned sum, cnt, mine, sp = 0u;
    for (;;) {
        sum = 0u; cnt = 0u; mine = 0u;
#pragma unroll
        for (unsigned j = 0; j < 16; ++j) { const unsigned c = xb_ld(&bar[XB_XCNT(j)]); sum += c; cnt += (c > 0u) ? 1u : 0u; mine = (j == x) ? c : mine; }
        if (sum == G) break;
        __builtin_amdgcn_s_sleep(1);
        if ((++sp & 255u) == 0u) { if (xb_ld(&bar[XB_TMO])) break; if (sp > XB_SPIN_CAP) { atomicAdd(&bar[XB_TMO], 1u); break; } }
    }
    nloc = mine > 0u ? mine : 1u; nx = cnt > 0u ? cnt : 1u;
}

__device__ __forceinline__ void xcd_barrier(const XcdBarrier& b, int tid) {
    asm volatile("s_waitcnt vmcnt(0)" ::: "memory");
    __syncthreads();
    if (tid == 0) {
        unsigned* bar = b.bar;
        __builtin_amdgcn_s_waitcnt(0);
        unsigned nloc = b.st[0], nx = b.st[1];
        if (nloc == 0u) { xcd_barrier_complete(bar, b.x, nloc, nx); b.st[0] = nloc; b.st[1] = nx; }
        const unsigned old = xb_add(&bar[XB_XSUB(b.x)], 1u);
        const unsigned gen = old / nloc;
        if (old + 1u == (gen + 1u) * nloc) {
            __builtin_amdgcn_fence(__ATOMIC_RELEASE, "agent");
            asm volatile("s_waitcnt vmcnt(0)" ::: "memory");
            const unsigned og = xb_add(&bar[XB_TOP], 1u);
            const unsigned tg = og / nx;
            if (og + 1u == (tg + 1u) * nx) xb_add(&bar[XB_TOPGEN], 1u);
            else XB_SPIN(xb_ld(&bar[XB_TOPGEN]) == tg, bar);
            __builtin_amdgcn_fence(__ATOMIC_ACQUIRE, "agent");
            xb_add(&bar[XB_XGEN(b.x)], 1u);
            asm volatile("s_waitcnt vmcnt(0)" ::: "memory");
        } else {
            XB_SPIN(xb_ld(&bar[XB_XGEN(b.x)]) == gen, bar);
            __builtin_amdgcn_fence(__ATOMIC_ACQUIRE, "agent");
            asm volatile("s_waitcnt vmcnt(0)" ::: "memory");
        }
    }
    __syncthreads();
}

typedef float f32x16 __attribute__((ext_vector_type(16)));
typedef float f32x2 __attribute__((ext_vector_type(2)));
typedef unsigned v2u __attribute__((ext_vector_type(2)));
typedef short s16x4 __attribute__((ext_vector_type(4)));

struct Params { const float* in[37]; float* out; unsigned char* ws; int ph_lo, ph_hi; };

__device__ __forceinline__ float bf2f(unsigned short b) { return __uint_as_float(((unsigned)b) << 16); }
__device__ __forceinline__ float bflo(unsigned w) { return __uint_as_float(w << 16); }
__device__ __forceinline__ float bfhi(unsigned w) { return __uint_as_float(w & 0xffff0000u); }
#define DPPF0(v, ctrl) __builtin_bit_cast(float, __builtin_amdgcn_update_dpp(__builtin_bit_cast(int, v), __builtin_bit_cast(int, v), ctrl, 0xf, 0xf, false))
__device__ __forceinline__ float row16_sum(float v) { v += DPPF0(v, 0xB1); v += DPPF0(v, 0x4E); v += DPPF0(v, 0x141); v += DPPF0(v, 0x140); return v; }
__device__ __forceinline__ float lane_xor16(float v, int lane) { auto rr = __builtin_amdgcn_permlane16_swap(__float_as_uint(v), __float_as_uint(v), false, false); return __uint_as_float((lane & 16) ? rr[0] : rr[1]); }
__device__ __forceinline__ float lane_xor32(float v, int lane) { auto rr = __builtin_amdgcn_permlane32_swap(__float_as_uint(v), __float_as_uint(v), false, false); return __uint_as_float((lane & 32) ? rr[0] : rr[1]); }
__device__ __forceinline__ float wave_sum(float v) {
    v = row16_sum(v);
    { auto rr = __builtin_amdgcn_permlane16_swap(__float_as_uint(v), __float_as_uint(v), false, false); v = __uint_as_float(rr[0]) + __uint_as_float(rr[1]); }
    { auto rr = __builtin_amdgcn_permlane32_swap(__float_as_uint(v), __float_as_uint(v), false, false); v = __uint_as_float(rr[0]) + __uint_as_float(rr[1]); }
    return v;
}
__device__ __forceinline__ void unpack8f(const v4u& w, float* v) { v[0] = bflo(w.x); v[1] = bfhi(w.x); v[2] = bflo(w.y); v[3] = bfhi(w.y); v[4] = bflo(w.z); v[5] = bfhi(w.z); v[6] = bflo(w.w); v[7] = bfhi(w.w); }
__device__ __forceinline__ float wave_max(float v) {
#pragma unroll
    for (int o = 1; o < 64; o <<= 1) v = fmaxf(v, __shfl_xor(v, o));
    return v;
}
__device__ __forceinline__ float dpp_f(float v, int ctrl_dummy);
#define DPPF(v, ctrl) __builtin_bit_cast(float, __builtin_amdgcn_update_dpp(__builtin_bit_cast(int, v), __builtin_bit_cast(int, v), ctrl, 0xf, 0xf, false))
__device__ __forceinline__ float half_max32(float v) {
    v = fmaxf(v, DPPF(v, 0xB1)); v = fmaxf(v, DPPF(v, 0x4E)); v = fmaxf(v, DPPF(v, 0x141)); v = fmaxf(v, DPPF(v, 0x140));
    auto rr = __builtin_amdgcn_permlane16_swap(__float_as_uint(v), __float_as_uint(v), false, false);
    return fmaxf(__uint_as_float(rr[0]), __uint_as_float(rr[1]));
}
__device__ __forceinline__ float gelu_tanh(float x) {
    const float u = 0.7978845608028654f * (x + 0.044715f * x * x * x);
    return x * __builtin_amdgcn_rcpf(1.0f + __builtin_amdgcn_exp2f(-2.8853900817779268f * u));
}
__device__ __forceinline__ float sigmoidf_(float x) { return __builtin_amdgcn_rcpf(1.0f + __builtin_amdgcn_exp2f(-1.4426950408889634f * x)); }
__device__ __forceinline__ f32x16 mfma32(bf16x8 a, bf16x8 b, f32x16 c) { return __builtin_amdgcn_mfma_f32_32x32x16_bf16(a, b, c, 0, 0, 0); }
__device__ __forceinline__ f32x4 mfma16(bf16x8 a, bf16x8 b, f32x4 c) { return __builtin_amdgcn_mfma_f32_16x16x32_bf16(a, b, c, 0, 0, 0); }
__device__ __forceinline__ int crow(int r, int hi) { return (r & 3) + 8 * (r >> 2) + 4 * hi; }
__device__ __forceinline__ bf16x8 pack8(const float* v) { v4u w; w.x = pk2(v[0], v[1]); w.y = pk2(v[2], v[3]); w.z = pk2(v[4], v[5]); w.w = pk2(v[6], v[7]); return __builtin_bit_cast(bf16x8, w); }
__device__ __forceinline__ float xhalf_sum(float v) { auto rr = __builtin_amdgcn_permlane32_swap(__float_as_uint(v), __float_as_uint(v), false, false); return __uint_as_float(rr[0]) + __uint_as_float(rr[1]); }

__device__ __forceinline__ int fresh_lane() { int l; asm volatile("v_mbcnt_lo_u32_b32 %0, -1, 0\n\tv_mbcnt_hi_u32_b32 %0, -1, %0" : "=v"(l)); return l; }
struct Ctx {
    LAS unsigned char* lds; int tid, lane, wave, G, bid;
    const Params* p;
};
#define WSP(T, off) ((T*)(P.ws + (off)))

template <bool UPPERM = false> __device__ __forceinline__ void p0_transpose_item(const float* W, int N, bf16* WT, int ldk, LAS float* scr, int nblk, int item, int lane) {
    const int kb = item / nblk, nb = item % nblk, k0 = 64 * kb, n0 = 32 * nb;
    const int d0 = UPPERM ? ((n0 < DFF) ? (256 * (n0 >> 7) + (n0 & 127)) : (256 * ((n0 - DFF) >> 7) + 128 + ((n0 - DFF) & 127))) : n0;
#pragma unroll 8
    for (int i = 0; i < 32; ++i) { const int kk = 2 * i + (lane >> 5); scr[kk * 33 + (lane & 31)] = W[(size_t)(k0 + kk) * N + n0 + (lane & 31)]; }
    LDS_WAIT(); asm volatile("" ::: "memory");
    const int c = lane & 7;
#pragma unroll
    for (int j = 0; j < 4; ++j) { const int n = (lane >> 3) + 8 * j; const LAS float* s = scr + (8 * c) * 33 + n;
        v4u o; o.x = pk2(s[0 * 33], s[1 * 33]); o.y = pk2(s[2 * 33], s[3 * 33]); o.z = pk2(s[4 * 33], s[5 * 33]); o.w = pk2(s[6 * 33], s[7 * 33]);
        *(GAS v4u*)(WT + (size_t)(d0 + n) * ldk + k0 + 8 * c) = o; }
    LDS_WAIT(); asm volatile("" ::: "memory");
}
constexpr int CW_SC = 16384;
constexpr int CW_F4 = 16448, CW_F8 = 16512, CW_F7 = 16576;
__device__ __forceinline__ void flag_publish(const Ctx& C, const Params& P, int word) {
    asm volatile("s_waitcnt vmcnt(0)" ::: "memory");
    __syncthreads();
    if (C.tid == 0) { __builtin_amdgcn_fence(__ATOMIC_RELEASE, "agent"); asm volatile("s_waitcnt vmcnt(0)" ::: "memory"); (void)xb_add((unsigned*)(P.ws + WS_CTL) + word, 1u); }
}
__device__ __forceinline__ void flag_wait(const Ctx& C, const Params& P, int word) {
    if (C.tid == 0) { unsigned* cnt = (unsigned*)(P.ws + WS_CTL) + word; unsigned sp = 0u;
        while (xb_ld(cnt) < (unsigned)C.G) { __builtin_amdgcn_s_sleep(1); if (++sp > (1u << 22)) break; }
        __builtin_amdgcn_fence(__ATOMIC_ACQUIRE, "agent"); asm volatile("s_waitcnt vmcnt(0)" ::: "memory"); }
    __syncthreads();
}
__device__ __forceinline__ void phase_p0a(const Ctx& C, const Params& P) {
    LAS float* scr = (LAS float*)(C.lds + RING_OFF + C.wave * 16384);
    const int gw = C.bid * NWAVES + C.wave, NGW = C.G * NWAVES, lane = C.lane;
    const int gt = C.bid * 512 + C.tid, NGT = C.G * 512;
    { bf16* sc = WSP(bf16, WS_SC);
      for (int i = gt; i < 144 * 1024 / 4; i += NGT) { const int r = i >> 8, c4 = (i & 255) * 4;
          const float* src = (r < 16) ? P.in[8] + (size_t)r * 1024 : P.in[9] + (size_t)(r - 16) * 1024; const f32x4 v = *(const f32x4*)(src + c4);
          v2u o; o.x = pk2(v.x * sigmoidf_(v.x), v.y * sigmoidf_(v.y)); o.y = pk2(v.z * sigmoidf_(v.z), v.w * sigmoidf_(v.w));
          *(v2u*)(sc + (size_t)r * 1024 + c4) = o; }
      asm volatile("s_waitcnt vmcnt(0)" ::: "memory");
      __syncthreads();
      if (C.tid == 0) { __builtin_amdgcn_fence(__ATOMIC_RELEASE, "agent"); asm volatile("s_waitcnt vmcnt(0)" ::: "memory"); (void)xb_add((unsigned*)(P.ws + WS_CTL) + CW_SC, 1u); } }
    constexpr int I_IN = 16 * 45, I_UQ = 4 * 24, I_UKV = 2 * 32, I_O = 16 * 32, I_UP = 16 * 176, I_DN = 44 * 32, I_G = 32;
    constexpr int NITEMS = I_IN + I_UQ + I_UKV + I_O + I_UP + I_DN + I_G;
    for (int it = NGW - 1 - gw; it < NITEMS; it += NGW) {
        int r = it;
        if (r < I_UP) { p0_transpose_item<true>(P.in[33], UPC, WSP(bf16, WS_WUP), 1024, scr, 176, r, lane); continue; } r -= I_UP;
        if (r < I_DN) { p0_transpose_item(P.in[36], DM, WSP(bf16, WS_WDN), DFF, scr, 32, r, lane); continue; } r -= I_DN;
        if (r < I_IN) { p0_transpose_item(P.in[13], 1440, WSP(bf16, WS_WIN), 1024, scr, 45, r, lane); continue; } r -= I_IN;
        if (r < I_O) { p0_transpose_item(P.in[31], DM, WSP(bf16, WS_WO), 1024, scr, 32, r, lane); continue; } r -= I_O;
        if (r < I_UQ) { p0_transpose_item(P.in[22], 768, WSP(bf16, WS_WUQ), 256, scr, 24, r, lane); continue; } r -= I_UQ;
        if (r < I_UKV) { p0_transpose_item(P.in[27], 1024, WSP(bf16, WS_WUKV), 256, scr, 32, r, lane); continue; } r -= I_UKV;
        { const int hg = r >> 1, sub = r & 1, h = hg >> 1, gate = hg & 1;
          p0_transpose_item(P.in[gate ? 18 : 16] + (size_t)h * 4096, 64, WSP(bf16, WS_WG) + (size_t)(h * 2 + gate) * 4096, 64, scr, 2, sub, lane); }
    }
    const int gtr = NGT - 1 - gt;
    { bf16* w = WSP(bf16, WS_WIN) + (size_t)1440 * 1024; for (int i = gtr; i < 96 * 1024 / 8; i += NGT) ((v4u*)w)[i] = (v4u){0u, 0u, 0u, 0u}; }
    { bf16* w = WSP(bf16, WS_WUKV); for (int i = gtr; i < 1024 * 16; i += NGT) { const int n = i >> 4, c = i & 15; *(v4u*)(w + (size_t)n * 256 + 128 + c * 8) = (v4u){0u, 0u, 0u, 0u}; } }
    { float* rt = WSP(float, WS_ROPE);
      for (int i = gtr; i < 2049 * 16; i += NGT) { const int pi = i >> 4, k = i & 15; const float pos = (pi == 2048) ? 16384.0f : (float)pi;
          const float inv = powf(10000.0f, -(float)(2 * k) / 32.0f); const float ang = pos * inv; rt[2 * i] = cosf(ang); rt[2 * i + 1] = sinf(ang); } }
}

template <int NW, class Epi> __device__ __forceinline__ void skinny_gemm(const Ctx& C, const bf16* A, int lda, const bf16* Bt, int ldb, int MT, int NT, int K, const Epi& E) {
    const int gw = C.bid * NWAVES + C.wave, NGW = C.G * NWAVES, lane = C.lane;
    for (int wu = gw; wu < MT * NT; wu += NGW) {
        const int mt = wu % MT, nt = wu / MT;
        const bf16* ap = A + (size_t)(mt * 16 + (lane & 15)) * lda + 8 * (lane >> 4);
        const bf16* bp = Bt + (size_t)(nt * 16 * NW + (lane & 15)) * ldb + 8 * (lane >> 4);
        f32x4 acc[NW];
#pragma unroll
        for (int w = 0; w < NW; ++w) acc[w] = (f32x4){0.f, 0.f, 0.f, 0.f};
#pragma unroll 8
        for (int k = 0; k < K; k += 32) { const bf16x8 a = *(const bf16x8*)(ap + k);
#pragma unroll
            for (int w = 0; w < NW; ++w) { const bf16x8 b = *(const bf16x8*)(bp + (size_t)w * 16 * ldb + k); acc[w] = mfma16(a, b, acc[w]); } }
#pragma unroll
        for (int w = 0; w < NW; ++w) E(acc[w], mt, nt * NW + w, lane);
    }
}
template <class E, class = void> struct epi_rowstat { static constexpr bool value = false; };
template <class E> struct epi_rowstat<E, decltype((void)E::ROWSTAT)> { static constexpr bool value = E::ROWSTAT; };
template <int NW, class Epi> __device__ __forceinline__ void skinny_gemm_splitk(const Ctx& C, const bf16* A, int lda, const bf16* Bt, int ldb, int MT, int NTG, int K, const Epi& E) {
    const int lane = C.lane, w = C.wave, tid = C.tid, KW = K / 8;
    LAS float* part = (LAS float*)(C.lds + RING_OFF);
    for (int bu = C.bid; bu < MT * ((NTG + 7) & ~7); bu += C.G) {
        const int g8 = bu / (8 * MT), r8 = bu % (8 * MT), mt = r8 >> 3, ntg = g8 * 8 + (r8 & 7);
        if (ntg >= NTG) continue;
        const bf16* ap = A + (size_t)(mt * 16 + (lane & 15)) * lda + w * KW + 8 * (lane >> 4);
        const bf16* bp = Bt + (size_t)(ntg * 16 * NW + (lane & 15)) * ldb + w * KW + 8 * (lane >> 4);
        f32x4 acc[NW];
#pragma unroll
        for (int q = 0; q < NW; ++q) acc[q] = (f32x4){0.f, 0.f, 0.f, 0.f};
#pragma unroll 4
        for (int k = 0; k < KW; k += 32) { const bf16x8 a = *(const bf16x8*)(ap + k);
#pragma unroll
            for (int q = 0; q < NW; ++q) { const bf16x8 b = *(const bf16x8*)(bp + (size_t)q * 16 * ldb + k); acc[q] = mfma16(a, b, acc[q]); } }
#pragma unroll
        for (int q = 0; q < NW; ++q) *(LAS f32x4*)(part + ((w * NW + q) * 64 + lane) * 4) = acc[q];
        __syncthreads();
        if constexpr (epi_rowstat<Epi>::value) {
            LAS float* sq = part + 8 * NW * 256;
            for (int e = tid; e < 256 * NW; e += 512) { const int q = e >> 8, ln = (e >> 2) & 63, i = e & 3; float s = 0.f;
#pragma unroll
                for (int ww = 0; ww < 8; ++ww) s += part[((ww * NW + q) * 64 + ln) * 4 + i];
                const float v = E.elem(s, mt * 16 + 4 * (ln >> 4) + i, (ntg * NW + q) * 16 + (ln & 15)); sq[(4 * (ln >> 4) + i) * (16 * NW) + q * 16 + (ln & 15)] = v * v; }
            __syncthreads();
            if (tid < 16) { float s = 0.f; for (int k = 0; k < 16 * NW; ++k) s += sq[tid * (16 * NW) + k]; E.rowstat(mt * 16 + tid, s); }
        } else {
            for (int e = tid; e < 256 * NW; e += 512) { const int q = e >> 8, ln = (e >> 2) & 63, i = e & 3; float s = 0.f;
#pragma unroll
                for (int ww = 0; ww < 8; ++ww) s += part[((ww * NW + q) * 64 + ln) * 4 + i];
                E.elem(s, mt * 16 + 4 * (ln >> 4) + i, (ntg * NW + q) * 16 + (ln & 15)); }
        }
        __syncthreads();
    }
}
struct EpiSkBf16 { bf16* O; int ldc;
    __device__ __forceinline__ void elem(float v, int row, int col) const { O[(size_t)(MP + row) * ldc + col] = (bf16)f2bf(v); }
    __device__ __forceinline__ void operator()(const f32x4& acc, int mt, int nt, int lane) const {
#pragma unroll
        for (int i = 0; i < 4; ++i) O[(size_t)(MP + mt * 16 + 4 * (lane >> 4) + i) * ldc + nt * 16 + (lane & 15)] = (bf16)f2bf(acc[i]); } };
struct EpiSB { float* SB;
    __device__ __forceinline__ void elem(float v, int row, int col) const { if (row < 144) SB[(size_t)row * UPC + col] = v; } };
struct EpiSkUp { bf16* O; const float* rowss; const float* SB;
    __device__ __forceinline__ void elem(float v0, int row, int np) const { const float v = v0 * rsqrtf(rowss[MP + row] * (1.f / 1024.f) + EPS) + SB[(size_t)(16 + row) * UPC + np]; const int col = (np & 128) ? (DFF + 128 * (np >> 8) + (np & 127)) : (128 * (np >> 8) + (np & 127)); O[(size_t)(MP + row) * UPC + col] = (bf16)f2bf(v); }
    __device__ __forceinline__ void operator()(const f32x4& acc, int mt, int nt, int lane) const {
        const int np = nt * 16 + (lane & 15); const int col = (np & 128) ? (DFF + 128 * (np >> 8) + (np & 127)) : (128 * (np >> 8) + (np & 127));
#pragma unroll
        for (int i = 0; i < 4; ++i) O[(size_t)(MP + mt * 16 + 4 * (lane >> 4) + i) * UPC + col] = (bf16)f2bf(acc[i]); } };
template <bool BASE_BF16, bool OUT_BF16, bool XG> struct EpiSkResGate { const void* base; void* out; const float* mod; int goff; bf16* xg; const float* g2; float* rowss;
    __device__ __forceinline__ float elem(float a, int s, int c) const { const size_t o = (size_t)s * 1024 + c;
        const float bs = BASE_BF16 ? bf2f(((const bf16*)base)[o]) : ((const float*)base)[o];
        const float v = bs + mod[(size_t)(16 + s) * MODC + goff + c] * a;
        if (OUT_BF16) ((bf16*)out)[o] = (bf16)f2bf(v); else ((float*)out)[o] = v;
        if (XG) xg[o] = (bf16)f2bf(v * g2[c] * (1.0f + mod[(size_t)(16 + s) * MODC + 4096 + c]));
        return v; }
    static constexpr bool ROWSTAT = XG;
    __device__ __forceinline__ void rowstat(int s, float sumsq) const { __hip_atomic_fetch_add(rowss + s, sumsq, __ATOMIC_RELAXED, __HIP_MEMORY_SCOPE_AGENT); }
};

struct EpiMod { float* mod; const float* bias; bf16* sh2;
    __device__ __forceinline__ void elem(float v, int row, int col) const { if (row < 144) { const float o = v + bias[col]; mod[(size_t)row * MODC + col] = o; if (col >= 3072 && col < 4096) sh2[(size_t)row * 1024 + col - 3072] = (bf16)f2bf(o); } }
    __device__ __forceinline__ void operator()(const f32x4& acc, int mt, int nt, int lane) const {
        const int col = nt * 16 + (lane & 15); const float b = bias[col];
#pragma unroll
        for (int i = 0; i < 4; ++i) { const int row = mt * 16 + 4 * (lane >> 4) + i; if (row < 144) mod[(size_t)row * MODC + col] = acc[i] + b; }
    } };
__device__ __forceinline__ void phase_adaln_direct(const Ctx& C, const Params& P) {
    const int lane = C.lane, w = C.wave, tid = C.tid;
    if (C.bid >= MODC / 32) return;
    if (tid == 0) { unsigned* cnt = (unsigned*)(P.ws + WS_CTL) + CW_SC; unsigned sp = 0u;
        while (xb_ld(cnt) < (unsigned)C.G) { __builtin_amdgcn_s_sleep(1); if (++sp > (1u << 22)) break; }
        __builtin_amdgcn_fence(__ATOMIC_ACQUIRE, "agent"); asm volatile("s_waitcnt vmcnt(0)" ::: "memory"); }
    __syncthreads();
    const float* W = P.in[10]; const bf16* SC = WSP(const bf16, WS_SC);
    LAS float* part = (LAS float*)(C.lds + RING_OFF);
    EpiMod E{WSP(float, WS_MOD), P.in[11], WSP(bf16, WS_SH2)};
    for (int ng = C.bid; ng < MODC / 32; ng += C.G) {
        const int n0 = 32 * ng;
        f32x4 acc[9][2];
#pragma unroll
        for (int mt = 0; mt < 9; ++mt) { acc[mt][0] = (f32x4){0.f, 0.f, 0.f, 0.f}; acc[mt][1] = acc[mt][0]; }
        const float* wp = W + (size_t)(w * 128 + 8 * (lane >> 4)) * MODC + n0 + (lane & 15);
        const bf16* ap = SC + (size_t)(lane & 15) * 1024 + w * 128 + 8 * (lane >> 4);
        float braw[4][2][8];
#pragma unroll
        for (int ks = 0; ks < 4; ++ks)
#pragma unroll
            for (int q = 0; q < 2; ++q)
#pragma unroll
                for (int j = 0; j < 8; ++j) braw[ks][q][j] = __builtin_nontemporal_load(wp + (size_t)(32 * ks + j) * MODC + 16 * q);
#pragma unroll
        for (int ks = 0; ks < 4; ++ks) {
            bf16x8 b[2];
#pragma unroll
            for (int q = 0; q < 2; ++q) b[q] = pack8(braw[ks][q]);
#pragma unroll
            for (int mt = 0; mt < 9; ++mt) { const bf16x8 a = *(const bf16x8*)(ap + (size_t)mt * 16 * 1024 + 32 * ks);
                acc[mt][0] = mfma16(a, b[0], acc[mt][0]); acc[mt][1] = mfma16(a, b[1], acc[mt][1]); }
        }
#pragma unroll
        for (int q = 0; q < 2; ++q) {
#pragma unroll
            for (int mt = 0; mt < 9; ++mt) *(LAS f32x4*)(part + ((w * 9 + mt) * 64 + lane) * 4) = acc[mt][q];
            __syncthreads();
#pragma unroll
            for (int t = 0; t < 5; ++t) { const int e = tid + 512 * t;
                if (e < 9 * 256) { const int mt = e >> 8, ln = (e >> 2) & 63, i = e & 3; float sum = 0.f;
#pragma unroll
                    for (int ww = 0; ww < 8; ++ww) sum += part[((ww * 9 + mt) * 64 + ln) * 4 + i];
                    E.elem(sum, mt * 16 + 4 * (ln >> 4) + i, n0 + 16 * q + (ln & 15)); } }
            __syncthreads();
        }
    }
}

__device__ __forceinline__ const float* mod_row(const Params& P, int r) { return WSP(const float, WS_MOD) + (size_t)((r < MP) ? (r >> 11) : (16 + r - MP)) * MODC; }
template <bool SECOND> __device__ __forceinline__ void phase_norm_mod(const Ctx& C, const Params& P) {
    const int gw = C.bid * NWAVES + C.wave, NGW = C.G * NWAVES, lane = C.lane;
    const float* g = P.in[SECOND ? 32 : 12]; bf16* H = WSP(bf16, WS_H1);
    constexpr int SH = SECOND ? 3072 : 0, SC = SECOND ? 4096 : 1024;
    for (int r0 = gw; r0 < MR; r0 += 2 * NGW) {
        f32x4 v[2][4]; int rr[2];
#pragma unroll
        for (int u = 0; u < 2; ++u) { const int r = (r0 + u * NGW < MR) ? r0 + u * NGW : r0; rr[u] = r;
            if (r < MREAL) {
                if (SECOND) { const bf16* xb = WSP(const bf16, WS_X1) + (size_t)r * 1024;
#pragma unroll
                    for (int j = 0; j < 4; ++j) { const v2u w = *((const v2u*)xb + lane + 64 * j); v[u][j] = (f32x4){bflo(w.x), bfhi(w.x), bflo(w.y), bfhi(w.y)}; } }
                else { const float* xr = (r < MP) ? P.in[0] + (size_t)r * 1024 : P.in[1] + (size_t)(r - MP) * 1024;
#pragma unroll
                    for (int j = 0; j < 4; ++j) v[u][j] = *((const f32x4*)xr + lane + 64 * j); } }
            else {
#pragma unroll
                for (int j = 0; j < 4; ++j) v[u][j] = (f32x4){0.f, 0.f, 0.f, 0.f}; } }
#pragma unroll
        for (int u = 0; u < 2; ++u) { const int r = rr[u];
            GAS unsigned long long* o8 = (GAS unsigned long long*)(H + (size_t)r * 1024) + lane;
            if (r >= MREAL) {
#pragma unroll
                for (int j = 0; j < 4; ++j) o8[64 * j] = 0ull;
                continue; }
            const float* md = mod_row(P, r);
            float s = 0.f;
#pragma unroll
            for (int j = 0; j < 4; ++j) s += (v[u][j].x * v[u][j].x + v[u][j].y * v[u][j].y) + (v[u][j].z * v[u][j].z + v[u][j].w * v[u][j].w);
            const float rstd = rsqrtf(wave_sum(s) * (1.f / 1024.f) + EPS);
#pragma unroll
            for (int j = 0; j < 4; ++j) { const int c = 4 * (lane + 64 * j);
                const f32x4 gg = *(const f32x4*)(g + c), sc = *(const f32x4*)(md + SC + c), sh = *(const f32x4*)(md + SH + c);
                const f32x4 h = v[u][j] * rstd * gg * (sc + 1.0f) + sh;
                o8[64 * j] = (unsigned long long)pk2(h.x, h.y) | ((unsigned long long)pk2(h.z, h.w) << 32); }
        }
    }
}

__device__ __forceinline__ void phase_p3a(const Ctx& C, const Params& P) {
    const int gw = C.bid * NWAVES + C.wave, NGW = C.G * NWAVES, lane = C.lane;
    const bf16* Z = WSP(const bf16, WS_Z); bf16* QN = WSP(bf16, WS_QN); bf16* KVN = WSP(bf16, WS_KVN); bf16* KR = WSP(bf16, WS_KR);
    const float* rope = WSP(const float, WS_ROPE);
    const f32x4 gq = *(const f32x4*)(P.in[21] + 4 * lane); const f32x2 gkv = *(const f32x2*)(P.in[25] + 2 * lane); const float gkr = P.in[26][lane & 31];
    for (int r0 = gw; r0 < MREAL; r0 += 4 * NGW) {
        v2u wq[4]; unsigned wk[4]; unsigned short wr[4]; v4u wx[4]; int rr[4];
#pragma unroll
        for (int u = 0; u < 4; ++u) { const int r = (r0 + u * NGW < MREAL) ? r0 + u * NGW : r0; rr[u] = r; const bf16* z = Z + (size_t)r * ZC;
            wq[u] = *(const v2u*)(z + 1024 + 4 * lane); wk[u] = *(const unsigned*)(z + 1280 + 2 * lane); wr[u] = z[1408 + (lane & 31)];
            wx[u] = (v4u){0u, 0u, 0u, 0u}; if (r >= MP || (r & 2047) >= 2045) wx[u] = *(const v4u*)(z + 8 * lane); }
#pragma unroll
        for (int u = 0; u < 4; ++u) { const int r = rr[u];
            const bool smp = r >= MP; const int s_ = r - MP, b = r >> 11, t = r & 2047;
            { const float a0 = bflo(wq[u].x), a1 = bfhi(wq[u].x), a2 = bflo(wq[u].y), a3 = bfhi(wq[u].y);
              const float rstd = rsqrtf(wave_sum(a0 * a0 + a1 * a1 + a2 * a2 + a3 * a3) * (1.f / 256.f) + EPS);
              v2u o; o.x = pk2(a0 * rstd * gq.x, a1 * rstd * gq.y); o.y = pk2(a2 * rstd * gq.z, a3 * rstd * gq.w); *(v2u*)(QN + (size_t)r * 256 + 4 * lane) = o; }
            { const float a0 = bflo(wk[u]), a1 = bfhi(wk[u]);
              const float rstd = rsqrtf(wave_sum(a0 * a0 + a1 * a1) * (1.f / 128.f) + EPS);
              const float o0 = a0 * rstd * gkv.x, o1 = a1 * rstd * gkv.y;
              float* dst = P.out + (smp ? O_KVS + (size_t)s_ * 128 : O_KVP + (size_t)r * 128); *(f32x2*)(dst + 2 * lane) = (f32x2){o0, o1};
              *(unsigned*)(KVN + (size_t)r * 256 + 2 * lane) = pk2(o0, o1); *(unsigned*)(KVN + (size_t)r * 256 + 128 + 2 * lane) = 0u; }
            { const float a = (lane < 32) ? bf2f(wr[u]) : 0.f; const float rstd = rsqrtf(wave_sum(a * a) * (1.f / 32.f) + EPS);
              const float v = a * rstd * gkr; const float pr = lane_xor16(v, lane);
              const f32x2 cs = *(const f32x2*)(rope + ((size_t)(smp ? 2048 : t) * 16 + (lane & 15)) * 2);
              const float o = (lane & 16) ? (v * cs.x + pr * cs.y) : (v * cs.x - pr * cs.y);
              if (lane < 32) { float* dst = P.out + (smp ? O_KRS + (size_t)s_ * 32 : O_KRP + (size_t)r * 32); dst[lane] = o; KR[(size_t)r * 32 + lane] = (bf16)f2bf(o); } }
            const v4u w = wx[u];
            if (smp) { float* d2 = P.out + O_LCS + (size_t)s_ * 1536; const float* st = P.in[5] + (size_t)s_ * 1536;
                *(f32x4*)(d2 + 8 * lane) = *(const f32x4*)(st + 512 + 8 * lane); *(f32x4*)(d2 + 8 * lane + 4) = *(const f32x4*)(st + 512 + 8 * lane + 4);
                *(f32x4*)(d2 + 512 + 8 * lane) = *(const f32x4*)(st + 1024 + 8 * lane); *(f32x4*)(d2 + 512 + 8 * lane + 4) = *(const f32x4*)(st + 1024 + 8 * lane + 4);
                *(f32x4*)(d2 + 1024 + 8 * lane) = (f32x4){bflo(w.x), bfhi(w.x), bflo(w.y), bfhi(w.y)}; *(f32x4*)(d2 + 1024 + 8 * lane + 4) = (f32x4){bflo(w.z), bfhi(w.z), bflo(w.w), bfhi(w.w)}; }
            else if (t >= 2045) { float* d2 = P.out + O_LCP + ((size_t)b * 3 + (t - 2045)) * 512;
                *(f32x4*)(d2 + 8 * lane) = (f32x4){bflo(w.x), bfhi(w.x), bflo(w.y), bfhi(w.y)}; *(f32x4*)(d2 + 8 * lane + 4) = (f32x4){bflo(w.z), bfhi(w.z), bflo(w.w), bfhi(w.w)}; }
        }
    }
}

template <bool SMP> __device__ __forceinline__ void phase_p3b(const Ctx& C, const Params& P) {
    LAS float* L = (LAS float*)(C.lds + RING_OFF);
    for (int i = C.tid; i < 2048; i += 512) L[i] = P.in[14][i];
    { const int i = C.tid; L[2048 + i] = P.in[15][i]; L[2560 + i] = P.in[17][i]; L[3072 + i] = P.in[19][i];
      const float nl = -P.in[20][i]; L[3584 + i] = fmaxf(nl, 0.f) + log1pf(__expf(-fabsf(nl))); }
    __syncthreads();
    const int lane0 = C.lane, h = C.wave;
    const bf16* Z = WSP(const bf16, WS_Z); bf16* HL = WSP(bf16, WS_HL); bf16* AC = WSP(bf16, WS_AC); float* SUM = WSP(float, WS_SUM);
    const bf16* WG = WSP(const bf16, WS_WG);
    bf16x8 idf[2];
#pragma unroll
    for (int s2 = 0; s2 < 2; ++s2) { bf16x8 f;
#pragma unroll
        for (int j = 0; j < 8; ++j) f[j] = (16 * s2 + 8 * (lane0 >> 5) + j == (lane0 & 31)) ? (short)0x3F80 : (short)0;
        idf[s2] = f; }
    const int NIT = SMP ? 4 : NBATCH * 32;
    for (int it0 = C.bid; it0 < NIT; it0 += C.G) {
        constexpr bool smp = SMP; const int it = SMP ? it0 + NBATCH * 32 : it0;
        int lane = lane0; asm volatile("" : "+v"(lane));
        const int tk = lane & 31, hh = lane >> 5;
        const int b = it >> 5, chunk = it & 31;
        float carP[2] = {1.f, 1.f}, carS[2] = {0.f, 0.f};
#pragma unroll 1
        for (int sub = 0; sub < (smp ? 1 : 2); ++sub) {
            const int t0 = smp ? 0 : chunk * 64 + sub * 32;
            const int sq = (it - NBATCH * 32) * 32;
            const size_t rowA = smp ? (size_t)(MP + sq + tk) : (size_t)b * SEQ + t0 + tk;
            bf16x8 af[4];
            int hhc = hh; asm volatile("" : "+v"(hhc));
            v4u zn[4];
#define P3B_LOADZ(s_) do { const int chn_ = 64 * h + 16 * (s_) + 8 * hhc; _Pragma("unroll") for (int tap = 0; tap < 4; ++tap) { const int tt = t0 + tk - 3 + tap; zn[tap] = (v4u){0u, 0u, 0u, 0u}; \
                if (!(smp && tap < 3) && (smp || tt >= 0)) zn[tap] = *(const v4u*)(Z + (rowA - 3 + tap) * ZC + chn_); } } while (0)
            P3B_LOADZ(0);
#pragma unroll
            for (int s = 0; s < 4; ++s) {
                const int ch0 = 64 * h + 16 * s + 8 * hhc;
                v4u zc[4];
#pragma unroll
                for (int tap = 0; tap < 4; ++tap) zc[tap] = zn[tap];
                if (s < 3) P3B_LOADZ(s + 1);
                float xc[8];
#pragma unroll
                for (int j = 0; j < 8; ++j) xc[j] = L[2048 + ch0 + j];
#pragma unroll
                for (int tap = 0; tap < 4; ++tap) {
                    float xv[8];
                    if (smp && tap < 3) { const float* st = P.in[5] + ((size_t)(sq + tk) * 3 + tap) * 512 + ch0; const f32x4 a = *(const f32x4*)st, bq = *(const f32x4*)(st + 4);
                        xv[0] = a.x; xv[1] = a.y; xv[2] = a.z; xv[3] = a.w; xv[4] = bq.x; xv[5] = bq.y; xv[6] = bq.z; xv[7] = bq.w; }
                    else unpack8f(zc[tap], xv);
#pragma unroll
                    for (int j = 0; j < 8; ++j) xc[j] += L[tap * 512 + ch0 + j] * xv[j];
                }
                af[s] = pack8(xc);
                asm volatile("" ::: "memory"); __builtin_amdgcn_sched_barrier(0);
            }
#undef P3B_LOADZ
#pragma unroll 1
            for (int cb = 0; cb < 2; ++cb) {
                f32x16 ra = {}, ia = {}, xq = {};
                { unsigned woff = (unsigned)(((h * 2) * 64 + 32 * cb + tk) * 64 + 8 * hh); asm volatile("" : "+v"(woff));
                  const bf16* wp = WG + woff;
#pragma unroll
                  for (int s = 0; s < 4; ++s) { const bf16x8 wa = *(const bf16x8*)(wp + 16 * s), wx = *(const bf16x8*)(wp + 4096 + 16 * s); ra = mfma32(af[s], wa, ra); ia = mfma32(af[s], wx, ia); } }
                { const bf16x8 afa = cb ? af[2] : af[0], afb = cb ? af[3] : af[1]; xq = mfma32(afa, idf[0], xq); xq = mfma32(afb, idf[1], xq); }
                const int ch = 64 * h + 32 * cb + tk;
                const float spc = L[3584 + ch], bac = L[2560 + ch], bxc = L[3072 + ch];
                float av[16], hv[16];
#pragma unroll
                for (int rr = 0; rr < 16; ++rr) {
                    const float rg = sigmoidf_(ra[rr] + bac), ig = sigmoidf_(ia[rr] + bxc);
                    const float la = -8.0f * spc * rg; const float a = __builtin_amdgcn_exp2f(1.4426950408889634f * la);
                    const float x2 = 2.0f * la;
                    const float ser = -x2 * (1.0f + x2 * (0.5f + x2 * (0.16666667f + x2 * (0.041666668f + x2 * (0.008333334f + x2 * 0.0013888889f)))));
                    float mult = __builtin_amdgcn_sqrtf(x2 > -0.25f ? ser : 1.0f - a * a);
                    if (!smp && (t0 + crow(rr, hh)) == 0) mult = 1.0f;
                    av[rr] = a; hv[rr] = mult * ig * xq[rr];
                    if ((rr & 3) == 3) __builtin_amdgcn_sched_barrier(0);
                }
                if (smp) {
#pragma unroll
                    for (int rr = 0; rr < 16; ++rr) { const int sI = sq + crow(rr, hh); const float h0 = P.in[4][(size_t)sI * 512 + ch];
                        const float hn = av[rr] * h0 + hv[rr]; P.out[O_LHS + (size_t)sI * 512 + ch] = hn;
                        HL[(size_t)(MP + sI) * 512 + ch] = (bf16)f2bf(hn); AC[(size_t)(MP + sI) * 512 + ch] = (bf16)0; }
                } else {
#pragma unroll
                    for (int gi = 0; gi < 4; ++gi)
#pragma unroll
                        for (int j = 1; j < 4; ++j) { hv[4 * gi + j] = av[4 * gi + j] * hv[4 * gi + j - 1] + hv[4 * gi + j]; av[4 * gi + j] = av[4 * gi + j] * av[4 * gi + j - 1]; }
                    float Pc = cb ? carP[1] : carP[0], Sc = cb ? carS[1] : carS[0];
#pragma unroll
                    for (int gi = 0; gi < 4; ++gi) {
                        const float oA = av[4 * gi + 3], oH = hv[4 * gi + 3];
                        const float pA = lane_xor32(oA, lane), pH = lane_xor32(oH, lane);
                        const float loA = hh ? pA : oA, loH = hh ? pH : oH, hiA = hh ? oA : pA, hiH = hh ? oH : pH;
                        const float S1 = loH + loA * Sc, P1 = loA * Pc;
                        const float Sin = hh ? S1 : Sc, Pin = hh ? P1 : Pc;
#pragma unroll
                        for (int j = 0; j < 4; ++j) { const int rr = 4 * gi + j; hv[rr] = hv[rr] + av[rr] * Sin; av[rr] = av[rr] * Pin; }
                        Sc = hiH + hiA * S1; Pc = hiA * P1;
                    }
                    if (cb) { carP[1] = Pc; carS[1] = Sc; } else { carP[0] = Pc; carS[0] = Sc; }
                    { const unsigned ob = (unsigned)(((b * SEQ + t0 + 4 * hh) * 512 + ch) * 2);
#pragma unroll
                      for (int rr = 0; rr < 16; ++rr) { const unsigned o2 = ob + (unsigned)(((rr & 3) + 8 * (rr >> 2)) * 1024);
                          const unsigned w2 = pk2(hv[rr], av[rr]); *(bf16*)((char*)HL + o2) = (bf16)w2; *(bf16*)((char*)AC + o2) = (bf16)(w2 >> 16); } }
                }
            }
        }
        if (!smp) { int lq = lane; asm volatile("" : "+v"(lq));
            if (lq < 32) {
#pragma unroll
                for (int cb = 0; cb < 2; ++cb) { const int ch = 64 * h + 32 * cb + lq; *(f32x2*)(SUM + (((size_t)b * 32 + chunk) * 512 + ch) * 2) = (f32x2){carP[cb], carS[cb]}; } }
        }
    }
    __syncthreads();
}

__device__ __forceinline__ float g8_sum(float v) { v += DPPF0(v, 0xB1); v += DPPF0(v, 0x4E); v += DPPF0(v, 0x141); return v; }
__device__ __forceinline__ void phase_p5(const Ctx& C, const Params& P) {
    const int gw = C.bid * NWAVES + C.wave, NGW = C.G * NWAVES, lane = C.lane, hd = lane >> 3, sub = lane & 7;
    const bf16* QRAW = WSP(const bf16, WS_QRAW); const bf16* KVRAW = WSP(const bf16, WS_KVRAW); const bf16* KR = WSP(const bf16, WS_KR);
    bf16* Q = WSP(bf16, WS_Q); bf16* KF = WSP(bf16, WS_KF);
    const float* rope = WSP(const float, WS_ROPE);
    float gkn[8];
#pragma unroll
    for (int j = 0; j < 8; ++j) gkn[j] = P.in[28][8 * sub + j];
    for (int r0 = gw; r0 < MREAL; r0 += 4 * NGW) {
        v4u wkn[4]; v2u wkr[4]; int rr[4];
#pragma unroll
        for (int u = 0; u < 4; ++u) { const int r = (r0 + u * NGW < MREAL) ? r0 + u * NGW : r0; rr[u] = r;
            wkn[u] = *(const v4u*)(KVRAW + (size_t)r * 1024 + hd * 128 + 8 * sub); wkr[u] = *(const v2u*)(KR + (size_t)r * 32 + 4 * sub); }
#pragma unroll
        for (int u = 0; u < 4; ++u) { const int r = rr[u];
            float v[8]; unpack8f(wkn[u], v); float ss = 0.f;
#pragma unroll
            for (int j = 0; j < 8; ++j) ss += v[j] * v[j];
            const float rstd = rsqrtf(g8_sum(ss) * (1.f / 64.f) + EPS);
#pragma unroll
            for (int j = 0; j < 8; ++j) v[j] = v[j] * rstd * gkn[j];
            *(bf16x8*)(KF + (size_t)r * 768 + hd * 96 + 8 * sub) = pack8(v);
            *(v2u*)(KF + (size_t)r * 768 + hd * 96 + 64 + 4 * sub) = wkr[u];
        }
    }
    for (int r = MP + gw; r < MREAL; r += NGW) {
        const bf16* q = QRAW + (size_t)r * 768 + hd * 96;
        float v[8]; unpack8f(*(const v4u*)(q + 8 * sub), v); float ss = 0.f;
#pragma unroll
        for (int j = 0; j < 8; ++j) ss += v[j] * v[j];
        const float rstd = rsqrtf(g8_sum(ss) * (1.f / 64.f) + EPS) * C2;
#pragma unroll
        for (int j = 0; j < 8; ++j) v[j] = v[j] * rstd * P.in[23][8 * sub + j];
        *(bf16x8*)(Q + (size_t)r * 768 + hd * 96 + 8 * sub) = pack8(v);
        const v2u wq = *(const v2u*)(q + 64 + 4 * sub); float x[4] = {bflo(wq.x), bfhi(wq.x), bflo(wq.y), bfhi(wq.y)};
        const float rs2 = rsqrtf(g8_sum(x[0] * x[0] + x[1] * x[1] + x[2] * x[2] + x[3] * x[3]) * (1.f / 32.f) + EPS);
        float o[4];
#pragma unroll
        for (int j = 0; j < 4; ++j) { const float me = x[j] * rs2 * P.in[24][4 * sub + j]; const float pr = __shfl_xor(me, 4);
            const f32x2 cs = *(const f32x2*)(rope + ((size_t)2048 * 16 + 4 * (sub & 3) + j) * 2);
            o[j] = ((sub & 4) ? (me * cs.x + pr * cs.y) : (me * cs.x - pr * cs.y)) * C2; }
        v2u ow; ow.x = pk2(o[0], o[1]); ow.y = pk2(o[2], o[3]); *(v2u*)(Q + (size_t)r * 768 + hd * 96 + 64 + 4 * sub) = ow;
    }
}

__device__ __forceinline__ void phase_carry(const Ctx& C, const Params& P) {
    const float* SUM = WSP(const float, WS_SUM); float* CAR = WSP(float, WS_CARRY);
    const int t = C.tid; if (t >= 32) return;
    for (int idx = C.bid * 32 + t; idx < NBATCH * 512; idx += C.G * 32) {
        const int b = idx >> 9, ch = idx & 511; f32x2 ps[32];
#pragma unroll
        for (int k = 0; k < 32; ++k) ps[k] = *(const f32x2*)(SUM + (((size_t)b * 32 + k) * 512 + ch) * 2);
        float H = 0.f;
#pragma unroll
        for (int k = 0; k < 32; ++k) { CAR[((size_t)b * 32 + k) * 512 + ch] = H; H = ps[k].x * H + ps[k].y; }
        P.out[O_LHP + idx] = H;
    }
}

constexpr int KT_PITCH = 208, VT_PITCH = 192;
constexpr int KT_BYTES = 64 * KT_PITCH, VT_BYTES = 64 * VT_PITCH, ATT_BUF = KT_BYTES + VT_BYTES;
__device__ __forceinline__ s16x4 tr_read(unsigned addr) { s16x4 r; asm volatile("ds_read_b64_tr_b16 %0, %1\n\ts_waitcnt lgkmcnt(0)" : "=&v"(r) : "v"(addr) : "memory"); return r; }
__device__ __forceinline__ void attn_unit(const Ctx& C, const Params& P, int bh, int qb) {
    const int lane = C.lane, wid = C.wave, tid = C.tid, r32 = lane & 31, hh = lane >> 5;
    const int b = bh >> 3, h = bh & 7;
    const bf16* QRAW = WSP(const bf16, WS_QRAW); const bf16* KF = WSP(const bf16, WS_KF); const bf16* KVRAW = WSP(const bf16, WS_KVRAW); bf16* ATT = WSP(bf16, WS_ATT);
    const size_t rowbase = (size_t)b * SEQ; const int q0 = qb * 256 + wid * 32;
    const unsigned lds0 = (unsigned)(uintptr_t)(C.lds + RING_OFF);
    bf16x8 qf[6];
    { float qv[6][8];
#pragma unroll
      for (int s = 0; s < 6; ++s) { const v4u w = *(const v4u*)(QRAW + (rowbase + q0 + r32) * 768 + h * 96 + 16 * s + 8 * hh); unpack8f(w, qv[s]); }
      float sn = 0.f, sr = 0.f;
#pragma unroll
      for (int j = 0; j < 8; ++j) { sn += qv[0][j] * qv[0][j] + qv[1][j] * qv[1][j] + qv[2][j] * qv[2][j] + qv[3][j] * qv[3][j]; sr += qv[4][j] * qv[4][j] + qv[5][j] * qv[5][j]; }
      const float rn = rsqrtf(xhalf_sum(sn) * (1.f / 64.f) + EPS) * C2, rr = rsqrtf(xhalf_sum(sr) * (1.f / 32.f) + EPS);
      const float* gqn = P.in[23]; const float* gqr = P.in[24]; const float* rope = WSP(const float, WS_ROPE) + (size_t)(q0 + r32) * 32;
#pragma unroll
      for (int s = 0; s < 4; ++s) {
#pragma unroll
          for (int j = 0; j < 8; ++j) qv[s][j] *= rn * gqn[16 * s + 8 * hh + j];
          qf[s] = pack8(qv[s]); }
#pragma unroll
      for (int j = 0; j < 8; ++j) { const int i = 8 * hh + j; const float x1 = qv[4][j] * rr * gqr[i], x2 = qv[5][j] * rr * gqr[16 + i]; const f32x2 cs = *(const f32x2*)(rope + 2 * i);
          qv[4][j] = (x1 * cs.x - x2 * cs.y) * C2; qv[5][j] = (x2 * cs.x + x1 * cs.y) * C2; }
      qf[4] = pack8(qv[4]); qf[5] = pack8(qv[5]); }
    const int NT = 4 * (qb + 1);
    const int kc0 = tid, kr0 = kc0 / 12, kk0 = kc0 % 12, kc1 = 512 + tid, kr1 = kc1 / 12, kk1 = kc1 % 12; const bool k2 = tid < 256;
    const int vr = tid >> 3, vk = tid & 7;
    const bf16* kg0 = KF + (rowbase + kr0) * 768 + h * 96 + kk0 * 8; const bf16* kg1 = KF + (rowbase + kr1) * 768 + h * 96 + kk1 * 8;
    const bf16* vg = KVRAW + (rowbase + vr) * 1024 + h * 128 + 64 + vk * 8;
    v4u sk0, sk1 = (v4u){0u, 0u, 0u, 0u}, sv;
    sk0 = *(const v4u*)kg0; if (k2) sk1 = *(const v4u*)kg1; sv = *(const v4u*)vg;
    { LAS unsigned char* bufp = C.lds + RING_OFF; *(LAS v4u*)(bufp + kr0 * KT_PITCH + kk0 * 16) = sk0; if (k2) *(LAS v4u*)(bufp + kr1 * KT_PITCH + kk1 * 16) = sk1; *(LAS v4u*)(bufp + KT_BYTES + vr * VT_PITCH + vk * 16) = sv; }
    __syncthreads();
    float m_run = -INFINITY, l_run = 0.f; f32x16 o[2]; o[0] = f32x16{}; o[1] = f32x16{};
    for (int t = 0; t < NT; ++t) {
        const int cur = t & 1; const bool more = (t + 1 < NT);
        if (more) { const size_t adv = (size_t)(t + 1) * 64; sk0 = *(const v4u*)(kg0 + adv * 768); if (k2) sk1 = *(const v4u*)(kg1 + adv * 768); sv = *(const v4u*)(vg + adv * 1024); }
        LAS unsigned char* Kb = C.lds + RING_OFF + cur * ATT_BUF; const unsigned Vb = lds0 + cur * ATT_BUF + KT_BYTES;
        if (64 * t <= q0 + 31) {
        f32x16 p[2];
#pragma unroll
        for (int kh = 0; kh < 2; ++kh) { f32x16 acc = f32x16{};
#pragma unroll
            for (int s = 0; s < 6; ++s) { const bf16x8 kf = *(const LAS bf16x8*)(Kb + (32 * kh + r32) * KT_PITCH + (16 * s + 8 * hh) * 2); acc = mfma32(kf, qf[s], acc); }
            p[kh] = acc; }
        s16x4 vl[2][2][2], vh[2][2][2];
        { const int i16 = lane & 15, q4 = i16 >> 2, p4 = i16 & 3, blk = (lane >> 4) & 1;
          const unsigned a0 = Vb + (4 * hh + q4) * VT_PITCH + (16 * blk + 4 * p4) * 2;
#define TRV(kh, s2) asm volatile("ds_read_b64_tr_b16 %0, %4 offset:%5\n\tds_read_b64_tr_b16 %1, %4 offset:%6\n\tds_read_b64_tr_b16 %2, %4 offset:%7\n\tds_read_b64_tr_b16 %3, %4 offset:%8" \
              : "=&v"(vl[kh][s2][0]), "=&v"(vh[kh][s2][0]), "=&v"(vl[kh][s2][1]), "=&v"(vh[kh][s2][1]) : "v"(a0), "i"((32 * kh + 16 * s2) * VT_PITCH), "i"((32 * kh + 16 * s2 + 8) * VT_PITCH), \
                "i"((32 * kh + 16 * s2) * VT_PITCH + 64), "i"((32 * kh + 16 * s2 + 8) * VT_PITCH + 64) : "memory")
          TRV(0, 0); TRV(0, 1); TRV(1, 0); TRV(1, 1);
#undef TRV
        }
        if (64 * t + 63 > q0) { const int qq = q0 + r32;
#pragma unroll
            for (int kh = 0; kh < 2; ++kh)
#pragma unroll
                for (int r = 0; r < 16; ++r) if (64 * t + 32 * kh + crow(r, hh) > qq) p[kh][r] = -INFINITY; }
        float mx = p[0][0];
#pragma unroll
        for (int r = 1; r < 16; ++r) mx = fmaxf(mx, p[0][r]);
#pragma unroll
        for (int r = 0; r < 16; ++r) mx = fmaxf(mx, p[1][r]);
        { auto rr = __builtin_amdgcn_permlane32_swap(__float_as_uint(mx), __float_as_uint(mx), false, false); mx = fmaxf(__uint_as_float(rr[0]), __uint_as_float(rr[1])); }
        const float m_new = fmaxf(m_run, mx); const float alpha = __builtin_amdgcn_exp2f(m_run - m_new); m_run = m_new;
        float ps = 0.f;
#pragma unroll
        for (int kh = 0; kh < 2; ++kh)
#pragma unroll
            for (int r = 0; r < 16; ++r) { const float e = __builtin_amdgcn_exp2f(p[kh][r] - m_new); p[kh][r] = e; ps += e; }
        l_run = l_run * alpha + ps;
#pragma unroll
        for (int dt = 0; dt < 2; ++dt)
#pragma unroll
            for (int r = 0; r < 16; ++r) o[dt][r] *= alpha;
        asm volatile("s_waitcnt lgkmcnt(0)" : "+v"(vl[0][0][0]), "+v"(vh[0][0][0]), "+v"(vl[0][0][1]), "+v"(vh[0][0][1]), "+v"(vl[0][1][0]), "+v"(vh[0][1][0]), "+v"(vl[0][1][1]), "+v"(vh[0][1][1]),
                     "+v"(vl[1][0][0]), "+v"(vh[1][0][0]), "+v"(vl[1][0][1]), "+v"(vh[1][0][1]), "+v"(vl[1][1][0]), "+v"(vh[1][1][0]), "+v"(vl[1][1][1]), "+v"(vh[1][1][1]) :: "memory");
#pragma unroll
        for (int kh = 0; kh < 2; ++kh)
#pragma unroll
            for (int s2 = 0; s2 < 2; ++s2) {
                float pv[8];
#pragma unroll
                for (int j = 0; j < 8; ++j) pv[j] = p[kh][8 * s2 + j];
                const bf16x8 pf = pack8(pv);
                o[0] = mfma32(__builtin_shufflevector(vl[kh][s2][0], vh[kh][s2][0], 0, 1, 2, 3, 4, 5, 6, 7), pf, o[0]);
                o[1] = mfma32(__builtin_shufflevector(vl[kh][s2][1], vh[kh][s2][1], 0, 1, 2, 3, 4, 5, 6, 7), pf, o[1]);
            }
        }
        if (more) { LAS unsigned char* nb = C.lds + RING_OFF + (cur ^ 1) * ATT_BUF;
            *(LAS v4u*)(nb + kr0 * KT_PITCH + kk0 * 16) = sk0; if (k2) *(LAS v4u*)(nb + kr1 * KT_PITCH + kk1 * 16) = sk1; *(LAS v4u*)(nb + KT_BYTES + vr * VT_PITCH + vk * 16) = sv; }
        __syncthreads();
    }
    const float linv = 1.0f / xhalf_sum(l_run);
    bf16* orow = ATT + (rowbase + q0 + r32) * 512 + h * 64;
#pragma unroll
    for (int dt = 0; dt < 2; ++dt)
#pragma unroll
        for (int g = 0; g < 4; ++g) { v2u w; w.x = pk2(o[dt][4 * g] * linv, o[dt][4 * g + 1] * linv); w.y = pk2(o[dt][4 * g + 2] * linv, o[dt][4 * g + 3] * linv);
            *(v2u*)(orow + 32 * dt + 8 * g + 4 * hh) = w; }
}
__device__ __forceinline__ void phase_attn_prompt(const Ctx& C, const Params& P) {
    for (int pi = C.bid; pi < 512; pi += C.G) {
        const int bh = pi >> 2, pr = pi & 3;
        attn_unit(C, P, bh, 7 - pr);
        attn_unit(C, P, bh, pr);
    }
}

constexpr int LK_PITCH = 272, LT_PITCH = 272, LKR_PITCH = 80;
constexpr int SA_LK = 0, SA_LT = 128 * LK_PITCH, SA_LT_BUF = 128 * LT_PITCH, SA_KR = SA_LT + 2 * SA_LT_BUF, SA_P = SA_KR + 128 * LKR_PITCH, SA_P_BUF = 8 * 256, SA_AL = SA_P + 2 * SA_P_BUF, SA_QG = SA_AL + 2 * 32, SA_END = SA_QG + 8 * 256;
static_assert(SA_END <= RING_BYTES, "sample attention LDS");
constexpr int PART_STRIDE = 8 * 132;
__device__ __forceinline__ float xhalf_sum_pl(float v) { auto rr = __builtin_amdgcn_permlane32_swap(__float_as_uint(v), __float_as_uint(v), false, false); return __uint_as_float(rr[0]) + __uint_as_float(rr[1]); }
__device__ __forceinline__ void phase_attn_sample(const Ctx& C, const Params& P) {
    const int lane = C.lane, h = C.wave, tid = C.tid, r32 = lane & 31, hh = lane >> 5;
    const bf16* WUKV = WSP(const bf16, WS_WUKV); const bf16* Q = WSP(const bf16, WS_Q); float* PART = WSP(float, WS_PART);
    const float* cache_lat = P.in[2]; const float* cache_kr = P.in[3]; const int* ptab = (const int*)P.in[7]; const float* gkn = P.in[28];
    LAS unsigned char* S = C.lds + RING_OFF;
    bf16x8 wk[2][8];
#pragma unroll
    for (int rt = 0; rt < 2; ++rt)
#pragma unroll
        for (int s = 0; s < 8; ++s) wk[rt][s] = *(const bf16x8*)(WUKV + (size_t)(h * 128 + 32 * rt + r32) * 256 + 16 * s + 8 * hh);
    const int kg = tid >> 5, dq = tid & 31;
    for (int u = C.bid; u < 256; u += C.G) {
        const int sq = u >> 1, half = u & 1; const size_t qrow = (size_t)(MP + sq);
        { const int l2 = fresh_lane(); *(LAS float*)(S + SA_QG + h * 256 + l2 * 4) = bf2f(Q[qrow * 768 + h * 96 + l2]) * gkn[l2]; }
        bf16x8 qv[2];
        { const bf16x8 qfr = *(const bf16x8*)(Q + qrow * 768 + h * 96 + 64 + 8 * (lane >> 4));
          qv[0] = ((lane & 7) == 0) ? qfr : bf16x8{}; qv[1] = ((lane & 7) == 4) ? qfr : bf16x8{}; }
        float m_run = -INFINITY, l_run = 0.f; f32x4 ctx = (f32x4){0.f, 0.f, 0.f, 0.f};
        f32x4 pl[8]; f32x4 pk[2];
        const int pgs = ptab[sq * NPAGES + half * 64 + lane];
#define SA_PREFETCH(pgidx) do { const int pg_ = __builtin_amdgcn_readlane(pgs, (pgidx)); \
          const char* lb_ = (const char*)(cache_lat + (size_t)pg_ * (PAGE * KVLR)); const char* kb_ = (const char*)(cache_kr + (size_t)pg_ * (PAGE * ROPE_D)); \
          const unsigned lo_ = (unsigned)((tid >> 5) * 4096 + (tid & 31) * 16), ko_ = (unsigned)(tid * 16); \
          _Pragma("unroll") for (int i = 0; i < 8; ++i) pl[i] = __builtin_nontemporal_load((const f32x4*)(lb_ + lo_ + i * 512)); \
          pk[0] = __builtin_nontemporal_load((const f32x4*)(kb_ + ko_)); pk[1] = __builtin_nontemporal_load((const f32x4*)(kb_ + 8192 + ko_)); } while (0)
        SA_PREFETCH(0);
#pragma unroll 1
        for (int pgi = 0; pgi < 64; ++pgi) {
            const int pb = pgi & 1;
#ifndef SA_REP_STAGE
#define SA_REP_STAGE 1
#endif
#ifndef SA_REP_TILE
#define SA_REP_TILE 1
#endif
            for (int rs_ = 0; rs_ < SA_REP_STAGE; ++rs_) { asm volatile("" ::: "memory");
            { unsigned lo[8], hi2[8];
#pragma unroll
              for (int i = 0; i < 8; ++i) { lo[i] = pk2(pl[i].x, pl[i].y); hi2[i] = pk2(pl[i].z, pl[i].w); *(LAS v2u*)(S + SA_LK + (8 * kg + i) * LK_PITCH + dq * 8) = (v2u){lo[i], hi2[i]}; }
              v4u w0, w1, w2, w3;
#pragma unroll
              for (int i = 0; i < 4; ++i) { w0[i] = __builtin_amdgcn_perm(lo[2 * i + 1], lo[2 * i], 0x05040100u); w1[i] = __builtin_amdgcn_perm(lo[2 * i + 1], lo[2 * i], 0x07060302u);
                                            w2[i] = __builtin_amdgcn_perm(hi2[2 * i + 1], hi2[2 * i], 0x05040100u); w3[i] = __builtin_amdgcn_perm(hi2[2 * i + 1], hi2[2 * i], 0x07060302u); }
              LAS unsigned char* T = S + SA_LT + pb * SA_LT_BUF + kg * 16;
              *(LAS v4u*)(T + (4 * dq + 0) * LT_PITCH) = w0; *(LAS v4u*)(T + (4 * dq + 1) * LT_PITCH) = w1; *(LAS v4u*)(T + (4 * dq + 2) * LT_PITCH) = w2; *(LAS v4u*)(T + (4 * dq + 3) * LT_PITCH) = w3; }
#pragma unroll
            for (int i = 0; i < 2; ++i) { const int c = tid + 512 * i, key = c >> 3, part = c & 7; *(LAS v2u*)(S + SA_KR + key * LKR_PITCH + part * 8) = (v2u){pk2(pk[i].x, pk[i].y), pk2(pk[i].z, pk[i].w)}; }
            }
            if (pgi + 1 < 64) SA_PREFETCH(pgi + 1);
            __syncthreads();
            float sc[4];
            for (int rt_ = 0; rt_ < SA_REP_TILE; ++rt_) { asm volatile("" ::: "memory");
            { f32x16 a0, a1; f32x4 r4; bf16x8 bf[8], kb0, kb1; float ssx, ssy, dtx, dty;
#define SA_LOADB(kt) do { _Pragma("unroll") for (int s = 0; s < 8; ++s) bf[s] = *(const LAS bf16x8*)(S + SA_LK + (32 * (kt) + r32) * LK_PITCH + (16 * s + 8 * hh) * 2); \
                const LAS unsigned char* kr_ = S + SA_KR + (32 * (kt) + (lane & 15)) * LKR_PITCH + (lane >> 4) * 16; kb0 = *(const LAS bf16x8*)kr_; kb1 = *(const LAS bf16x8*)(kr_ + 16 * LKR_PITCH); } while (0)
#define SA_ROPE() do { r4 = (f32x4){0.f, 0.f, 0.f, 0.f}; r4 = mfma16(qv[0], kb0, r4); r4 = mfma16(qv[1], kb1, r4); } while (0)
#define SA_MF(A, rt) do { A = f32x16{}; _Pragma("unroll") for (int s = 0; s < 8; ++s) A = mfma32(wk[rt][s], bf[s], A); } while (0)
#define SA_RED(A, rt) do { f32x4 q_[4]; _Pragma("unroll") for (int g = 0; g < 4; ++g) q_[g] = *(const LAS f32x4*)(S + SA_QG + h * 256 + (32 * (rt) + 8 * g + 4 * hh) * 4); \
                _Pragma("unroll") for (int g = 0; g < 4; ++g) { ssx += A[4 * g] * A[4 * g]; ssy += A[4 * g + 1] * A[4 * g + 1]; ssx += A[4 * g + 2] * A[4 * g + 2]; ssy += A[4 * g + 3] * A[4 * g + 3]; } \
                _Pragma("unroll") for (int g = 0; g < 4; ++g) { dtx += A[4 * g] * q_[g].x; dty += A[4 * g + 1] * q_[g].y; dtx += A[4 * g + 2] * q_[g].z; dty += A[4 * g + 3] * q_[g].w; } } while (0)
#define SA_FIN(kt, RV) do { const float ss_ = xhalf_sum_pl(ssx + ssy), dot_ = xhalf_sum_pl(dtx + dty); sc[kt] = __builtin_amdgcn_rsqf(ss_ * (1.f / 64.f) + EPS) * dot_ + (RV); } while (0)
#define SA_SB() __builtin_amdgcn_sched_barrier(0)
              float rv;
              SA_LOADB(0); SA_ROPE(); SA_MF(a0, 0); SA_SB();
#pragma unroll
              for (int kt = 0; kt < 4; ++kt) {
                  ssx = 0.f; ssy = 0.f; dtx = 0.f; dty = 0.f; rv = r4[0];
                  SA_MF(a1, 1); SA_SB();
                  if (kt < 3) { SA_LOADB(kt + 1); SA_SB(); }
                  SA_RED(a0, 0); SA_SB();
                  if (kt < 3) { SA_ROPE(); SA_MF(a0, 0); SA_SB(); }
                  SA_RED(a1, 1); SA_FIN(kt, rv); SA_SB();
              }
#undef SA_LOADB
#undef SA_ROPE
#undef SA_MF
#undef SA_RED
#undef SA_FIN
#undef SA_SB
            } }
            float mx = half_max32(fmaxf(fmaxf(sc[0], sc[1]), fmaxf(sc[2], sc[3])));
            const float m_new = fmaxf(m_run, mx); const float alpha = __builtin_amdgcn_exp2f(m_run - m_new); m_run = m_new;
            float ps = 0.f;
#pragma unroll
            for (int kt = 0; kt < 4; ++kt) { const float e = __builtin_amdgcn_exp2f(sc[kt] - m_new); ps += e; if (hh == 0) *(LAS bf16*)(S + SA_P + pb * SA_P_BUF + h * 256 + (32 * kt + r32) * 2) = (bf16)f2bf(e); }
            l_run = l_run * alpha + ps;
            if (lane == 0) *(LAS float*)(S + SA_AL + pb * 32 + h * 4) = alpha;
            __syncthreads();
            { const int g4 = lane >> 4, n16 = lane & 15;
              if (g4 < 2) { const f32x4 al = *(const LAS f32x4*)(S + SA_AL + pb * 32 + 16 * g4); ctx = ctx * al; }
#pragma unroll
              for (int ks = 0; ks < 4; ++ks) {
                  bf16x8 af = *(const LAS bf16x8*)(S + SA_P + pb * SA_P_BUF + (n16 & 7) * 256 + (32 * ks + 8 * g4) * 2); if (n16 >= 8) af = bf16x8{};
                  const bf16x8 bfr = *(const LAS bf16x8*)(S + SA_LT + pb * SA_LT_BUF + (16 * h + n16) * LT_PITCH + (32 * ks + 8 * g4) * 2);
                  ctx = mfma16(af, bfr, ctx); } }
        }
#undef SA_PREFETCH
        { const int ln = fresh_lane(); const int g4 = ln >> 4, n16 = ln & 15; float* pu = PART + (size_t)u * PART_STRIDE;
          if (g4 < 2) {
#pragma unroll
              for (int i = 0; i < 4; ++i) pu[(4 * g4 + i) * 132 + 16 * h + n16] = ctx[i]; }
          const float lsum = wave_sum(l_run) * 0.5f;
          if (ln == 0) { pu[h * 132 + 128] = m_run; pu[h * 132 + 129] = lsum; } }
        __syncthreads();
    }
}

typedef int v8i __attribute__((ext_vector_type(8)));
constexpr int L8_PITCH = 144;
constexpr int S8_LK = 0, S8_LK_BUF = 128 * L8_PITCH, S8_LT = 2 * S8_LK_BUF, S8_LT_BUF = 128 * LT_PITCH, S8_KR = S8_LT + 2 * S8_LT_BUF, S8_KR_BUF = 128 * LKR_PITCH,
              S8_DOT = S8_KR + 2 * S8_KR_BUF, S8_ROPE = S8_DOT + 4096, S8_P = S8_ROPE + 4096, S8_AL = S8_P + 2048, S8_QA = S8_AL + 32, S8_QG = S8_QA + 2048, S8_END = S8_QG + 2048;
static_assert(S8_END <= RING_BYTES, "fp8 sample attention LDS");
__device__ __forceinline__ int fp8x4(float a, float b, float c, float d) { int w = 0; w = __builtin_amdgcn_cvt_pk_fp8_f32(a, b, w, false); w = __builtin_amdgcn_cvt_pk_fp8_f32(c, d, w, true); return w; }
__device__ __forceinline__ f32x16 mfma8(v8i a, v8i b, f32x16 c) { return __builtin_amdgcn_mfma_scale_f32_32x32x64_f8f6f4(a, b, c, 0, 0, 0, 127, 0, 127); }
__device__ __forceinline__ void phase_attn_sample8(const Ctx& C, const Params& P) {
    const int lane = C.lane, h = C.wave, tid = C.tid, r32 = lane & 31, hh = lane >> 5;
    const bf16* WUKV = WSP(const bf16, WS_WUKV); const bf16* Q = WSP(const bf16, WS_Q); float* PART = WSP(float, WS_PART);
    const float* cache_lat = P.in[2]; const float* cache_kr = P.in[3]; const int* ptab = (const int*)P.in[7]; const float* gkn = P.in[28];
    LAS unsigned char* S = C.lds + RING_OFF; const unsigned lds0 = (unsigned)(uintptr_t)S;
    v8i wk8[2][2];
#pragma unroll
    for (int rt = 0; rt < 2; ++rt)
#pragma unroll
        for (int ks = 0; ks < 2; ++ks) { const bf16* wp = WUKV + (size_t)(h * 128 + 32 * rt + r32) * 256 + 64 * ks + 32 * hh;
#pragma unroll
            for (int q = 0; q < 4; ++q) { const v4u w = *(const v4u*)(wp + 8 * q); float f[8]; unpack8f(w, f);
                wk8[rt][ks][2 * q] = fp8x4(16.f * f[0], 16.f * f[1], 16.f * f[2], 16.f * f[3]); wk8[rt][ks][2 * q + 1] = fp8x4(16.f * f[4], 16.f * f[5], 16.f * f[6], 16.f * f[7]); } }
    const int kg = tid >> 5, dq = tid & 31;
    for (int u = C.bid; u < 256; u += C.G) {
        const int sq = u >> 1, half = u & 1; const size_t qrow = (size_t)(MP + sq);
        { const int l2 = fresh_lane(); *(LAS float*)(S + S8_QG + h * 256 + l2 * 4) = bf2f(Q[qrow * 768 + h * 96 + l2]) * gkn[l2];
          const int kc = l2 & 15, dg = l2 >> 4; float acc[8] = {0.f, 0.f, 0.f, 0.f, 0.f, 0.f, 0.f, 0.f};
          asm volatile("s_waitcnt lgkmcnt(0)" ::: "memory");
#pragma unroll 4
          for (int i = 0; i < 16; ++i) { const int d = dg + 4 * i; const v4u w = *(const v4u*)(WUKV + (size_t)(h * 128 + d) * 256 + 8 * kc); float f[8]; unpack8f(w, f);
              const float qd = *(const LAS float*)(S + S8_QG + h * 256 + d * 4);
#pragma unroll
              for (int j = 0; j < 8; ++j) acc[j] += f[j] * qd; }
#pragma unroll
          for (int j = 0; j < 8; ++j) { acc[j] += lane_xor16(acc[j], l2); acc[j] += lane_xor32(acc[j], l2); }
          if (dg == 0) *(LAS bf16x8*)(S + S8_QA + h * 256 + kc * 16) = pack8(acc); }
        float m_run = -INFINITY, l_run = 0.f; f32x4 ctx = (f32x4){0.f, 0.f, 0.f, 0.f};
        f32x4 pl[8]; f32x4 pk[2];
        const int pgs = ptab[sq * NPAGES + half * 64 + lane];
#define S8_PREFETCH(pgidx) do { const int pg_ = __builtin_amdgcn_readlane(pgs, (pgidx)); \
          const char* lb_ = (const char*)(cache_lat + (size_t)pg_ * (PAGE * KVLR)); const char* kb_ = (const char*)(cache_kr + (size_t)pg_ * (PAGE * ROPE_D)); \
          const unsigned lo_ = (unsigned)((tid >> 5) * 4096 + (tid & 31) * 16), ko_ = (unsigned)(tid * 16); \
          _Pragma("unroll") for (int i = 0; i < 8; ++i) pl[i] = __builtin_nontemporal_load((const f32x4*)(lb_ + lo_ + i * 512)); \
          pk[0] = __builtin_nontemporal_load((const f32x4*)(kb_ + ko_)); pk[1] = __builtin_nontemporal_load((const f32x4*)(kb_ + 8192 + ko_)); } while (0)
#define S8_STAGE(nb) do { \
          unsigned lo[8], hi2[8]; \
          _Pragma("unroll") for (int i = 0; i < 8; ++i) { lo[i] = pk2(pl[i].x, pl[i].y); hi2[i] = pk2(pl[i].z, pl[i].w); \
              *(LAS int*)(S + S8_LK + (nb) * S8_LK_BUF + (8 * kg + i) * L8_PITCH + dq * 4) = fp8x4(pl[i].x, pl[i].y, pl[i].z, pl[i].w); } \
          v4u w0, w1, w2, w3; \
          _Pragma("unroll") for (int i = 0; i < 4; ++i) { w0[i] = __builtin_amdgcn_perm(lo[2 * i + 1], lo[2 * i], 0x05040100u); w1[i] = __builtin_amdgcn_perm(lo[2 * i + 1], lo[2 * i], 0x07060302u); \
                                            w2[i] = __builtin_amdgcn_perm(hi2[2 * i + 1], hi2[2 * i], 0x05040100u); w3[i] = __builtin_amdgcn_perm(hi2[2 * i + 1], hi2[2 * i], 0x07060302u); } \
          LAS unsigned char* T = S + S8_LT + (nb) * S8_LT_BUF + kg * 16; \
          *(LAS v4u*)(T + (4 * dq + 0) * LT_PITCH) = w0; *(LAS v4u*)(T + (4 * dq + 1) * LT_PITCH) = w1; *(LAS v4u*)(T + (4 * dq + 2) * LT_PITCH) = w2; *(LAS v4u*)(T + (4 * dq + 3) * LT_PITCH) = w3; \
          _Pragma("unroll") for (int i = 0; i < 2; ++i) { const int c = tid + 512 * i, key = c >> 3, part = c & 7; \
              *(LAS v2u*)(S + S8_KR + (nb) * S8_KR_BUF + key * LKR_PITCH + part * 8) = (v2u){pk2(pk[i].x, pk[i].y), pk2(pk[i].z, pk[i].w)}; } } while (0)
#define S8_DOTROPE(nb) do { \
          const int n16_ = lane & 15, g4_ = lane >> 4, q4_ = n16_ >> 2, p4_ = n16_ & 3; \
          f32x4 dacc = (f32x4){0.f, 0.f, 0.f, 0.f}, racc = (f32x4){0.f, 0.f, 0.f, 0.f}; \
          const unsigned tb_ = lds0 + S8_LT + (nb) * S8_LT_BUF + (8 * g4_ + q4_) * LT_PITCH + (16 * h + 4 * p4_) * 2; \
          s16x4 tl_[4], th_[4]; \
          asm volatile("ds_read_b64_tr_b16 %0, %8\n\tds_read_b64_tr_b16 %1, %8 offset:%9\n\tds_read_b64_tr_b16 %2, %8 offset:%10\n\tds_read_b64_tr_b16 %3, %8 offset:%11\n\t" \
                       "ds_read_b64_tr_b16 %4, %8 offset:%12\n\tds_read_b64_tr_b16 %5, %8 offset:%13\n\tds_read_b64_tr_b16 %6, %8 offset:%14\n\tds_read_b64_tr_b16 %7, %8 offset:%15\n\ts_waitcnt lgkmcnt(0)" \
                       : "=&v"(tl_[0]), "=&v"(th_[0]), "=&v"(tl_[1]), "=&v"(th_[1]), "=&v"(tl_[2]), "=&v"(th_[2]), "=&v"(tl_[3]), "=&v"(th_[3]) \
                       : "v"(tb_), "i"(4 * LT_PITCH), "i"(32 * LT_PITCH), "i"(36 * LT_PITCH), "i"(64 * LT_PITCH), "i"(68 * LT_PITCH), "i"(96 * LT_PITCH), "i"(100 * LT_PITCH) : "memory"); \
          _Pragma("unroll") for (int ks = 0; ks < 4; ++ks) dacc = mfma16(qa[ks], __builtin_shufflevector(tl_[ks], th_[ks], 0, 1, 2, 3, 4, 5, 6, 7), dacc); \
          { const bf16x8 kb_ = *(const LAS bf16x8*)(S + S8_KR + (nb) * S8_KR_BUF + (16 * h + n16_) * LKR_PITCH + g4_ * 16); racc = mfma16(qr, kb_, racc); } \
          if (g4_ < 2) { _Pragma("unroll") for (int i = 0; i < 4; ++i) { *(LAS float*)(S + S8_DOT + ((4 * g4_ + i) * 128 + 16 * h + n16_) * 4) = dacc[i]; *(LAS float*)(S + S8_ROPE + ((4 * g4_ + i) * 128 + 16 * h + n16_) * 4) = racc[i]; } } } while (0)
        S8_PREFETCH(0);
        __syncthreads();
        bf16x8 qa[4], qr;
        { const int n16 = lane & 15, g4 = lane >> 4;
#pragma unroll
          for (int ks = 0; ks < 4; ++ks) { bf16x8 f = *(const LAS bf16x8*)(S + S8_QA + (n16 & 7) * 256 + (32 * ks + 8 * g4) * 2); if (n16 >= 8) f = bf16x8{}; qa[ks] = f; }
          qr = bf16x8{}; if (n16 < 8) qr = *(const bf16x8*)(Q + qrow * 768 + n16 * 96 + 64 + 8 * g4); }
        S8_STAGE(0); S8_PREFETCH(1);
        __syncthreads();
        S8_DOTROPE(0);
#pragma unroll 1
        for (int pgi = 0; pgi < 64; ++pgi) {
            const int pb = pgi & 1;
            __syncthreads();
            float sc[4];
            { v8i bA0, bA1, bB0, bB1; f32x16 xa0, xa1, ya0, ya1; float dvA, rvA, dvB, rvB;
#define S8_LOADB(kt, B0, B1, DV, RV) do { const LAS unsigned char* bp_ = S + S8_LK + pb * S8_LK_BUF + (32 * (kt) + r32) * L8_PITCH + 32 * hh; \
                const v4u b00_ = *(const LAS v4u*)bp_, b01_ = *(const LAS v4u*)(bp_ + 16), b10_ = *(const LAS v4u*)(bp_ + 64), b11_ = *(const LAS v4u*)(bp_ + 80); \
                DV = *(const LAS float*)(S + S8_DOT + (h * 128 + 32 * (kt) + r32) * 4); RV = *(const LAS float*)(S + S8_ROPE + (h * 128 + 32 * (kt) + r32) * 4); \
                B0 = (v8i){(int)b00_.x, (int)b00_.y, (int)b00_.z, (int)b00_.w, (int)b01_.x, (int)b01_.y, (int)b01_.z, (int)b01_.w}; \
                B1 = (v8i){(int)b10_.x, (int)b10_.y, (int)b10_.z, (int)b10_.w, (int)b11_.x, (int)b11_.y, (int)b11_.z, (int)b11_.w}; } while (0)
#define S8_MF(B0, B1, A0, A1) do { A0 = f32x16{}; A1 = f32x16{}; A0 = mfma8(wk8[0][0], B0, A0); A1 = mfma8(wk8[1][0], B0, A1); A0 = mfma8(wk8[0][1], B1, A0); A1 = mfma8(wk8[1][1], B1, A1); } while (0)
#define S8_RED(kt, A0, A1, DV, RV) do { float sx_ = 0.f, sy_ = 0.f; \
                _Pragma("unroll") for (int r = 0; r < 16; r += 2) { sx_ += A0[r] * A0[r]; sy_ += A0[r + 1] * A0[r + 1]; sx_ += A1[r] * A1[r]; sy_ += A1[r + 1] * A1[r + 1]; } \
                const float ss_ = xhalf_sum_pl(sx_ + sy_); sc[kt] = __builtin_amdgcn_rsqf(ss_ * (1.f / (64.f * 256.f)) + EPS) * (DV) + (RV); } while (0)
#define S8_SB() __builtin_amdgcn_sched_barrier(0)
              S8_LOADB(0, bA0, bA1, dvA, rvA); S8_LOADB(1, bB0, bB1, dvB, rvB); S8_MF(bA0, bA1, xa0, xa1); S8_SB();
              { const float d0 = dvA, r0 = rvA; S8_MF(bB0, bB1, ya0, ya1); S8_LOADB(2, bA0, bA1, dvA, rvA); S8_RED(0, xa0, xa1, d0, r0); S8_SB(); }
              { const float d1 = dvB, r1 = rvB; S8_MF(bA0, bA1, xa0, xa1); S8_LOADB(3, bB0, bB1, dvB, rvB); S8_RED(1, ya0, ya1, d1, r1); S8_SB(); }
              S8_MF(bB0, bB1, ya0, ya1); S8_RED(2, xa0, xa1, dvA, rvA); S8_SB();
              S8_RED(3, ya0, ya1, dvB, rvB);
#undef S8_LOADB
#undef S8_MF
#undef S8_RED
#undef S8_SB
            }
            float mx = half_max32(fmaxf(fmaxf(sc[0], sc[1]), fmaxf(sc[2], sc[3])));
            const float m_new = fmaxf(m_run, mx); const float alpha = __builtin_amdgcn_exp2f(m_run - m_new); m_run = m_new;
            float ps = 0.f;
#pragma unroll
            for (int kt = 0; kt < 4; ++kt) { const float e = __builtin_amdgcn_exp2f(sc[kt] - m_new); ps += e; if (hh == 0) *(LAS bf16*)(S + S8_P + h * 256 + (32 * kt + r32) * 2) = (bf16)f2bf(e); }
            l_run = l_run * alpha + ps;
            if (lane == 0) *(LAS float*)(S + S8_AL + h * 4) = alpha;
            if (pgi + 1 < 64) { S8_STAGE(pb ^ 1); if (pgi + 2 < 64) S8_PREFETCH(pgi + 2); }
            __syncthreads();
            { const int g4 = lane >> 4, n16 = lane & 15;
              const f32x4 al = *(const LAS f32x4*)(S + S8_AL + 16 * (g4 & 1));
              bf16x8 af[4], bfr[4];
#pragma unroll
              for (int ks = 0; ks < 4; ++ks) { af[ks] = *(const LAS bf16x8*)(S + S8_P + (n16 & 7) * 256 + (32 * ks + 8 * g4) * 2);
                  bfr[ks] = *(const LAS bf16x8*)(S + S8_LT + pb * S8_LT_BUF + (16 * h + n16) * LT_PITCH + (32 * ks + 8 * g4) * 2); }
              if (g4 < 2) ctx = ctx * al;
#pragma unroll
              for (int ks = 0; ks < 4; ++ks) { if (n16 >= 8) af[ks] = bf16x8{}; ctx = mfma16(af[ks], bfr[ks], ctx); } }
            if (pgi + 1 < 64) S8_DOTROPE(pb ^ 1);
        }
#undef S8_PREFETCH
#undef S8_STAGE
#undef S8_DOTROPE
        { const int ln = fresh_lane(); const int g4 = ln >> 4, n16 = ln & 15; float* pu = PART + (size_t)u * PART_STRIDE;
          if (g4 < 2) {
#pragma unroll
              for (int i = 0; i < 4; ++i) pu[(4 * g4 + i) * 132 + 16 * h + n16] = ctx[i]; }
          const float lsum = wave_sum(l_run) * 0.5f;
          if (ln == 0) { pu[h * 132 + 128] = m_run; pu[h * 132 + 129] = lsum; } }
        __syncthreads();
    }
}

__device__ __forceinline__ void phase_sample_combine(const Ctx& C, const Params& P) {
    const int gw = C.bid * NWAVES + C.wave, NGW = C.G * NWAVES, lane = C.lane;
    const float* PART = WSP(const float, WS_PART); const bf16* Q = WSP(const bf16, WS_Q); const bf16* KF = WSP(const bf16, WS_KF); const bf16* KVRAW = WSP(const bf16, WS_KVRAW);
    bf16* ATT = WSP(bf16, WS_ATT); const float* wukv = P.in[27];
    for (int it = gw; it < MS * NHEAD; it += NGW) {
        const int sq = it >> 3, h = it & 7; const size_t row = (size_t)(MP + sq);
        const float* p0 = PART + (size_t)(2 * sq) * PART_STRIDE + h * 132; const float* p1 = p0 + PART_STRIDE;
        float sn = 0.f; if (lane < 48) { const unsigned qa = *(const unsigned*)(Q + row * 768 + h * 96 + 2 * lane), ka = *(const unsigned*)(KF + row * 768 + h * 96 + 2 * lane); sn = bflo(qa) * bflo(ka) + bfhi(qa) * bfhi(ka); }
        sn = wave_sum(sn);
        const float m0 = p0[128], l0 = p0[129], m1 = p1[128], l1 = p1[129];
        const float M = fmaxf(fmaxf(m0, m1), sn); const float w0 = exp2f(m0 - M), w1 = exp2f(m1 - M), wn = exp2f(sn - M);
        const float Lt = l0 * w0 + l1 * w1 + wn;
        const float c_lo = p0[lane] * w0 + p1[lane] * w1, c_hi = p0[64 + lane] * w0 + p1[64 + lane] * w1;
        float acc = 0.f; const float* wv = wukv + h * 128 + 64 + lane;
#pragma unroll
        for (int k = 0; k < 64; ++k) { acc += __builtin_bit_cast(float, __builtin_amdgcn_readlane(__builtin_bit_cast(int, c_lo), k)) * wv[(size_t)k * 1024];
                                       acc += __builtin_bit_cast(float, __builtin_amdgcn_readlane(__builtin_bit_cast(int, c_hi), k)) * wv[(size_t)(64 + k) * 1024]; }
        const float outv = (acc + wn * bf2f(KVRAW[row * 1024 + h * 128 + 64 + lane])) / Lt;
        ATT[row * 512 + h * 64 + lane] = (bf16)f2bf(outv);
    }
}

__device__ __forceinline__ void phase_mix(const Ctx& C, const Params& P) {
    const int gw = C.bid * NWAVES + C.wave, NGW = C.G * NWAVES, lane = C.lane;
    const bf16* Z = WSP(const bf16, WS_Z); const bf16* HL = WSP(const bf16, WS_HL); const bf16* AC = WSP(const bf16, WS_AC); const bf16* ATT = WSP(const bf16, WS_ATT);
    const float* CAR = WSP(const float, WS_CARRY); bf16* MIX = WSP(bf16, WS_MIX);
    const int c = 8 * lane;
    float glo[8], gmo[8];
#pragma unroll
    for (int j = 0; j < 8; ++j) { glo[j] = P.in[29][c + j]; gmo[j] = P.in[30][c + j]; }
    for (int r0 = gw; r0 < MREAL; r0 += 2 * NGW) {
        v4u wh[2], wa[2], wg[2], wt[2]; f32x4 c0[2], c1[2]; int rr[2];
#pragma unroll
        for (int u = 0; u < 2; ++u) { const int r = (r0 + u * NGW < MREAL) ? r0 + u * NGW : r0; rr[u] = r;
            wh[u] = *(const v4u*)(HL + (size_t)r * 512 + c); wa[u] = *(const v4u*)(AC + (size_t)r * 512 + c); wg[u] = *(const v4u*)(Z + (size_t)r * ZC + 512 + c); wt[u] = *(const v4u*)(ATT + (size_t)r * 512 + c);
            c0[u] = (f32x4){0.f, 0.f, 0.f, 0.f}; c1[u] = c0[u];
            if (r < MP) { const float* cp = CAR + ((size_t)(r >> 11) * 32 + ((r & 2047) >> 6)) * 512 + c; c0[u] = *(const f32x4*)cp; c1[u] = *(const f32x4*)(cp + 4); } }
#pragma unroll
        for (int u = 0; u < 2; ++u) { const int r = rr[u];
            float hv[8], av[8], gv[8], tv[8]; unpack8f(wh[u], hv); unpack8f(wa[u], av); unpack8f(wg[u], gv); unpack8f(wt[u], tv);
            const float cin[8] = {c0[u].x, c0[u].y, c0[u].z, c0[u].w, c1[u].x, c1[u].y, c1[u].z, c1[u].w};
            float ss = 0.f, s2 = 0.f;
#pragma unroll
            for (int j = 0; j < 8; ++j) { hv[j] = (hv[j] + av[j] * cin[j]) * gelu_tanh(gv[j]); ss += hv[j] * hv[j]; s2 += tv[j] * tv[j]; }
            const float rstd = rsqrtf(wave_sum(ss) * (1.f / 512.f) + EPS), rs2 = rsqrtf(wave_sum(s2) * (1.f / 512.f) + EPS);
#pragma unroll
            for (int j = 0; j < 8; ++j) { hv[j] = hv[j] * rstd * glo[j]; tv[j] = tv[j] * rs2 * gmo[j]; }
            *(bf16x8*)(MIX + (size_t)r * 1024 + c) = pack8(hv); *(bf16x8*)(MIX + (size_t)r * 1024 + 512 + c) = pack8(tv);
        }
    }
}

__device__ __forceinline__ void unpack8(const v4u& w, float* v) { v[0] = bflo(w.x); v[1] = bfhi(w.x); v[2] = bflo(w.y); v[3] = bfhi(w.y); v[4] = bflo(w.z); v[5] = bfhi(w.z); v[6] = bflo(w.w); v[7] = bfhi(w.w); }
__device__ __forceinline__ void phase_ffn_fixup(const Ctx& C, const Params& P) {
    const float* RAW = WSP(const float, WS_RAW); const bf16* UP = WSP(const bf16, WS_UP); bf16* ACT = WSP(bf16, WS_ACT); const float* fw = P.in[34]; const float* fb = P.in[35];
    const int gt = C.bid * 512 + C.tid, NGT = C.G * 512;
    constexpr int N1 = 256 * 704, N2 = NBATCH * 2 * (UPC / 4), N3 = MS * 352;
    for (int it = gt; it < N1 + N2 + N3; it += NGT) {
      if (it < N1) { const int idx = it;
        const int blk = idx / 704, c = 4 * (idx - blk * 704);
        if ((blk & 15) == 0) continue;
        const float* r0 = RAW + (size_t)(blk - 1) * 4 * UPC; const float* r1 = RAW + (size_t)blk * 4 * UPC;
        const f32x4 wv0 = *(const f32x4*)(fw + c), wv1 = *(const f32x4*)(fw + UPC + c), wv2 = *(const f32x4*)(fw + 2 * UPC + c), bv = *(const f32x4*)(fb + c);
        const f32x4 wg0 = *(const f32x4*)(fw + DFF + c), wg1 = *(const f32x4*)(fw + UPC + DFF + c), wg2 = *(const f32x4*)(fw + 2 * UPC + DFF + c), bg = *(const f32x4*)(fb + DFF + c);
        const f32x4 vm2 = *(const f32x4*)(r0 + c), vm1 = *(const f32x4*)(r0 + UPC + c), v0 = *(const f32x4*)(r1 + 2 * UPC + c), v1 = *(const f32x4*)(r1 + 3 * UPC + c);
        const f32x4 gm2 = *(const f32x4*)(r0 + DFF + c), gm1 = *(const f32x4*)(r0 + UPC + DFF + c), g0 = *(const f32x4*)(r1 + 2 * UPC + DFF + c), g1 = *(const f32x4*)(r1 + 3 * UPC + DFF + c);
        const f32x4 va = bv + wv0 * vm2 + wv1 * vm1 + wv2 * v0, ga = bg + wg0 * gm2 + wg1 * gm1 + wg2 * g0;
        const f32x4 vb = bv + wv0 * vm1 + wv1 * v0 + wv2 * v1, gb = bg + wg0 * gm1 + wg1 * g0 + wg2 * g1;
        v2u oa, ob; oa.x = pk2(gelu_tanh(ga.x) * va.x, gelu_tanh(ga.y) * va.y); oa.y = pk2(gelu_tanh(ga.z) * va.z, gelu_tanh(ga.w) * va.w);
        ob.x = pk2(gelu_tanh(gb.x) * vb.x, gelu_tanh(gb.y) * vb.y); ob.y = pk2(gelu_tanh(gb.z) * vb.z, gelu_tanh(gb.w) * vb.w);
        *(v2u*)(ACT + (size_t)(blk * 128) * DFF + c) = oa; *(v2u*)(ACT + (size_t)(blk * 128 + 1) * DFF + c) = ob;
      } else if (it < N1 + N2) { const int idx = it - N1;
        const int b = idx / (2 * (UPC / 4)), rem = idx - b * (2 * (UPC / 4)), s = rem / (UPC / 4), c = 4 * (rem - s * (UPC / 4));
        *(f32x4*)(P.out + O_FCP + ((size_t)b * 2 + s) * UPC + c) = *(const f32x4*)(RAW + ((size_t)(16 * b + 15) * 4 + s) * UPC + c);
      } else { const int idx = it - N1 - N2;
        const int s_ = idx / 352, c = 8 * (idx - s_ * 352); const int r = MP + s_;
        float v0[8], g0[8]; unpack8(*(const v4u*)(UP + (size_t)r * UPC + c), v0); unpack8(*(const v4u*)(UP + (size_t)r * UPC + DFF + c), g0);
        const float* st = P.in[6] + (size_t)s_ * 2 * UPC; float* d = P.out + O_FCS + (size_t)s_ * 2 * UPC;
        float o[8];
#pragma unroll
        for (int q = 0; q < 2; ++q) { const int cc = c + 4 * q;
            const f32x4 v2 = *(const f32x4*)(st + cc), g2 = *(const f32x4*)(st + DFF + cc), v1 = *(const f32x4*)(st + UPC + cc), g1 = *(const f32x4*)(st + UPC + DFF + cc);
            const f32x4 vv = (f32x4){v0[4 * q], v0[4 * q + 1], v0[4 * q + 2], v0[4 * q + 3]}, gg = (f32x4){g0[4 * q], g0[4 * q + 1], g0[4 * q + 2], g0[4 * q + 3]};
            *(f32x4*)(d + cc) = v1; *(f32x4*)(d + DFF + cc) = g1; *(f32x4*)(d + UPC + cc) = vv; *(f32x4*)(d + UPC + DFF + cc) = gg;
            const f32x4 val = *(const f32x4*)(fb + cc) + *(const f32x4*)(fw + cc) * v2 + *(const f32x4*)(fw + UPC + cc) * v1 + *(const f32x4*)(fw + 2 * UPC + cc) * vv;
            const f32x4 gt_ = *(const f32x4*)(fb + DFF + cc) + *(const f32x4*)(fw + DFF + cc) * g2 + *(const f32x4*)(fw + UPC + DFF + cc) * g1 + *(const f32x4*)(fw + 2 * UPC + DFF + cc) * gg;
#pragma unroll
            for (int e = 0; e < 4; ++e) o[4 * q + e] = gelu_tanh(gt_[e]) * val[e]; }
        *(bf16x8*)(ACT + (size_t)r * DFF + c) = pack8(o);
      }
    }
}

__device__ __forceinline__ void phase_stream_probe(const Ctx& C, const Params& P) {
    const float* cache_lat = P.in[2]; const float* cache_kr = P.in[3]; const int* ptab = (const int*)P.in[7]; const int tid = C.tid, lane = C.lane;
    float accum = 0.f;
    for (int u = C.bid; u < 256; u += C.G) {
        const int sq = u >> 1, half = u & 1;
        const int pgs = ptab[sq * NPAGES + half * 64 + lane];
        f32x4 pl[8], pk[2];
#define PR_PREFETCH(pgidx) do { const int pg_ = __builtin_amdgcn_readlane(pgs, (pgidx)); \
          const char* lb_ = (const char*)(cache_lat + (size_t)pg_ * (PAGE * KVLR)); const char* kb_ = (const char*)(cache_kr + (size_t)pg_ * (PAGE * ROPE_D)); \
          const unsigned lo_ = (unsigned)((tid >> 5) * 4096 + (tid & 31) * 16), ko_ = (unsigned)(tid * 16); \
          _Pragma("unroll") for (int i = 0; i < 8; ++i) pl[i] = __builtin_nontemporal_load((const f32x4*)(lb_ + lo_ + i * 512)); \
          pk[0] = __builtin_nontemporal_load((const f32x4*)(kb_ + ko_)); pk[1] = __builtin_nontemporal_load((const f32x4*)(kb_ + 8192 + ko_)); } while (0)
        PR_PREFETCH(0);
#pragma unroll 1
        for (int pgi = 0; pgi < 64; ++pgi) {
            float s = 0.f;
#pragma unroll
            for (int i = 0; i < 8; ++i) s += (pl[i].x + pl[i].y) + (pl[i].z + pl[i].w);
            s += pk[0].x + pk[1].y;
            if (pgi + 1 < 64) PR_PREFETCH(pgi + 1);
            accum += s;
        }
#undef PR_PREFETCH
    }
    WSP(float, WS_END)[C.bid * 512 + tid] = accum;
}
#ifndef SA_FP8
#define SA_FP8 1
#endif

constexpr int N_LAUNCHES = MK_N_LAUNCHES;
constexpr int N_PHASES = 16;
template <int PHASE_MASK> __global__ void __launch_bounds__(NWAVES * 64, 2) mk_fwd(Params P) {
    extern __shared__ __attribute__((aligned(16))) unsigned char lds[];
    Ctx C0; C0.lds = (LAS unsigned char*)lds; C0.tid = threadIdx.x; C0.lane = C0.tid & 63; C0.wave = __builtin_amdgcn_readfirstlane(C0.tid >> 6); C0.G = gridDim.x; C0.bid = blockIdx.x; C0.p = nullptr;
    const Ctx& C = C0;
    volatile LAS unsigned* MISC = (volatile LAS unsigned*)(C.lds + MISC_OFF);
    for (int u = C.tid; u < (LDS_BYTES - LDSCTL_OFF) / 4; u += NWAVES * 64) ((LAS unsigned*)(C.lds + LDSCTL_OFF))[u] = 0u;
    __syncthreads();
    gu32* ctl = (gu32*)(P.ws + WS_CTL);
    XcdBarrier bar; bar.bar = (unsigned*)(ctl + CW_BAR); bar.x = 0; bar.st = nullptr;
    if (N_LAUNCHES == 1) bar = xcd_barrier_post((unsigned*)(ctl + CW_BAR), MISC + 8, C0.tid);
    const int lo = P.ph_lo, hi = P.ph_hi;
#define IN(k) (((PHASE_MASK >> (k)) & 1) && lo <= (k) && (k) < hi)
#ifndef EXTRA_BARRIERS
#define EXTRA_BARRIERS 0
#endif
#define SEAM(k) do { if (IN(k) && IN((k) + 1)) { PHASE_CTX(); xcd_barrier(bar, C.tid); for (int xb_ = 0; xb_ < EXTRA_BARRIERS; ++xb_) xcd_barrier(bar, C.tid); } } while (0)
#ifndef REPEAT_MASK
#define REPEAT_MASK 0
#endif
#define NREP(k) (((REPEAT_MASK >> (k)) & 1) ? 2 : 1)
#define PHASE_CTX() Ctx C = C0; asm volatile("v_mbcnt_lo_u32_b32 %0, -1, 0\n\tv_mbcnt_hi_u32_b32 %0, -1, %0" : "=v"(C.lane)); C.tid = C0.wave * 64 + C.lane

    if (IN(0)) { { PHASE_CTX(); phase_p0a(C, P); } { PHASE_CTX(); phase_adaln_direct(C, P); } } SEAM(0);
    if (IN(2)) for (int rep_ = 0; rep_ < NREP(2); ++rep_) { PHASE_CTX();
        { EpiSB Es{WSP(float, WS_SB)}; skinny_gemm_splitk<8>(C, WSP(const bf16, WS_SH2), 1024, WSP(const bf16, WS_WUP), 1024, 9, UPC / 128, 1024, Es); }
        phase_norm_mod<false>(C, P); } SEAM(2);
    if (IN(3)) for (int rep_ = 0; rep_ < NREP(3); ++rep_) { PHASE_CTX();
        { EpiSkBf16 Es{WSP(bf16, WS_Z), ZC}; skinny_gemm_splitk<2>(C, WSP(const bf16, WS_H1) + (size_t)MP * 1024, 1024, WSP(const bf16, WS_WIN), 1024, 8, ZC / 32, 1024, Es); }
        pg8::Gemm g{WSP(const pg8::bf16_t, WS_H1), WSP(const pg8::bf16_t, WS_WIN), MP, ZC, 1024}; pg8::StaticOrder S; S.init(MP, ZC, C.G, C.bid);
        pg8::EpiBf16<0> E{WSP(pg8::bf16_t, WS_Z), ZC, nullptr, 0, 0, 1.f};
        pg8::gemm_phase<pg8::EpiBf16<0>, pg8::StaticOrder, true, true>(C.lds + RING_OFF, g, S, E, C.tid);
    } SEAM(3);
    if (IN(4)) { PHASE_CTX(); phase_p3a(C, P); flag_publish(C, P, CW_F4); phase_p3b<false>(C, P); flag_wait(C, P, CW_F4); }
    if (IN(5)) for (int rep_ = 0; rep_ < NREP(5); ++rep_) { PHASE_CTX();
        { EpiSkBf16 Es{WSP(bf16, WS_QRAW), 768}; skinny_gemm<2>(C, WSP(const bf16, WS_QN) + (size_t)MP * 256, 256, WSP(const bf16, WS_WUQ), 256, 8, 768 / 32, 256, Es); }
        { EpiSkBf16 Es{WSP(bf16, WS_KVRAW), 1024}; skinny_gemm<2>(C, WSP(const bf16, WS_KVN) + (size_t)MP * 256, 256, WSP(const bf16, WS_WUKV), 256, 8, 1024 / 32, 128, Es); }
        pg8::Gemm g{WSP(const pg8::bf16_t, WS_QN), WSP(const pg8::bf16_t, WS_WUQ), MP, 768, 256}; pg8::StaticOrder S; S.init(MP, 768, C.G, C.bid);
        pg8::EpiBf16<0> E{WSP(pg8::bf16_t, WS_QRAW), 768, nullptr, 0, 0, 1.f};
        pg8::gemm_phase<pg8::EpiBf16<0>, pg8::StaticOrder, true, true>(C.lds + RING_OFF, g, S, E, C.tid);
        { Ctx C2 = C; C2.bid = (C.bid + 4) % C.G; if (C2.bid < 4) phase_p3b<true>(C2, P); }
    }
    if (IN(6)) for (int rep_ = 0; rep_ < NREP(6); ++rep_) { PHASE_CTX();
        pg8::Gemm g{WSP(const pg8::bf16_t, WS_KVN), WSP(const pg8::bf16_t, WS_WUKV), MP, 1024, 256}; pg8::StaticOrder S; S.init(MP, 1024, C.G, C.bid);
        pg8::EpiBf16<0> E{WSP(pg8::bf16_t, WS_KVRAW), 1024, nullptr, 0, 0, 1.f};
        pg8::gemm_phase<pg8::EpiBf16<0>, pg8::StaticOrder, true, true>(C.lds + RING_OFF, g, S, E, C.tid);
    } SEAM(6);
    if (IN(7)) for (int rep_ = 0; rep_ < NREP(7); ++rep_) { PHASE_CTX(); phase_p5(C, P); } SEAM(7);
    if (IN(8)) { { PHASE_CTX(); phase_carry(C, P); } for (int rep_ = 0; rep_ < NREP(16); ++rep_) { PHASE_CTX();
#if SA_FP8
            phase_attn_sample8(C, P);
#else
            phase_attn_sample(C, P);
#endif
        } { PHASE_CTX(); flag_publish(C, P, CW_F8); } for (int rep_ = 0; rep_ < NREP(17); ++rep_) { PHASE_CTX(); phase_attn_prompt(C, P); } { PHASE_CTX(); flag_wait(C, P, CW_F8); } }
    if (IN(9)) for (int rep_ = 0; rep_ < NREP(9); ++rep_) { PHASE_CTX(); phase_sample_combine(C, P); } SEAM(9);
    if (IN(10)) for (int rep_ = 0; rep_ < NREP(10); ++rep_) { PHASE_CTX(); phase_mix(C, P); } SEAM(10);
    if (IN(11)) for (int rep_ = 0; rep_ < NREP(11); ++rep_) { PHASE_CTX();
        { EpiSkResGate<false, true, true> Es{P.in[1], WSP(bf16, WS_X1) + (size_t)MP * 1024, WSP(const float, WS_MOD), 2048, WSP(bf16, WS_H1) + (size_t)MP * 1024, P.in[32], WSP(float, WS_ROWSS) + MP}; skinny_gemm_splitk<2>(C, WSP(const bf16, WS_MIX) + (size_t)MP * 1024, 1024, WSP(const bf16, WS_WO), 1024, 8, 1024 / 32, 1024, Es); }
        pg8::Gemm g{WSP(const pg8::bf16_t, WS_MIX), WSP(const pg8::bf16_t, WS_WO), MP, 1024, 1024}; pg8::StaticOrder S; S.init(MP, 1024, C.G, C.bid);
        pg8::EpiResGate<false, true, true> E{P.in[0], WSP(bf16, WS_X1), WSP(const float, WS_MOD), 2048, WSP(pg8::bf16_t, WS_H1), P.in[32], WSP(float, WS_ROWSS)};
        pg8::gemm_phase<pg8::EpiResGate<false, true, true>, pg8::StaticOrder, true, true>(C.lds + RING_OFF, g, S, E, C.tid);
        if ((REPEAT_MASK >> 21) & 1) { pg8::EpiNull<false> En; pg8::gemm_phase<pg8::EpiNull<false>, pg8::StaticOrder, true, true>(C.lds + RING_OFF, g, S, En, C.tid); }
    } SEAM(11);
    if (IN(13)) for (int rep_ = 0; rep_ < NREP(13); ++rep_) { PHASE_CTX();
        { EpiSkUp Es{WSP(bf16, WS_UP), WSP(const float, WS_ROWSS), WSP(const float, WS_SB)}; skinny_gemm_splitk<8>(C, WSP(const bf16, WS_H1) + (size_t)MP * 1024, 1024, WSP(const bf16, WS_WUP), 1024, 8, UPC / 128, 1024, Es); }
        pg8::Gemm g{WSP(const pg8::bf16_t, WS_H1), WSP(const pg8::bf16_t, WS_WUP), MP, UPC, 1024}; pg8::StaticOrder S; S.init(MP, UPC, C.G, C.bid);
        pg8::EpiConvGelu E{WSP(pg8::bf16_t, WS_ACT), WSP(float, WS_RAW), P.in[34], P.in[35], WSP(const float, WS_ROWSS), WSP(const float, WS_SB)};
        pg8::gemm_phase<pg8::EpiConvGelu, pg8::StaticOrder, true, true>(C.lds + RING_OFF, g, S, E, C.tid);
    } SEAM(13);
    if (IN(14)) for (int rep_ = 0; rep_ < NREP(14); ++rep_) { PHASE_CTX(); phase_ffn_fixup(C, P); }
    if (((REPEAT_MASK >> 20) & 1) && IN(14)) { PHASE_CTX(); pg8::Gemm g{WSP(const pg8::bf16_t, WS_H1), WSP(const pg8::bf16_t, WS_WUP), MP, UPC, 1024}; pg8::StaticOrder S; S.init(MP, UPC, C.G, C.bid);
        pg8::EpiNull<true> En; pg8::gemm_phase<pg8::EpiNull<true>, pg8::StaticOrder, true, true>(C.lds + RING_OFF, g, S, En, C.tid); }
    SEAM(14);
    if (IN(15)) for (int rep_ = 0; rep_ < NREP(15); ++rep_) { PHASE_CTX();
        { EpiSkResGate<true, false, false> Es{WSP(const bf16, WS_X1) + (size_t)MP * 1024, P.out + (size_t)MP * 1024, WSP(const float, WS_MOD), 5120, nullptr, nullptr, nullptr}; skinny_gemm_splitk<2>(C, WSP(const bf16, WS_ACT) + (size_t)MP * DFF, DFF, WSP(const bf16, WS_WDN), DFF, 8, 1024 / 32, DFF, Es);
          if ((REPEAT_MASK >> 26) & 1) skinny_gemm_splitk<2>(C, WSP(const bf16, WS_ACT) + (size_t)MP * DFF, DFF, WSP(const bf16, WS_WDN), DFF, 8, 1024 / 32, DFF, Es); }
        pg8::Gemm g{WSP(const pg8::bf16_t, WS_ACT), WSP(const pg8::bf16_t, WS_WDN), MP, 1024, DFF}; pg8::StaticOrder S; S.init(MP, 1024, C.G, C.bid);
        pg8::EpiResGate<true, false, false> E{WSP(const bf16, WS_X1), P.out, WSP(const float, WS_MOD), 5120, nullptr, nullptr, nullptr};
        pg8::gemm_phase<pg8::EpiResGate<true, false, false>, pg8::StaticOrder, true, true>(C.lds + RING_OFF, g, S, E, C.tid);
        if ((REPEAT_MASK >> 22) & 1) { pg8::EpiProbe<0> En{(float*)(P.ws + WS_UP + 64 * MiB), nullptr}; pg8::gemm_phase<pg8::EpiProbe<0>, pg8::StaticOrder, true, true>(C.lds + RING_OFF, g, S, En, C.tid); }
        if ((REPEAT_MASK >> 23) & 1) { pg8::EpiProbe<1> En{nullptr, WSP(const pg8::bf16_t, WS_X1)}; pg8::gemm_phase<pg8::EpiProbe<1>, pg8::StaticOrder, true, true>(C.lds + RING_OFF, g, S, En, C.tid); }
        if ((REPEAT_MASK >> 24) & 1) { pg8::EpiProbe<2> En{(float*)(P.ws + WS_UP + 64 * MiB), nullptr}; pg8::gemm_phase<pg8::EpiProbe<2>, pg8::StaticOrder, true, true>(C.lds + RING_OFF, g, S, En, C.tid); }
        if ((REPEAT_MASK >> 25) & 1) { pg8::EpiResGate<true, false, false> En{WSP(const bf16, WS_X1), (float*)(P.ws + WS_UP + 64 * MiB), WSP(const float, WS_MOD), 5120, nullptr, nullptr, nullptr}; pg8::gemm_phase<pg8::EpiResGate<true, false, false>, pg8::StaticOrder, true, true>(C.lds + RING_OFF, g, S, En, C.tid); }
        if ((REPEAT_MASK >> 19) & 1) { pg8::EpiNull<false> En; pg8::gemm_phase<pg8::EpiNull<false>, pg8::StaticOrder, true, true>(C.lds + RING_OFF, g, S, En, C.tid); }
    }
#undef IN
#undef SEAM
}

typedef void (*KernFn)(Params);
template <int... I> struct Seq {};
static KernFn phase_kernel(int k) {
    if constexpr (N_LAUNCHES == 1) { return mk_fwd<0xffff>; }
    else {
        switch (k) {
#define PK(i) case i: return mk_fwd<(1 << i)>;
            PK(0) PK(1) PK(2) PK(3) PK(4) PK(5) PK(6) PK(7) PK(8) PK(9) PK(10) PK(11) PK(12) PK(13) PK(14) PK(15)
#undef PK
            default: return nullptr;
        }
    }
}
extern "C" void kernel_launch(void* const* d_in, const int* in_sizes, int n_in, void* d_out, int out_size, void* d_ws, size_t ws_size, hipStream_t stream) {
    static int grid = 0;
    static KernFn fns[N_PHASES];
    if (grid == 0) {
        if (n_in != 37 || out_size != (int)O_END || ws_size < WS_END + 4 * MiB) { fprintf(stderr, "kernel_launch: unexpected shapes: n_in %d out %d ws %zu\n", n_in, out_size, ws_size); grid = -1; return; }
        int dev = 0, cus = 0, per_cu = 0;
        if (hipGetDevice(&dev) != hipSuccess || hipDeviceGetAttribute(&cus, hipDeviceAttributeMultiprocessorCount, dev) != hipSuccess) { grid = -1; return; }
        for (int li = 0; li < N_LAUNCHES; ++li) {
            fns[li] = (N_LAUNCHES == 1) ? phase_kernel(99) : phase_kernel(li);
            if (hipFuncSetAttribute((const void*)fns[li], hipFuncAttributeMaxDynamicSharedMemorySize, LDS_BYTES) != hipSuccess) { fprintf(stderr, "kernel_launch: hipFuncSetAttribute failed\n"); grid = -1; return; }
            if (hipOccupancyMaxActiveBlocksPerMultiprocessor(&per_cu, (const void*)fns[li], NWAVES * 64, LDS_BYTES) != hipSuccess || per_cu < 1) { fprintf(stderr, "kernel_launch: occupancy query says %d for launch %d\n", per_cu, li); }
        }
        (void)hipGetLastError();
        grid = cus;
    }
    if (grid < 0) return;
    if (hipMemsetAsync((char*)d_ws + WS_CTL, 0, CTL_ZERO_BYTES, stream) != hipSuccess) return;
    Params p{};
    for (int i = 0; i < 37; ++i) p.in[i] = (const float*)d_in[i];
    p.out = (float*)d_out; p.ws = (unsigned char*)d_ws;
    for (int li = 0; li < N_LAUNCHES; ++li) {
        if (N_LAUNCHES == 1) { p.ph_lo = 0; p.ph_hi = N_PHASES; } else { p.ph_lo = li; p.ph_hi = li + 1; }
        hipLaunchKernelGGL(fns[li], dim3(grid), dim3(NWAVES * 64), LDS_BYTES, stream, p);
        const hipError_t le = hipPeekAtLastError();
        if (le != hipSuccess) { fprintf(stderr, "kernel_launch: launch %d failed: %s\n", li, hipGetErrorName(le)); break; }
    }
}
```
